# Optimizing an MI355X kernel written in HIP

```python
import math
import jax, jax.numpy as jnp
from jax import lax
import numpy as np

D_MODEL = 1024
BATCH = 16
SEQ = 2048
DEPTH = 1

LRU_WIDTH = 512
LRU_HEADS = 8
LRU_BLOCK = LRU_WIDTH // LRU_HEADS
CONV_WIDTH = 4
LRU_C = 8.0
NSA_Q_HEADS = 8
NSA_KV_HEADS = 2
NSA_GROUP = NSA_Q_HEADS // NSA_KV_HEADS
HEAD_DIM = 64
NSA_WIDTH = NSA_Q_HEADS * HEAD_DIM
KV_WIDTH = NSA_KV_HEADS * HEAD_DIM
CMP_BLOCK = 32
CMP_STRIDE = 16
CMP_HIDDEN = 256
SLC_BLOCK = 64
SLC_TOP_N = 16
N_LOCAL_BLOCKS = 2
WINDOW = 512
WIN_QBLOCK = 128
SLC_QCHUNK = 32
ROPE_THETA = 10000.0
MIX_WIDTH = LRU_WIDTH + NSA_WIDTH
IN_SPLIT_SIZES = (LRU_WIDTH, LRU_WIDTH, NSA_WIDTH, KV_WIDTH, KV_WIDTH, KV_WIDTH, KV_WIDTH,
                  KV_WIDTH, KV_WIDTH, 3 * NSA_Q_HEADS)
IN_COLS = sum(IN_SPLIT_SIZES)
D_FF = 2816
ALPHA = (2.0 * DEPTH) ** 0.25
BETA = (8.0 * DEPTH) ** -0.25
LN_EPS = 1e-5
RMS_EPS = 1e-6
NEG = -1e30

kernel_name = "hymba_rglru_nsa_macaron_deepnorm"


def layer_norm(x, g, b):
    xf = x.astype(jnp.float32)
    mu = jnp.mean(xf, -1, keepdims=True)
    var = jnp.mean(jnp.square(xf - mu), -1, keepdims=True)
    return ((xf - mu) * lax.rsqrt(var + LN_EPS) * g + b).astype(x.dtype)


def rms_norm(x, g):
    xf = x.astype(jnp.float32)
    y = xf * lax.rsqrt(jnp.mean(xf * xf, -1, keepdims=True) + RMS_EPS)
    return (y * g).astype(x.dtype)


def swiglu_ffn(x, w_in, w_out):
    gate, up = jnp.split(x @ w_in, 2, axis=-1)
    return (jax.nn.silu(gate) * up) @ w_out


def rope(x):
    S = x.shape[1]
    half = HEAD_DIM // 2
    inv = ROPE_THETA ** (-jnp.arange(half, dtype=jnp.float32) / half)
    ang = jnp.arange(S, dtype=jnp.float32)[:, None] * inv[None, :]
    cos = jnp.cos(ang)[None, :, None, :]
    sin = jnp.sin(ang)[None, :, None, :]
    x1 = x[..., :half].astype(jnp.float32)
    x2 = x[..., half:].astype(jnp.float32)
    out = jnp.concatenate([x1 * cos - x2 * sin, x2 * cos + x1 * sin], axis=-1)
    return out.astype(x.dtype)


def causal_conv(x, w, b):
    S = x.shape[1]
    xp = jnp.pad(x, ((0, 0), (CONV_WIDTH - 1, 0), (0, 0)))
    y = b
    for j in range(CONV_WIDTH):
        y = y + xp[:, j:j + S] * w[j]
    return y


def rg_lru(x, w_a, b_a, w_x, b_x, lam):
    B, S, C = x.shape
    xh = x.reshape(B, S, LRU_HEADS, LRU_BLOCK)
    r = jax.nn.sigmoid(jnp.einsum('bshi,hij->bshj', xh, w_a) + b_a).reshape(B, S, C)
    i = jax.nn.sigmoid(jnp.einsum('bshi,hij->bshj', xh, w_x) + b_x).reshape(B, S, C)
    log_a = -LRU_C * r.astype(jnp.float32) * jax.nn.softplus(-lam.astype(jnp.float32))
    a = jnp.exp(log_a)
    mult = jnp.sqrt(-jnp.expm1(2.0 * log_a))
    mult = jnp.where(jnp.arange(S)[None, :, None] == 0, 1.0, mult)
    u = mult * (i * x).astype(jnp.float32)

    def combine(c1, c2):
        a1, b1 = c1
        a2, b2 = c2
        return a1 * a2, a2 * b1 + b2

    _, h = lax.associative_scan(combine, (a, u), axis=1)
    return h.astype(x.dtype)


def compress_blocks(k, pe, w1, w2):
    B, S, G, D = k.shape
    n_seg = S // CMP_STRIDE
    r = CMP_BLOCK // CMP_STRIDE
    n_cmp = n_seg - r + 1
    seg = k.reshape(B, n_seg, CMP_STRIDE, G, D)
    blocks = jnp.concatenate([seg[:, j:j + n_cmp] for j in range(r)], axis=2)
    blocks = blocks + pe[:, None, :]
    flat = blocks.transpose(0, 3, 1, 2, 4).reshape(B, G, n_cmp, CMP_BLOCK * D)
    return jax.nn.silu(flat @ w1) @ w2


def cmp_to_slc_overlap(n_cmp, n_blk):
    cs = np.arange(n_cmp) * CMP_STRIDE
    ce = cs + CMP_BLOCK - 1
    ss = np.arange(n_blk) * SLC_BLOCK
    se = ss + SLC_BLOCK - 1
    return ((cs[:, None] <= se[None, :]) & (ce[:, None] >= ss[None, :])).astype(np.float32)


def nsa_attention(q, k_cmp, v_cmp, k_slc, v_slc, k_win, v_win, gate_logits,
                  cmp_pe_k, cmp_w1_k, cmp_w2_k, cmp_pe_v, cmp_w1_v, cmp_w2_v):
    B, S = q.shape[0], q.shape[1]
    G, R, D = NSA_KV_HEADS, NSA_GROUP, HEAD_DIM
    scale = HEAD_DIM ** -0.5
    t = jnp.arange(S)
    qg = q.reshape(B, S, G, R, D).transpose(0, 2, 3, 1, 4)

    kc = compress_blocks(k_cmp, cmp_pe_k, cmp_w1_k, cmp_w2_k)
    vc = compress_blocks(v_cmp, cmp_pe_v, cmp_w1_v, cmp_w2_v)
    n_cmp = kc.shape[2]
    cmp_end = jnp.arange(n_cmp) * CMP_STRIDE + CMP_BLOCK - 1
    cmp_mask = cmp_end[None, :] <= t[:, None]
    s_cmp = jnp.einsum('bgrsd,bgnd->bgrsn', qg, kc).astype(jnp.float32) * scale
    p_cmp = jax.nn.softmax(jnp.where(cmp_mask, s_cmp, NEG), axis=-1)
    p_cmp = p_cmp * cmp_mask.any(-1)[:, None]
    o_cmp = jnp.einsum('bgrsn,bgnd->bgrsd', p_cmp.astype(vc.dtype), vc)

    n_blk = S // SLC_BLOCK
    overlap = jnp.asarray(cmp_to_slc_overlap(n_cmp, n_blk))
    imp = jnp.einsum('bgrsn,nj->bgsj', p_cmp, overlap)
    j = jnp.arange(n_blk)
    blk_valid = (j * SLC_BLOCK)[None, :] <= t[:, None]
    back = (t // SLC_BLOCK)[:, None] - j[None, :]
    forced = (j[None, :] == 0) | ((back >= 0) & (back < N_LOCAL_BLOCKS))
    score = jnp.where(blk_valid, jnp.where(forced, jnp.inf, imp), -jnp.inf)
    n_sel = min(SLC_TOP_N, n_blk)
    top_val, top_idx = lax.top_k(score, n_sel)
    sel_valid = top_val > -jnp.inf

    kb = k_slc.transpose(0, 2, 1, 3).reshape(B, G, n_blk, SLC_BLOCK, D)
    vb = v_slc.transpose(0, 2, 1, 3).reshape(B, G, n_blk, SLC_BLOCK, D)
    n_chunk = S // SLC_QCHUNK
    n_keys = n_sel * SLC_BLOCK
    q_ch = jnp.moveaxis(qg.reshape(B, G, R, n_chunk, SLC_QCHUNK, D), 3, 0)
    i_ch = jnp.moveaxis(top_idx.reshape(B, G, n_chunk, SLC_QCHUNK, n_sel), 2, 0)
    m_ch = jnp.moveaxis(sel_valid.reshape(B, G, n_chunk, SLC_QCHUNK, n_sel), 2, 0)
    starts = jnp.arange(n_chunk) * SLC_QCHUNK
    b_ix = jnp.arange(B)[:, None, None, None]
    g_ix = jnp.arange(G)[None, :, None, None]
    offs = jnp.arange(SLC_BLOCK)

    def sel_chunk(args):
        qc, ic, mc, c0 = args
        kg = kb[b_ix, g_ix, ic].reshape(B, G, SLC_QCHUNK, n_keys, D)
        vg = vb[b_ix, g_ix, ic].reshape(B, G, SLC_QCHUNK, n_keys, D)
        kpos = (ic[..., None] * SLC_BLOCK + offs).reshape(B, G, SLC_QCHUNK, n_keys)
        kval = jnp.broadcast_to(mc[..., None], mc.shape + (SLC_BLOCK,)).reshape(B, G, SLC_QCHUNK, n_keys)
        tq = c0 + jnp.arange(SLC_QCHUNK)
        mask = kval & (kpos <= tq[None, None, :, None])
        s = jnp.einsum('bgrtd,bgtkd->bgrtk', qc, kg).astype(jnp.float32) * scale
        p = jax.nn.softmax(jnp.where(mask[:, :, None], s, NEG), axis=-1)
        return jnp.einsum('bgrtk,bgtkd->bgrtd', p.astype(vg.dtype), vg)

    o_slc = lax.map(sel_chunk, (q_ch, i_ch, m_ch, starts))
    o_slc = jnp.moveaxis(o_slc, 0, 3).reshape(B, G, R, S, D)

    span = WINDOW + WIN_QBLOCK
    n_wb = S // WIN_QBLOCK
    pad = ((0, 0), (0, 0), (WINDOW, 0), (0, 0))
    kw = jnp.pad(k_win.transpose(0, 2, 1, 3), pad)
    vw = jnp.pad(v_win.transpose(0, 2, 1, 3), pad)
    q_wb = jnp.moveaxis(qg.reshape(B, G, R, n_wb, WIN_QBLOCK, D), 3, 0)

    def win_block(args):
        qb, i = args
        s0 = i * WIN_QBLOCK
        kk = lax.dynamic_slice_in_dim(kw, s0, span, axis=2)
        vv = lax.dynamic_slice_in_dim(vw, s0, span, axis=2)
        tq = s0 + jnp.arange(WIN_QBLOCK)
        kp = s0 - WINDOW + jnp.arange(span)
        diff = tq[:, None] - kp[None, :]
        mask = (diff >= 0) & (diff < WINDOW) & (kp >= 0)[None, :]
        s = jnp.einsum('bgrtd,bgkd->bgrtk', qb, kk).astype(jnp.float32) * scale
        p = jax.nn.softmax(jnp.where(mask, s, NEG), axis=-1)
        return jnp.einsum('bgrtk,bgkd->bgrtd', p.astype(vv.dtype), vv)

    o_win = lax.map(win_block, (q_wb, jnp.arange(n_wb)))
    o_win = jnp.moveaxis(o_win, 0, 3).reshape(B, G, R, S, D)

    g = jax.nn.sigmoid(gate_logits.reshape(B, S, G, R, 3).transpose(0, 2, 3, 1, 4))
    o = g[..., 0:1] * o_cmp + g[..., 1:2] * o_slc + g[..., 2:3] * o_win
    return o.transpose(0, 3, 1, 2, 4).reshape(B, S, NSA_WIDTH)


def hybrid_mixer(x, w_in, conv_w, conv_b, lru_w_a, lru_b_a, lru_w_x, lru_b_x, lru_lam,
                 cmp_pe_k, cmp_w1_k, cmp_w2_k, cmp_pe_v, cmp_w1_v, cmp_w2_v,
                 gn_lru, gn_nsa, w_out):
    B, S, _ = x.shape
    proj = x @ w_in
    cuts = np.cumsum(IN_SPLIT_SIZES)[:-1].tolist()
    (lru_x, lru_gate, q, k_cmp, v_cmp, k_slc, v_slc, k_win, v_win,
     gate_logits) = jnp.split(proj, cuts, axis=-1)

    h = rg_lru(causal_conv(lru_x, conv_w, conv_b), lru_w_a, lru_b_a, lru_w_x, lru_b_x, lru_lam)
    y_lru = h * jax.nn.gelu(lru_gate)

    def heads(a, n):
        return a.reshape(B, S, n, HEAD_DIM)
    y_nsa = nsa_attention(rope(heads(q, NSA_Q_HEADS)),
                          rope(heads(k_cmp, NSA_KV_HEADS)), heads(v_cmp, NSA_KV_HEADS),
                          rope(heads(k_slc, NSA_KV_HEADS)), heads(v_slc, NSA_KV_HEADS),
                          rope(heads(k_win, NSA_KV_HEADS)), heads(v_win, NSA_KV_HEADS),
                          gate_logits, cmp_pe_k, cmp_w1_k, cmp_w2_k, cmp_pe_v, cmp_w1_v, cmp_w2_v)

    y = jnp.concatenate([rms_norm(y_lru, gn_lru), rms_norm(y_nsa, gn_nsa)], axis=-1)
    return y @ w_out


def setup_inputs(seed: int = 0) -> dict:
    key = jax.random.key(seed)
    ks = jax.random.split(key, 32)
    f32 = jnp.float32
    L = DEPTH

    def nrm(k, shape, scale):
        return jax.random.normal(k, shape, f32) * scale

    u = jax.random.uniform(ks[12], (L, LRU_WIDTH), f32, 0.9, 0.999)
    a_base = u ** (1.0 / LRU_C)
    lru_lam = jnp.log(a_base) - jnp.log1p(-a_base)
    return {
        "x": nrm(ks[0], (BATCH, SEQ, D_MODEL), 1.0),
        "ffn1_w_in": nrm(ks[1], (L, D_MODEL, 2 * D_FF), D_MODEL ** -0.5),
        "ffn1_w_out": nrm(ks[2], (L, D_FF, D_MODEL), BETA * D_FF ** -0.5),
        "ln1_g": 1.0 + nrm(ks[3], (L, D_MODEL), 0.02),
        "ln1_b": nrm(ks[4], (L, D_MODEL), 0.02),
        "mix_w_in": nrm(ks[5], (L, D_MODEL, IN_COLS), D_MODEL ** -0.5),
        "conv_w": nrm(ks[6], (L, CONV_WIDTH, LRU_WIDTH), CONV_WIDTH ** -0.5),
        "conv_b": nrm(ks[7], (L, LRU_WIDTH), 0.02),
        "lru_w_a": nrm(ks[8], (L, LRU_HEADS, LRU_BLOCK, LRU_BLOCK), LRU_BLOCK ** -0.5),
        "lru_b_a": nrm(ks[9], (L, LRU_HEADS, LRU_BLOCK), 0.02),
        "lru_w_x": nrm(ks[10], (L, LRU_HEADS, LRU_BLOCK, LRU_BLOCK), LRU_BLOCK ** -0.5),
        "lru_b_x": nrm(ks[11], (L, LRU_HEADS, LRU_BLOCK), 0.02),
        "lru_lam": lru_lam,
        "cmp_pe_k": nrm(ks[13], (L, CMP_BLOCK, HEAD_DIM), 0.02),
        "cmp_w1_k": nrm(ks[14], (L, CMP_BLOCK * HEAD_DIM, CMP_HIDDEN), (CMP_BLOCK * HEAD_DIM) ** -0.5),
        "cmp_w2_k": nrm(ks[15], (L, CMP_HIDDEN, HEAD_DIM), CMP_HIDDEN ** -0.5),
        "cmp_pe_v": nrm(ks[16], (L, CMP_BLOCK, HEAD_DIM), 0.02),
        "cmp_w1_v": nrm(ks[17], (L, CMP_BLOCK * HEAD_DIM, CMP_HIDDEN), (CMP_BLOCK * HEAD_DIM) ** -0.5),
        "cmp_w2_v": nrm(ks[18], (L, CMP_HIDDEN, HEAD_DIM), CMP_HIDDEN ** -0.5),
        "gn_lru": 1.0 + nrm(ks[19], (L, LRU_WIDTH), 0.02),
        "gn_nsa": 1.0 + nrm(ks[20], (L, NSA_WIDTH), 0.02),
        "mix_w_out": nrm(ks[21], (L, MIX_WIDTH, D_MODEL), BETA * MIX_WIDTH ** -0.5),
        "ln2_g": 1.0 + nrm(ks[22], (L, D_MODEL), 0.02),
        "ln2_b": nrm(ks[23], (L, D_MODEL), 0.02),
        "ffn2_w_in": nrm(ks[24], (L, D_MODEL, 2 * D_FF), D_MODEL ** -0.5),
        "ffn2_w_out": nrm(ks[25], (L, D_FF, D_MODEL), BETA * D_FF ** -0.5),
        "ln3_g": 1.0 + nrm(ks[26], (L, D_MODEL), 0.02),
        "ln3_b": nrm(ks[27], (L, D_MODEL), 0.02),
    }


def reference(x, ffn1_w_in, ffn1_w_out, ln1_g, ln1_b, mix_w_in, conv_w, conv_b,
              lru_w_a, lru_b_a, lru_w_x, lru_b_x, lru_lam,
              cmp_pe_k, cmp_w1_k, cmp_w2_k, cmp_pe_v, cmp_w1_v, cmp_w2_v,
              gn_lru, gn_nsa, mix_w_out, ln2_g, ln2_b,
              ffn2_w_in, ffn2_w_out, ln3_g, ln3_b):
    h = x
    for l in range(DEPTH):
        h = layer_norm(ALPHA * h + 0.5 * swiglu_ffn(h, ffn1_w_in[l], ffn1_w_out[l]), ln1_g[l], ln1_b[l])
        mix = hybrid_mixer(h, mix_w_in[l], conv_w[l], conv_b[l], lru_w_a[l], lru_b_a[l],
                           lru_w_x[l], lru_b_x[l], lru_lam[l],
                           cmp_pe_k[l], cmp_w1_k[l], cmp_w2_k[l], cmp_pe_v[l], cmp_w1_v[l], cmp_w2_v[l],
                           gn_lru[l], gn_nsa[l], mix_w_out[l])
        h = layer_norm(ALPHA * h + mix, ln2_g[l], ln2_b[l])
        h = layer_norm(ALPHA * h + 0.5 * swiglu_ffn(h, ffn2_w_in[l], ffn2_w_out[l]), ln3_g[l], ln3_b[l])
    return h
```

```cpp
#include <hip/hip_runtime.h>
#include <hip/hip_cooperative_groups.h>
#include <cstdio>
#include <cstdint>
namespace cg = cooperative_groups;

#define LAS __attribute__((address_space(3)))
typedef unsigned short bf16_t;
typedef short bf16x8 __attribute__((ext_vector_type(8)));
typedef short s16x4 __attribute__((ext_vector_type(4)));
typedef float f32x4 __attribute__((ext_vector_type(4)));
typedef float f32x16 __attribute__((ext_vector_type(16)));
typedef unsigned u32x4 __attribute__((ext_vector_type(4)));
typedef unsigned u32x2 __attribute__((ext_vector_type(2)));
typedef float f32x2_t __attribute__((ext_vector_type(2)));
typedef __bf16 bf16x2_t __attribute__((ext_vector_type(2)));

constexpr int DM = 1024, NBATCH = 16, SEQ = 2048, MTOK = NBATCH * SEQ;
constexpr int DFF = 2816, NFF2 = 5632, INCOLS = 2328, NPROJ = 2560;
constexpr float ALPHA = 1.189207115002721f;
constexpr float LN_EPS = 1e-5f, RMS_EPS = 1e-6f;
constexpr float L2E = 1.4426950408889634f;

constexpr size_t MiB = 1u << 20;
constexpr size_t WS_W1A = 2 * MiB, WS_W1B = 14 * MiB, WS_WMI = 20 * MiB, WS_WMO = 26 * MiB, WS_W2A = 28 * MiB, WS_W2B = 40 * MiB;
constexpr size_t WS_WC1 = 46 * MiB;
constexpr size_t WS_ROPE = 48 * MiB;
constexpr size_t WS_CBIAS = 48 * MiB + 512 * 1024;
constexpr size_t WS_KC = 49 * MiB;
constexpr size_t WS_VCT = 49 * MiB + 512 * 1024;
constexpr size_t WS_HID = 50 * MiB;
constexpr size_t WS_KCV = 54 * MiB;
constexpr size_t WS_VT = 72 * MiB;
constexpr size_t WS_AB = 96 * MiB;
constexpr size_t WS_Y = 160 * MiB;
constexpr size_t WS_ACT = 224 * MiB;
constexpr size_t WS_END = 400 * MiB;

__device__ __forceinline__ unsigned pk2(float lo, float hi) { f32x2_t v = {lo, hi}; bf16x2_t b = __builtin_convertvector(v, bf16x2_t); return __builtin_bit_cast(unsigned, b); }
__device__ __forceinline__ float bflo(unsigned w) { return __uint_as_float(w << 16); }
__device__ __forceinline__ float bfhi(unsigned w) { return __uint_as_float(w & 0xffff0000u); }
__device__ __forceinline__ float bf2f(bf16_t h) { return __uint_as_float((unsigned)h << 16); }
__device__ __forceinline__ float fsigmoid(float x) { return __builtin_amdgcn_rcpf(1.0f + __builtin_amdgcn_exp2f(-x * L2E)); }
#define LDS_WAIT() asm volatile("s_waitcnt lgkmcnt(0)" ::: "memory")

namespace pg8 {
constexpr int BM = 256, BK = 64, HALF = 128, HTB = HALF * BK * 2, STAGE_BYTES = 8 * HTB, NXCD = 8, WGM = 8;
__host__ __device__ __forceinline__ int lds_byte(int r, int c) { const int st = (r >> 4) * 2 + (c >> 5), rr = r & 15, cc = c & 31, ob = rr * 64 + cc * 2; return st * 1024 + (ob ^ (((ob >> 9) & 1) << 5)); }
__host__ __device__ __forceinline__ void stage_rc(int b, int& R, int& C) { const int st = b / 1024, sb = b % 1024, swz = sb ^ (((sb >> 9) & 1) << 5); R = (st >> 1) * 16 + swz / 64; C = (st & 1) * 32 + (swz % 64) / 2; }
__host__ __device__ __forceinline__ int perm32(int rho) { const int n = rho >> 4, i = rho & 15; return 8 * (i >> 2) + 4 * n + (i & 3); }
struct Unit { int pm, pn; };
struct Gemm { const bf16_t* A; const bf16_t* Bt; int M, N, K, lda; };
struct StaticOrder {
    int nM, nN, nwg, G, c;
    __device__ void init(int M, int N, int G_, int c_) { nM = M / BM; nN = N / BM; nwg = nM * nN; G = G_; c = c_; }
    __device__ bool next(int i, Unit& u) const {
        const long L = (long)i * G + c; if (L >= nwg) return false;
        int wgid = (int)L; { const int q = nwg / NXCD, r = nwg % NXCD, xcd = wgid % NXCD, off = wgid / NXCD; wgid = (xcd < r ? xcd * (q + 1) : r * (q + 1) + (xcd - r) * q) + off; }
        const int nig = WGM * nN, gid = wgid / nig, fm = gid * WGM, gsz = (nM - fm) < WGM ? (nM - fm) : WGM;
        u.pm = fm + ((wgid % nig) % gsz); u.pn = (wgid % nig) / gsz; return true;
    }
};

template <class Epi, int K, int lda>
__device__ __forceinline__ void gemm_phase(LAS unsigned char* lds, const Gemm g, const StaticOrder& S, const Epi& E, const int tid) {
    const int wid = __builtin_amdgcn_readfirstlane(tid >> 6), lane = tid & 63, wr = wid >> 2, wc = wid & 3, fr = lane & 15, fq = lane >> 4;
    constexpr int nt = K / BK;
    unsigned voffA[2], voffB[2];
#pragma unroll
    for (int i = 0; i < 2; ++i) { int R, C; stage_rc(tid * 16 + i * 8192, R, C); const int Rb = Epi::PERM ? ((R & ~31) + perm32(R & 31)) : R;
        voffA[i] = (unsigned)(R * lda + C) * 2u; voffB[i] = (unsigned)(Rb * K + C) * 2u; }
    const size_t kstep = (size_t)(BK * 2);
    const size_t hstepA = (size_t)HALF * lda * 2, hstepB = (size_t)HALF * K * 2;
    const size_t tstepA = 2 * hstepA, tstepB = 2 * hstepB;
    const unsigned ldsw = (unsigned)wid * 1024u;
    const int aoff = lds_byte(wr * 64 + fr, fq * 8), boff = lds_byte(wc * 32 + fr, fq * 8);
#define PG8_SA(b, h) (((b) * 2 + (h)) * HTB)
#define PG8_SB(b, h) ((4 + (b) * 2 + (h)) * HTB)
#define PG8_STAGE(bufoff, gbase, voff) do { _Pragma("unroll") for (int _i = 0; _i < 2; ++_i) \
        __builtin_amdgcn_global_load_lds((const unsigned*)((const char*)(gbase) + (voff)[_i]), (LAS unsigned*)(lds + (bufoff) + ldsw + _i * 8192), 16, 0, 0); } while (0)
#define PG8_LDA(dst, b, h) do { _Pragma("unroll") for (int m = 0; m < 4; ++m) _Pragma("unroll") for (int k = 0; k < 2; ++k) dst[m][k] = *(const LAS bf16x8*)(lds + PG8_SA(b, h) + aoff + m * 2048 + k * 1024); } while (0)
#define PG8_LDB(dst, b, h) do { _Pragma("unroll") for (int n = 0; n < 2; ++n) _Pragma("unroll") for (int k = 0; k < 2; ++k) dst[n][k] = *(const LAS bf16x8*)(lds + PG8_SB(b, h) + boff + n * 2048 + k * 1024); } while (0)
#define PG8_MMA(ai, bj, At, Bt) do { __builtin_amdgcn_s_setprio(1); _Pragma("unroll") for (int m = 0; m < 4; ++m) _Pragma("unroll") for (int n = 0; n < 2; ++n) _Pragma("unroll") for (int k = 0; k < 2; ++k) \
        acc[ai][bj][m][n] = __builtin_amdgcn_mfma_f32_16x16x32_bf16(Bt[n][k], At[m][k], acc[ai][bj][m][n], 0, 0, 0); __builtin_amdgcn_s_setprio(0); } while (0)
#define PG8_WAIT_V(n) asm volatile("s_waitcnt vmcnt(" #n ")" ::: "memory")
#define PG8_WAIT_L(n) asm volatile("s_waitcnt lgkmcnt(" #n ")" ::: "memory")
#define PG8_BAR __builtin_amdgcn_s_barrier()
#define PG8_SCHED __builtin_amdgcn_sched_barrier(0)
    Unit cur, nxt; int ui = 0;
    if (!S.next(0, cur)) return;
    f32x4 acc[2][2][4][2];
#pragma unroll
    for (int a = 0; a < 2; ++a)
#pragma unroll
        for (int b = 0; b < 2; ++b)
#pragma unroll
            for (int m = 0; m < 4; ++m)
#pragma unroll
                for (int n = 0; n < 2; ++n) acc[a][b][m][n] = (f32x4){0.f, 0.f, 0.f, 0.f};
    bf16x8 At[4][2], B0[2][2], B1[2][2];
    const char* cA = (const char*)g.A + (size_t)cur.pm * tstepA; const char* cB = (const char*)g.Bt + (size_t)cur.pn * tstepB;
    PG8_STAGE(PG8_SB(0, 0), cB, voffB); PG8_STAGE(PG8_SB(0, 1), cB + hstepB, voffB); PG8_STAGE(PG8_SA(0, 0), cA, voffA); PG8_STAGE(PG8_SA(0, 1), cA + hstepA, voffA);
    if (wr == 1) PG8_BAR;
    PG8_WAIT_V(2); PG8_BAR;
    PG8_STAGE(PG8_SB(1, 0), cB + kstep, voffB); PG8_STAGE(PG8_SA(1, 0), cA + kstep, voffA); PG8_STAGE(PG8_SB(1, 1), cB + hstepB + kstep, voffB);
    PG8_WAIT_V(6); PG8_BAR;
    for (;;) {
        const bool has_next = S.next(ui + 1, nxt);
        const char* nA = has_next ? (const char*)g.A + (size_t)nxt.pm * tstepA : cA; const char* nB = has_next ? (const char*)g.Bt + (size_t)nxt.pn * tstepB : cB;
        for (int t = 0; t < nt; t += 2) {
            const bool last = (t == nt - 2);
            const char* a1 = cA + (size_t)(t + 1) * kstep;
            const char* a2 = last ? nA : cA + (size_t)(t + 2) * kstep; const char* b2 = last ? nB : cB + (size_t)(t + 2) * kstep;
            const char* a3 = a2 + kstep; const char* b3 = b2 + kstep;
            PG8_LDB(B0, 0, 0); PG8_LDB(B1, 0, 1); PG8_SCHED; PG8_LDA(At, 0, 0); PG8_STAGE(PG8_SA(1, 1), a1 + hstepA, voffA);
            PG8_WAIT_V(8); PG8_WAIT_L(0); PG8_BAR; PG8_MMA(0, 0, At, B0); PG8_MMA(0, 1, At, B1); PG8_BAR; PG8_SCHED;
            PG8_LDA(At, 0, 1); PG8_STAGE(PG8_SB(0, 0), b2, voffB); PG8_STAGE(PG8_SB(0, 1), b2 + hstepB, voffB); PG8_STAGE(PG8_SA(0, 0), a2, voffA);
            PG8_WAIT_V(8); PG8_WAIT_L(0); PG8_BAR; PG8_MMA(1, 0, At, B0); PG8_MMA(1, 1, At, B1); PG8_BAR; PG8_SCHED;
            PG8_LDB(B0, 1, 0); PG8_LDB(B1, 1, 1); PG8_SCHED; PG8_LDA(At, 1, 0); PG8_STAGE(PG8_SA(0, 1), a2 + hstepA, voffA);
            PG8_WAIT_V(8); PG8_WAIT_L(0); PG8_BAR; PG8_MMA(0, 0, At, B0); PG8_MMA(0, 1, At, B1); PG8_BAR; PG8_SCHED;
            PG8_LDA(At, 1, 1); PG8_STAGE(PG8_SB(1, 0), b3, voffB); PG8_STAGE(PG8_SB(1, 1), b3 + hstepB, voffB); PG8_STAGE(PG8_SA(1, 0), a3, voffA);
            PG8_WAIT_V(8); PG8_WAIT_L(0); PG8_BAR; PG8_MMA(1, 0, At, B0); PG8_MMA(1, 1, At, B1); PG8_BAR; PG8_SCHED;
        }
        if (wr == 0) PG8_BAR;
        E(acc, cur, wr, wc, fr, fq);
        if (!has_next) break;
#pragma unroll
        for (int a = 0; a < 2; ++a)
#pragma unroll
            for (int b = 0; b < 2; ++b)
#pragma unroll
                for (int m = 0; m < 4; ++m)
#pragma unroll
                    for (int n = 0; n < 2; ++n) acc[a][b][m][n] = (f32x4){0.f, 0.f, 0.f, 0.f};
        cur = nxt; cA = nA; cB = nB; ++ui;
        if (wr == 1) PG8_BAR;
    }
    PG8_WAIT_V(0);
    PG8_BAR;
#undef PG8_SA
#undef PG8_SB
#undef PG8_STAGE
#undef PG8_LDA
#undef PG8_LDB
#undef PG8_MMA
#undef PG8_WAIT_V
#undef PG8_WAIT_L
#undef PG8_BAR
#undef PG8_SCHED
}

struct EpiSwiGLU {
    static constexpr bool PERM = true;
    bf16_t* O;
    __device__ __forceinline__ void operator()(const f32x4 (&acc)[2][2][4][2], const Unit& u, int wr, int wc, int fr, int fq) const {
        const int col = u.pn * 128 + wc * 32 + 8 * fq;
#pragma unroll
        for (int ai = 0; ai < 2; ++ai)
#pragma unroll
            for (int m = 0; m < 4; ++m) {
                const int row = u.pm * BM + ai * HALF + wr * 64 + m * 16 + fr;
                float o[8];
#pragma unroll
                for (int n = 0; n < 2; ++n)
#pragma unroll
                    for (int e = 0; e < 4; ++e) { const float gv = acc[ai][0][m][n][e], uv = acc[ai][1][m][n][e]; o[4 * n + e] = gv * fsigmoid(gv) * uv; }
                u32x4 w; w.x = pk2(o[0], o[1]); w.y = pk2(o[2], o[3]); w.z = pk2(o[4], o[5]); w.w = pk2(o[6], o[7]);
                *(u32x4*)(O + (size_t)row * DFF + col) = w;
            }
    }
};
struct EpiResid {
    static constexpr bool PERM = false;
    const bf16_t* res; float* out; float alpha, scale;
    __device__ __forceinline__ void operator()(const f32x4 (&acc)[2][2][4][2], const Unit& u, int wr, int wc, int fr, int fq) const {
        const int col0 = u.pn * BM + wc * 32 + 4 * fq;
#pragma unroll
        for (int ai = 0; ai < 2; ++ai)
#pragma unroll
            for (int m = 0; m < 4; ++m) {
                const size_t off = (size_t)(u.pm * BM + ai * HALF + wr * 64 + m * 16 + fr) * DM + col0;
#pragma unroll
                for (int bj = 0; bj < 2; ++bj)
#pragma unroll
                    for (int n = 0; n < 2; ++n) {
                        const u32x2 rv = *(const u32x2*)(res + off + bj * HALF + n * 16);
                        const f32x4 a = acc[ai][bj][m][n];
                        f32x4 o; o[0] = alpha * bflo(rv.x) + scale * a[0]; o[1] = alpha * bfhi(rv.x) + scale * a[1]; o[2] = alpha * bflo(rv.y) + scale * a[2]; o[3] = alpha * bfhi(rv.y) + scale * a[3];
                        *(f32x4*)(out + off + bj * HALF + n * 16) = o;
                    }
            }
    }
};
struct EpiProj {
    static constexpr bool PERM = true;
    bf16_t* PROJ; bf16_t* KCV; bf16_t* VT; const float* ROPE;
    __device__ __forceinline__ void operator()(const f32x4 (&acc)[2][2][4][2], const Unit& u, int wr, int wc, int fr, int fq) const {
        const int pn = u.pn, hc = 32 * wc + 8 * fq;
#pragma unroll
        for (int ai = 0; ai < 2; ++ai)
#pragma unroll
            for (int m = 0; m < 4; ++m) {
                const int row = u.pm * BM + ai * HALF + wr * 64 + m * 16 + fr, b = row >> 11, t = row & 2047;
#pragma unroll
                for (int bj = 0; bj < 2; ++bj) {
                    f32x4 v0 = acc[ai][bj][m][0], v1 = acc[ai][bj][m][1];
                    const bool isq = (pn == 4 || pn == 5);
                    const bool rope = isq || (pn >= 6 && pn <= 8 && bj == 0);
                    if (rope) {
                        const int i0 = (hc & 63) >> 1;
                        const f32x4* rp = (const f32x4*)(ROPE + ((size_t)t * 32 + i0) * 2);
                        const f32x4 c0 = rp[0], c1 = rp[1];
                        float a, bb;
                        a = v0[0] * c0[0] - v0[1] * c0[1]; bb = v0[1] * c0[0] + v0[0] * c0[1]; v0[0] = a; v0[1] = bb;
                        a = v0[2] * c0[2] - v0[3] * c0[3]; bb = v0[3] * c0[2] + v0[2] * c0[3]; v0[2] = a; v0[3] = bb;
                        a = v1[0] * c1[0] - v1[1] * c1[1]; bb = v1[1] * c1[0] + v1[0] * c1[1]; v1[0] = a; v1[1] = bb;
                        a = v1[2] * c1[2] - v1[3] * c1[3]; bb = v1[3] * c1[2] + v1[2] * c1[3]; v1[2] = a; v1[3] = bb;
                        if (isq) { v0 = v0 * 0.125f; v1 = v1 * 0.125f; }
                    }
                    u32x4 w; w.x = pk2(v0[0], v0[1]); w.y = pk2(v0[2], v0[3]); w.z = pk2(v1[0], v1[1]); w.w = pk2(v1[2], v1[3]);
                    if (pn == 6) {
                        const int gg = hc >> 6, d = hc & 63;
                        *(u32x4*)(KCV + (((size_t)(bj * 32 + b * 2 + gg)) * 2048 + t) * 64 + d) = w;
                    } else if ((pn == 7 || pn == 8) && bj == 1) {
                        const int gg = hc >> 6, d = hc & 63;
                        bf16_t* vp = VT + (((size_t)((pn - 7) * 32 + b * 2 + gg)) * 64 + d) * 2048 + t;
                        vp[0 * 2048] = (bf16_t)(w.x & 0xffffu); vp[1 * 2048] = (bf16_t)(w.x >> 16); vp[2 * 2048] = (bf16_t)(w.y & 0xffffu); vp[3 * 2048] = (bf16_t)(w.y >> 16);
                        vp[4 * 2048] = (bf16_t)(w.z & 0xffffu); vp[5 * 2048] = (bf16_t)(w.z >> 16); vp[6 * 2048] = (bf16_t)(w.w & 0xffffu); vp[7 * 2048] = (bf16_t)(w.w >> 16);
                    } else {
                        *(u32x4*)(PROJ + (size_t)row * NPROJ + 256 * pn + 128 * bj + hc) = w;
                    }
                    asm volatile("" ::: "memory");
                }
            }
    }
};
struct EpiCmp {
    static constexpr bool PERM = true;
    bf16_t* O; const float* bias;
    __device__ __forceinline__ void operator()(const f32x4 (&acc)[2][2][4][2], const Unit& u, int wr, int wc, int fr, int fq) const {
#pragma unroll
        for (int ai = 0; ai < 2; ++ai)
#pragma unroll
            for (int m = 0; m < 4; ++m) {
                const int row = u.pm * BM + ai * HALF + wr * 64 + m * 16 + fr;
#pragma unroll
                for (int bj = 0; bj < 2; ++bj) {
                    const int col = 128 * bj + 32 * wc + 8 * fq;
                    const f32x4 b0 = *(const f32x4*)(bias + col), b1 = *(const f32x4*)(bias + col + 4);
                    f32x4 v0 = acc[ai][bj][m][0] + b0, v1 = acc[ai][bj][m][1] + b1;
#pragma unroll
                    for (int e = 0; e < 4; ++e) { v0[e] = v0[e] * fsigmoid(v0[e]); v1[e] = v1[e] * fsigmoid(v1[e]); }
                    u32x4 w; w.x = pk2(v0[0], v0[1]); w.y = pk2(v0[2], v0[3]); w.z = pk2(v1[0], v1[1]); w.w = pk2(v1[2], v1[3]);
                    *(u32x4*)(O + (size_t)row * 256 + col) = w;
                }
                asm volatile("" ::: "memory");
            }
    }
};
}

constexpr int NWAVES = 8, NTHREADS = 512;
constexpr int LDS_BYTES = 131072;
constexpr int NPHASE = 14;

struct Args { const float* in[28]; float* out; unsigned char* ws; int ph_lo, ph_hi; };

#define INP(k) ((const float*)F.kp[(k)])
struct Frame {
    LAS unsigned char* lds;
    int tid, lane, wave, G, bid;
    const __attribute__((address_space(4))) unsigned long long* kp;
    float* out; unsigned char* ws;
};

__device__ __forceinline__ float wave_sum(float v) {
#pragma unroll
    for (int o = 1; o < 64; o <<= 1) v += __shfl_xor(v, o);
    return v;
}
__device__ __forceinline__ int rope_d(int d) { return d < 32 ? 2 * d : 2 * (d - 32) + 1; }
__device__ __forceinline__ int map_swiglu(int n) { const int h = n >= DFF ? 1 : 0; const int c = n - h * DFF; return 256 * (c >> 7) + 128 * h + (c & 127); }
__device__ __forceinline__ int map_proj(int n) { const bool roped = (n >= 1024 && n < 1664) || (n >= 1792 && n < 1920) || (n >= 2048 && n < 2176); return roped ? ((n & ~63) + rope_d(n & 63)) : n; }

template <int MAP, bool KPERM>
__device__ __forceinline__ void tr_item(const float* W, int K, int N, bf16_t* WT, LAS float* scr, int item, int lane) {
    const int nblk = (N + 31) / 32, kb = item / nblk, nb = item % nblk, k0 = 64 * kb, n0 = 32 * nb;
    const int nsrc = n0 + (lane & 31); const bool ok = nsrc < N;
#pragma unroll 8
    for (int i = 0; i < 32; ++i) { const int kk = 2 * i + (lane >> 5); scr[kk * 33 + (lane & 31)] = ok ? W[(size_t)(k0 + kk) * N + nsrc] : 0.f; }
    LDS_WAIT(); asm volatile("" ::: "memory");
    const int c = lane & 7;
#pragma unroll
    for (int j = 0; j < 4; ++j) {
        const int n = (lane >> 3) + 8 * j;
        if (n0 + n < N) {
            const LAS float* s = scr + n;
            float e[8];
#pragma unroll
            for (int q = 0; q < 8; ++q) { const int kk = KPERM ? ((q & 1) * 32 + 4 * c + (q >> 1)) : (8 * c + q); e[q] = s[kk * 33]; }
            const int dn = MAP == 1 ? map_swiglu(n0 + n) : (MAP == 2 ? map_proj(n0 + n) : (n0 + n));
            u32x4 o; o.x = pk2(e[0], e[1]); o.y = pk2(e[2], e[3]); o.z = pk2(e[4], e[5]); o.w = pk2(e[6], e[7]);
            *(u32x4*)(WT + (size_t)dn * K + k0 + 8 * c) = o;
        }
    }
    LDS_WAIT(); asm volatile("" ::: "memory");
}

__device__ __forceinline__ void p_prologue(Frame& F) {
    LAS float* scr = (LAS float*)(F.lds + F.wave * 16384);
    const int gw = F.bid * NWAVES + F.wave, NGW = F.G * NWAVES;
    bf16_t* W1A = (bf16_t*)(F.ws + WS_W1A); bf16_t* W1B = (bf16_t*)(F.ws + WS_W1B); bf16_t* WMI = (bf16_t*)(F.ws + WS_WMI); bf16_t* WMO = (bf16_t*)(F.ws + WS_WMO);
    bf16_t* W2A = (bf16_t*)(F.ws + WS_W2A); bf16_t* W2B = (bf16_t*)(F.ws + WS_W2B); bf16_t* WC1 = (bf16_t*)(F.ws + WS_WC1);
    constexpr int I_A = (DM / 64) * (NFF2 / 32), I_B = (DFF / 64) * (DM / 32), I_MI = (DM / 64) * ((INCOLS + 31) / 32), I_MO = (DM / 64) * (DM / 32), I_C = (2048 / 64) * (256 / 32);
    constexpr int NITEMS = 2 * I_A + 2 * I_B + I_MI + I_MO + 2 * I_C;
    for (int it = gw; it < NITEMS; it += NGW) {
        int r = it;
        if (r < I_A) { tr_item<1, false>(INP(1), DM, NFF2, W1A, scr, r, F.lane); continue; } r -= I_A;
        if (r < I_A) { tr_item<1, false>(INP(24), DM, NFF2, W2A, scr, r, F.lane); continue; } r -= I_A;
        if (r < I_B) { tr_item<0, false>(INP(2), DFF, DM, W1B, scr, r, F.lane); continue; } r -= I_B;
        if (r < I_B) { tr_item<0, false>(INP(25), DFF, DM, W2B, scr, r, F.lane); continue; } r -= I_B;
        if (r < I_MI) { tr_item<2, false>(INP(5), DM, INCOLS, WMI, scr, r, F.lane); continue; } r -= I_MI;
        if (r < I_MO) { tr_item<0, false>(INP(21), DM, DM, WMO, scr, r, F.lane); continue; } r -= I_MO;
        if (r < I_C) { tr_item<0, true>(INP(14), 2048, 256, WC1, scr, r, F.lane); continue; } r -= I_C;
        tr_item<0, false>(INP(17), 2048, 256, WC1 + (size_t)256 * 2048, scr, r, F.lane);
    }
    const int gt = F.bid * NTHREADS + F.tid, NGT = F.G * NTHREADS;
    { u32x4* z = (u32x4*)(WMI + (size_t)INCOLS * DM); const int nz = (NPROJ - INCOLS) * DM / 8;
      for (int i = gt; i < nz; i += NGT) z[i] = (u32x4){0u, 0u, 0u, 0u}; }
    { float* R = (float*)(F.ws + WS_ROPE);
      for (int i = gt; i < 2048 * 32; i += NGT) {
          const int t = i >> 5, k = i & 31;
          const float inv = __builtin_amdgcn_exp2f(-(float)k * 0.41524101186092029f);
          const float ang = (float)t * inv;
          const float kk = rintf(ang * 0.15915494309189535f);
          float rr = fmaf(-kk, 6.28318548202514648f, ang); rr = fmaf(-kk, -1.74845553e-7f, rr);
          const float fr = rr * 0.15915494309189535f;
          R[2 * i] = __builtin_amdgcn_cosf(fr); R[2 * i + 1] = __builtin_amdgcn_sinf(fr);
      } }
    { const float* x = INP(0); bf16_t* XB = (bf16_t*)(F.ws + WS_AB);
      for (int m = gw; m < MTOK; m += NGW) {
          const f32x4* xr = (const f32x4*)(x + (size_t)m * DM) + F.lane; u32x2* o = (u32x2*)(XB + (size_t)m * DM) + F.lane;
#pragma unroll
          for (int j = 0; j < 4; ++j) { const f32x4 v = xr[64 * j]; o[64 * j] = (u32x2){pk2(v[0], v[1]), pk2(v[2], v[3])}; }
      } }
    if (F.bid < 2) {
        __syncthreads();
        const float* pe = INP(F.bid == 0 ? 13 : 16); const float* w1 = INP(F.bid == 0 ? 14 : 17);
        const int n = F.tid & 255, hf = F.tid >> 8; float s = 0.f;
        for (int kk = hf * 1024; kk < hf * 1024 + 1024; ++kk) s += pe[kk] * w1[(size_t)kk * 256 + n];
        LAS float* red = (LAS float*)F.lds;
        red[F.tid] = s; __syncthreads();
        if (F.tid < 256) ((float*)(F.ws + WS_CBIAS))[F.bid * 256 + F.tid] = red[F.tid] + red[F.tid + 256];
        __syncthreads();
    }
}

template <bool OUT_F32>
__device__ __forceinline__ void p_layernorm(Frame& F, float* Z, const float* g, const float* bta, bf16_t* OB) {
    const int gw = F.bid * NWAVES + F.wave, NGW = F.G * NWAVES;
    f32x4 gv[4], bv[4];
#pragma unroll
    for (int j = 0; j < 4; ++j) { gv[j] = ((const f32x4*)g)[F.lane + 64 * j]; bv[j] = ((const f32x4*)bta)[F.lane + 64 * j]; }
    for (int m = gw; m < MTOK; m += NGW) {
        f32x4* xr = (f32x4*)(Z + (size_t)m * DM) + F.lane;
        f32x4 v[4]; float s = 0.f;
#pragma unroll
        for (int j = 0; j < 4; ++j) { v[j] = xr[64 * j]; s += (v[j][0] + v[j][1]) + (v[j][2] + v[j][3]); }
        const float mean = wave_sum(s) * (1.f / DM); float s2 = 0.f;
#pragma unroll
        for (int j = 0; j < 4; ++j) { v[j] = v[j] - mean; s2 += (v[j][0] * v[j][0] + v[j][1] * v[j][1]) + (v[j][2] * v[j][2] + v[j][3] * v[j][3]); }
        const float rstd = 1.f / sqrtf(wave_sum(s2) * (1.f / DM) + LN_EPS);
#pragma unroll
        for (int j = 0; j < 4; ++j) {
            const f32x4 o = v[j] * rstd * gv[j] + bv[j];
            if (OUT_F32) xr[64 * j] = o;
            else ((u32x2*)(OB + (size_t)m * DM) + F.lane)[64 * j] = (u32x2){pk2(o[0], o[1]), pk2(o[2], o[3])};
        }
    }
}

__device__ __forceinline__ void p_rmsnorm(Frame& F, bf16_t* Y, const float* gl, const float* gn) {
    const int gw = F.bid * NWAVES + F.wave, NGW = F.G * NWAVES;
    const float* gp = (F.lane < 32) ? (gl + 16 * F.lane) : (gn + 16 * (F.lane - 32));
    float gvv[16];
#pragma unroll
    for (int e = 0; e < 16; ++e) gvv[e] = gp[e];
    for (int m = gw; m < MTOK; m += NGW) {
        u32x4* yr = (u32x4*)(Y + (size_t)m * DM + 16 * F.lane);
        const u32x4 a = yr[0], b = yr[1];
        float v[16];
        v[0] = bflo(a.x); v[1] = bfhi(a.x); v[2] = bflo(a.y); v[3] = bfhi(a.y); v[4] = bflo(a.z); v[5] = bfhi(a.z); v[6] = bflo(a.w); v[7] = bfhi(a.w);
        v[8] = bflo(b.x); v[9] = bfhi(b.x); v[10] = bflo(b.y); v[11] = bfhi(b.y); v[12] = bflo(b.z); v[13] = bfhi(b.z); v[14] = bflo(b.w); v[15] = bfhi(b.w);
        float s = 0.f;
#pragma unroll
        for (int e = 0; e < 16; ++e) s += v[e] * v[e];
#pragma unroll
        for (int o = 1; o < 32; o <<= 1) s += __shfl_xor(s, o);
        const float r = 1.f / sqrtf(s * (1.f / 512.f) + RMS_EPS);
#pragma unroll
        for (int e = 0; e < 16; ++e) v[e] = v[e] * r * gvv[e];
        u32x4 oa, ob; oa.x = pk2(v[0], v[1]); oa.y = pk2(v[2], v[3]); oa.z = pk2(v[4], v[5]); oa.w = pk2(v[6], v[7]);
        ob.x = pk2(v[8], v[9]); ob.y = pk2(v[10], v[11]); ob.z = pk2(v[12], v[13]); ob.w = pk2(v[14], v[15]);
        yr[0] = oa; yr[1] = ob;
    }
}

__device__ __forceinline__ void p_kcvc(Frame& F) {
    const int gw = F.bid * NWAVES + F.wave, NGW = F.G * NWAVES;
    const bf16_t* HID = (const bf16_t*)(F.ws + WS_HID); bf16_t* KC = (bf16_t*)(F.ws + WS_KC); bf16_t* VCT = (bf16_t*)(F.ws + WS_VCT);
    for (int it = gw; it < 2 * 4096; it += NGW) {
        const int which = it >> 12, row = it & 4095, d = F.lane;
        const float* w2 = INP(which == 0 ? 15 : 18);
        const u32x4* hr = (const u32x4*)(HID + ((size_t)which * 4096 + row) * 256);
        float s = 0.f;
        for (int j8 = 0; j8 < 32; ++j8) {
            const u32x4 h = hr[j8]; const float* wp = w2 + (size_t)(8 * j8) * 64 + d;
            s += bflo(h.x) * wp[0] + bfhi(h.x) * wp[64] + bflo(h.y) * wp[128] + bfhi(h.y) * wp[192] + bflo(h.z) * wp[256] + bfhi(h.z) * wp[320] + bflo(h.w) * wp[384] + bfhi(h.w) * wp[448];
        }
        const unsigned hb = pk2(s, 0.f) & 0xffffu;
        if (which == 0) KC[(size_t)row * 64 + rope_d(d)] = (bf16_t)hb;
        else { const int bg = row >> 7, n = row & 127; VCT[((size_t)bg * 64 + d) * 128 + n] = (bf16_t)hb; }
    }
}

constexpr int LR_XBF = 0, LR_XF = 18432, LR_AS = 34816, LR_US = 51200, LR_WT = 67584, LR_SEGP = 76800, LR_SEGH = 78848, LR_CARRY = 80896;
__device__ __forceinline__ void lru_unit(Frame& F, int u) {
    const int b = u >> 4, h = (u >> 1) & 7, jh = u & 1;
    const int tid = F.tid, lane = F.lane, w = F.wave, quad = lane >> 4, l16 = lane & 15;
    const bf16_t* PROJ = (const bf16_t*)(F.ws + WS_ACT); bf16_t* Y = (bf16_t*)(F.ws + WS_Y);
    LAS unsigned char* lds = F.lds;
    LAS float* XF = (LAS float*)(lds + LR_XF); LAS float* AS = (LAS float*)(lds + LR_AS); LAS float* US = (LAS float*)(lds + LR_US);
    LAS float* SEGP = (LAS float*)(lds + LR_SEGP); LAS float* SEGH = (LAS float*)(lds + LR_SEGH); LAS float* CARRY = (LAS float*)(lds + LR_CARRY);
    LAS bf16_t* WT = (LAS bf16_t*)(lds + LR_WT);
    __syncthreads();
    for (int idx = tid; idx < 2 * 32 * 64; idx += NTHREADS) {
        const int gsel = idx >> 11, rem = idx & 2047, i = rem >> 5, j = rem & 31;
        const float* wsrc = INP(gsel == 0 ? 8 : 10);
        const float v = wsrc[((size_t)(h * 64 + i)) * 64 + 32 * jh + j];
        WT[(gsel * 32 + j) * 72 + i] = (bf16_t)(pk2(v, 0.f) & 0xffffu);
    }
    if (tid < 32) CARRY[tid] = 0.f;
    float ba[2], bx[2], c8[2];
#pragma unroll
    for (int nt = 0; nt < 2; ++nt) { const int c = 64 * h + 32 * jh + nt * 16 + l16; ba[nt] = INP(9)[c]; bx[nt] = INP(11)[c]; c8[nt] = 8.0f * log1pf(expf(-INP(12)[c])); }
    const int ca0 = 8 * (tid & 7);
    float cw[4][8], cb[8];
#pragma unroll
    for (int e = 0; e < 8; ++e) { cb[e] = INP(7)[64 * h + ca0 + e];
#pragma unroll
        for (int jt = 0; jt < 4; ++jt) cw[jt][e] = INP(6)[jt * 512 + 64 * h + ca0 + e]; }
    __syncthreads();
    for (int tb = 0; tb < 16; ++tb) {
        const int t0 = tb * 128;
#pragma unroll
        for (int half = 0; half < 2; ++half) {
            const int tt = (tid >> 3) + 64 * half, t = t0 + tt;
            float a[8];
#pragma unroll
            for (int e = 0; e < 8; ++e) a[e] = cb[e];
#pragma unroll
            for (int jt = 0; jt < 4; ++jt) {
                const int ts = t - 3 + jt;
                if (ts >= 0) {
                    const u32x4 raw = *(const u32x4*)(PROJ + ((size_t)(b * 2048 + ts)) * NPROJ + 64 * h + ca0);
                    a[0] += cw[jt][0] * bflo(raw.x); a[1] += cw[jt][1] * bfhi(raw.x); a[2] += cw[jt][2] * bflo(raw.y); a[3] += cw[jt][3] * bfhi(raw.y);
                    a[4] += cw[jt][4] * bflo(raw.z); a[5] += cw[jt][5] * bfhi(raw.z); a[6] += cw[jt][6] * bflo(raw.w); a[7] += cw[jt][7] * bfhi(raw.w);
                }
            }
            u32x4 pw; pw.x = pk2(a[0], a[1]); pw.y = pk2(a[2], a[3]); pw.z = pk2(a[4], a[5]); pw.w = pk2(a[6], a[7]);
            *(LAS u32x4*)(lds + LR_XBF + tt * 144 + ca0 * 2) = pw;
            if ((ca0 >> 5) == jh) {
                LAS f32x4* xf = (LAS f32x4*)(XF + tt * 32 + (ca0 & 31));
                xf[0] = (f32x4){a[0], a[1], a[2], a[3]}; xf[1] = (f32x4){a[4], a[5], a[6], a[7]};
            }
        }
        __syncthreads();
        {
            bf16x8 af[2];
#pragma unroll
            for (int s = 0; s < 2; ++s) af[s] = *(const LAS bf16x8*)(lds + LR_XBF + (16 * w + l16) * 144 + (s * 32 + quad * 8) * 2);
            f32x4 acc[2][2];
#pragma unroll
            for (int gsel = 0; gsel < 2; ++gsel)
#pragma unroll
                for (int nt = 0; nt < 2; ++nt) {
                    f32x4 c = {0.f, 0.f, 0.f, 0.f};
#pragma unroll
                    for (int s = 0; s < 2; ++s) { const bf16x8 bfr = *(const LAS bf16x8*)(lds + LR_WT + ((gsel * 32 + nt * 16 + l16) * 72 + s * 32 + quad * 8) * 2); c = __builtin_amdgcn_mfma_f32_16x16x32_bf16(af[s], bfr, c, 0, 0, 0); }
                    acc[gsel][nt] = c;
                }
#pragma unroll
            for (int nt = 0; nt < 2; ++nt)
#pragma unroll
                for (int j = 0; j < 4; ++j) {
                    const int tt = 16 * w + quad * 4 + j, ch = nt * 16 + l16;
                    const float r = fsigmoid(acc[0][nt][j] + ba[nt]), ig = fsigmoid(acc[1][nt][j] + bx[nt]);
                    const float la = -c8[nt] * r, av = expf(la);
                    const float mult = (t0 + tt == 0) ? 1.0f : sqrtf(-expm1f(2.0f * la));
                    AS[tt * 32 + ch] = av; US[tt * 32 + ch] = mult * ig * XF[tt * 32 + ch];
                }
        }
        __syncthreads();
        {
            const int ch = tid & 31, seg = tid >> 5;
            float P = 1.f, Hh = 0.f;
#pragma unroll
            for (int s = 0; s < 8; ++s) { const int ix = (seg * 8 + s) * 32 + ch; const float a = AS[ix]; Hh = a * Hh + US[ix]; P *= a; }
            SEGP[seg * 32 + ch] = P; SEGH[seg * 32 + ch] = Hh;
            __syncthreads();
            float c = CARRY[ch];
            for (int s2 = 0; s2 < seg; ++s2) c = SEGP[s2 * 32 + ch] * c + SEGH[s2 * 32 + ch];
#pragma unroll
            for (int s = 0; s < 8; ++s) { const int ix = (seg * 8 + s) * 32 + ch; c = AS[ix] * c + US[ix]; US[ix] = c; }
            __syncthreads();
            if (seg == 15) CARRY[ch] = c;
        }
        {
            const int tt = tid >> 2, cc = (tid & 3) * 8; const size_t row = (size_t)(b * 2048 + t0 + tt);
            const u32x4 raw = *(const u32x4*)(PROJ + row * NPROJ + 512 + 64 * h + 32 * jh + cc);
            float gt[8] = {bflo(raw.x), bfhi(raw.x), bflo(raw.y), bfhi(raw.y), bflo(raw.z), bfhi(raw.z), bflo(raw.w), bfhi(raw.w)};
            float o[8];
#pragma unroll
            for (int e = 0; e < 8; ++e) {
                const float x = gt[e], z = 0.7978845608028654f * (x + 0.044715f * x * x * x);
                const float th = 1.0f - 2.0f * __builtin_amdgcn_rcpf(1.0f + __builtin_amdgcn_exp2f(2.0f * z * L2E));
                o[e] = US[tt * 32 + cc + e] * (0.5f * x * (1.0f + th));
            }
            u32x4 pw; pw.x = pk2(o[0], o[1]); pw.y = pk2(o[2], o[3]); pw.z = pk2(o[4], o[5]); pw.w = pk2(o[6], o[7]);
            *(u32x4*)(Y + row * DM + 64 * h + 32 * jh + cc) = pw;
        }
    }
    __syncthreads();
}

constexpr int AT_KC = 0, AT_VC = 18432, AT_K = 35328, AT_V = 44544, AT_IMPP = 53248, AT_IMP = 87040, AT_SEL = 95488;
__device__ __forceinline__ int crow(int r, int hi) { return (r & 3) + 8 * (r >> 2) + 4 * hi; }
#define MFMA32(a, b, c) __builtin_amdgcn_mfma_f32_32x32x16_bf16((a), (b), (c), 0, 0, 0)
__device__ __forceinline__ f32x16 qk_tile(const LAS unsigned char* Kl, int krow0, const bf16x8 (&qf)[4], int i, int hi) {
    f32x16 p;
#pragma unroll
    for (int r = 0; r < 16; ++r) p[r] = 0.f;
    const LAS unsigned char* kp = Kl + (krow0 + i) * 144 + hi * 16;
#pragma unroll
    for (int d0 = 0; d0 < 4; ++d0) { const bf16x8 a = *(const LAS bf16x8*)(kp + d0 * 32); p = MFMA32(a, qf[d0], p); }
    return p;
}
__device__ __forceinline__ bf16x8 pack8(const f32x16& p, int s) {
    u32x4 w; w.x = pk2(p[8 * s], p[8 * s + 1]); w.y = pk2(p[8 * s + 2], p[8 * s + 3]); w.z = pk2(p[8 * s + 4], p[8 * s + 5]); w.w = pk2(p[8 * s + 6], p[8 * s + 7]);
    return __builtin_bit_cast(bf16x8, w);
}
__device__ __forceinline__ void pv_step(f32x16 (&o)[2], const LAS unsigned char* Vl, int VS, int kbase, bf16x8 pb, int i, int hi) {
#pragma unroll
    for (int d0t = 0; d0t < 2; ++d0t) {
        const LAS unsigned char* vp = Vl + (32 * d0t + i) * VS + (kbase + 4 * hi) * 2;
        const s16x4 lo = *(const LAS s16x4*)vp, hi4 = *(const LAS s16x4*)(vp + 16);
        const bf16x8 a = __builtin_shufflevector(lo, hi4, 0, 1, 2, 3, 4, 5, 6, 7);
        o[d0t] = MFMA32(a, pb, o[d0t]);
    }
}
template <int MODE>
__device__ __forceinline__ void attn_branch(const bf16_t* Kg, const bf16_t* VTg, int kt_lo, int kt_hi, unsigned selw, unsigned unionmask, int tq,
                                            const bf16x8 (&qf)[4], LAS unsigned char* lds, int tid, int i, int hi, float gate, f32x16 (&tot)[2]) {
    f32x16 o[2];
#pragma unroll
    for (int r = 0; r < 16; ++r) { o[0][r] = 0.f; o[1][r] = 0.f; }
    float m = -INFINITY, l = 0.f;
    for (int kt = kt_lo; kt <= kt_hi; ++kt) {
        if (MODE == 1 && !((unionmask >> kt) & 1u)) continue;
        {
            const int row = tid >> 3, ch = tid & 7;
            const u32x4 kv = *(const u32x4*)(Kg + (size_t)(kt * 64 + row) * NPROJ + ch * 8);
            const u32x4 vv = *(const u32x4*)(VTg + (size_t)row * 2048 + kt * 64 + ch * 8);
            *(LAS u32x4*)(lds + AT_K + row * 144 + ch * 16) = kv;
            LAS u32x2* vd = (LAS u32x2*)(lds + AT_V + row * 136 + ch * 16); vd[0] = (u32x2){vv.x, vv.y}; vd[1] = (u32x2){vv.z, vv.w};
        }
        __syncthreads();
        f32x16 p0 = qk_tile(lds + AT_K, 0, qf, i, hi), p1 = qk_tile(lds + AT_K, 32, qf, i, hi);
        const bool selbit = (MODE == 1) ? (((selw >> kt) & 1u) != 0u) : true;
        float mx = -INFINITY;
        const int rel = tq - kt * 64 - 4 * hi;
#pragma unroll
        for (int r = 0; r < 16; ++r) {
            const int cr0 = (r & 3) + 8 * (r >> 2), cr1 = cr0 + 32;
            const bool v0 = selbit && cr0 <= rel && (MODE == 1 || cr0 >= rel - 511);
            const bool v1 = selbit && cr1 <= rel && (MODE == 1 || cr1 >= rel - 511);
            p0[r] = v0 ? p0[r] : -INFINITY; p1[r] = v1 ? p1[r] : -INFINITY;
            mx = fmaxf(mx, fmaxf(p0[r], p1[r]));
        }
        mx = fmaxf(mx, __shfl_xor(mx, 32));
        const float mnew = fmaxf(m, mx), msafe = (mnew == -INFINITY) ? 0.f : mnew;
        const float alpha = __builtin_amdgcn_exp2f((m - msafe) * L2E);
        float ls = 0.f;
#pragma unroll
        for (int r = 0; r < 16; ++r) { p0[r] = __builtin_amdgcn_exp2f((p0[r] - msafe) * L2E); p1[r] = __builtin_amdgcn_exp2f((p1[r] - msafe) * L2E); ls += p0[r] + p1[r]; }
        l = l * alpha + ls; m = mnew;
#pragma unroll
        for (int r = 0; r < 16; ++r) { o[0][r] *= alpha; o[1][r] *= alpha; }
        pv_step(o, lds + AT_V, 136, 0, pack8(p0, 0), i, hi);
        pv_step(o, lds + AT_V, 136, 16, pack8(p0, 1), i, hi);
        pv_step(o, lds + AT_V, 136, 32, pack8(p1, 0), i, hi);
        pv_step(o, lds + AT_V, 136, 48, pack8(p1, 1), i, hi);
        __syncthreads();
    }
    l += __shfl_xor(l, 32);
    const float sc = gate / l;
#pragma unroll
    for (int r = 0; r < 16; ++r) { tot[0][r] += o[0][r] * sc; tot[1][r] += o[1][r] * sc; }
}

__device__ __forceinline__ void attn_unit(Frame& F, int b, int g, int qt) {
    const int tid = F.tid, lane = F.lane, w = F.wave, i = lane & 31, hi = lane >> 5, r = w >> 1;
    const int bg = b * 2 + g, t0 = qt * 64, tl = 32 * (w & 1) + i, tq = t0 + tl;
    const size_t row = (size_t)b * 2048 + tq;
    LAS unsigned char* lds = F.lds;
    const bf16_t* PROJ = (const bf16_t*)(F.ws + WS_ACT); bf16_t* Y = (bf16_t*)(F.ws + WS_Y);
    const bf16_t* KC = (const bf16_t*)(F.ws + WS_KC); const bf16_t* VCT = (const bf16_t*)(F.ws + WS_VCT); const bf16_t* VT = (const bf16_t*)(F.ws + WS_VT);
    bf16x8 qf[4];
    { const bf16_t* qp = PROJ + row * NPROJ + 1024 + 64 * (4 * g + r) + 8 * hi;
#pragma unroll
      for (int d0 = 0; d0 < 4; ++d0) qf[d0] = *(const bf16x8*)(qp + 16 * d0); }
    float g0, g1, g2;
    { const bf16_t* gp = PROJ + row * NPROJ + 2304 + (4 * g + r) * 3; g0 = fsigmoid(bf2f(gp[0])); g1 = fsigmoid(bf2f(gp[1])); g2 = fsigmoid(bf2f(gp[2])); }
#pragma unroll
    for (int c2 = 0; c2 < 2; ++c2) {
        const int idx = tid + NTHREADS * c2;
        { const int rk = idx >> 3, ch = idx & 7; const u32x4 v = *(const u32x4*)(KC + ((size_t)bg * 128 + rk) * 64 + ch * 8); *(LAS u32x4*)(lds + AT_KC + rk * 144 + ch * 16) = v; }
        { const int rd = idx >> 4, ch = idx & 15; const u32x4 v = *(const u32x4*)(VCT + ((size_t)bg * 64 + rd) * 128 + ch * 8);
          LAS u32x2* vd = (LAS u32x2*)(lds + AT_VC + rd * 264 + ch * 16); vd[0] = (u32x2){v.x, v.y}; vd[1] = (u32x2){v.z, v.w}; }
    }
    __syncthreads();
    f32x16 tot[2];
    {
        f32x16 p[4];
#pragma unroll
        for (int kt = 0; kt < 4; ++kt) p[kt] = qk_tile(lds + AT_KC, 32 * kt, qf, i, hi);
        const int nv = tq >= 31 ? (((tq - 31) >> 4) + 1) : 0;
        const int nvl = nv - 4 * hi;
        float mx = -INFINITY;
#pragma unroll
        for (int kt = 0; kt < 4; ++kt)
#pragma unroll
            for (int rr = 0; rr < 16; ++rr) { const int nc = 32 * kt + (rr & 3) + 8 * (rr >> 2); p[kt][rr] = (nc < nvl) ? p[kt][rr] : -INFINITY; mx = fmaxf(mx, p[kt][rr]); }
        mx = fmaxf(mx, __shfl_xor(mx, 32));
        const float msafe = (mx == -INFINITY) ? 0.f : mx;
        float ls = 0.f;
#pragma unroll
        for (int kt = 0; kt < 4; ++kt)
#pragma unroll
            for (int rr = 0; rr < 16; ++rr) { p[kt][rr] = __builtin_amdgcn_exp2f((p[kt][rr] - msafe) * L2E); ls += p[kt][rr]; }
        ls += __shfl_xor(ls, 32);
        const float inv = ls > 0.f ? 1.0f / ls : 0.f;
#pragma unroll
        for (int kt = 0; kt < 4; ++kt)
#pragma unroll
            for (int rr = 0; rr < 16; ++rr) p[kt][rr] *= inv;
        float Qs[16], rl[16];
#pragma unroll
        for (int q4 = 0; q4 < 16; ++q4) {
            const int kt = q4 >> 2, g4 = q4 & 3;
            Qs[q4] = (p[kt][4 * g4] + p[kt][4 * g4 + 1]) + (p[kt][4 * g4 + 2] + p[kt][4 * g4 + 3]);
            rl[q4] = __shfl_xor(p[kt][4 * g4 + 3], 32);
        }
        LAS float* impp = (LAS float*)(lds + AT_IMPP) + (r * 64 + tl) * 33;
#pragma unroll
        for (int q4 = 0; q4 < 16; ++q4) {
            const float ex = hi ? rl[q4] : (q4 > 0 ? rl[q4 > 0 ? q4 - 1 : 0] : 0.f);
            impp[8 * (q4 >> 2) + 2 * (q4 & 3) + hi] = Qs[q4] + ex;
        }
        f32x16 o[2];
#pragma unroll
        for (int rr = 0; rr < 16; ++rr) { o[0][rr] = 0.f; o[1][rr] = 0.f; }
#pragma unroll
        for (int kt = 0; kt < 4; ++kt)
#pragma unroll
            for (int s = 0; s < 2; ++s) pv_step(o, lds + AT_VC, 264, 32 * kt + 16 * s, pack8(p[kt], s), i, hi);
#pragma unroll
        for (int rr = 0; rr < 16; ++rr) { tot[0][rr] = o[0][rr] * g0; tot[1][rr] = o[1][rr] * g0; }
    }
    __syncthreads();
    {
        LAS float* IMPP = (LAS float*)(lds + AT_IMPP); LAS float* IMP = (LAS float*)(lds + AT_IMP); LAS unsigned* SEL = (LAS unsigned*)(lds + AT_SEL);
#pragma unroll
        for (int it = 0; it < 4; ++it) {
            const int idx = tid + NTHREADS * it, tt = idx >> 5, j = idx & 31;
            IMP[tt * 33 + j] = ((IMPP[(0 * 64 + tt) * 33 + j] + IMPP[(1 * 64 + tt) * 33 + j]) + IMPP[(2 * 64 + tt) * 33 + j]) + IMPP[(3 * 64 + tt) * 33 + j];
        }
        __syncthreads();
#pragma unroll 1
        for (int it = 0; it < 4; ++it) {
            const int idx = tid + NTHREADS * it, tt = idx >> 5, j = idx & 31;
            const float v = IMP[tt * 33 + j];
            int cnt = 0;
#pragma unroll 2
            for (int j2 = 1; j2 <= qt - 2; ++j2) { const float v2 = IMP[tt * 33 + j2]; cnt += ((v2 > v) || (v2 == v && j2 < j)) ? 1 : 0; }
            const bool forced = (j == 0) || (j == qt) || (j == qt - 1);
            const bool sel = (j <= qt) && (forced || (j >= 1 && j <= qt - 2 && cnt < 13));
            const unsigned long long bal = __ballot(sel);
            if ((lane & 31) == 0) SEL[tt] = (lane < 32) ? (unsigned)bal : (unsigned)(bal >> 32);
        }
        __syncthreads();
    }
    unsigned selw, unionmask;
    { LAS unsigned* SEL = (LAS unsigned*)(lds + AT_SEL); selw = SEL[tl]; unsigned uu = SEL[lane];
#pragma unroll
      for (int o = 1; o < 64; o <<= 1) uu |= __shfl_xor(uu, o);
      unionmask = uu; }
    unionmask = __builtin_amdgcn_readfirstlane(unionmask);
    attn_branch<0>(PROJ + (size_t)b * 2048 * NPROJ + 2048 + 64 * g, VT + ((size_t)(32 + bg) * 64) * 2048, qt - 8 > 0 ? qt - 8 : 0, qt, 0u, 0u, tq, qf, lds, tid, i, hi, g2, tot);
    attn_branch<1>(PROJ + (size_t)b * 2048 * NPROJ + 1792 + 64 * g, VT + ((size_t)bg * 64) * 2048, 0, qt, selw, unionmask, tq, qf, lds, tid, i, hi, g1, tot);
    bf16_t* yp = Y + row * DM + 512 + 64 * (4 * g + r);
#pragma unroll
    for (int d0t = 0; d0t < 2; ++d0t)
#pragma unroll
        for (int g4 = 0; g4 < 4; ++g4) {
            const int d = 32 * d0t + 8 * g4 + 4 * hi;
            *(u32x2*)(yp + d) = (u32x2){pk2(tot[d0t][4 * g4], tot[d0t][4 * g4 + 1]), pk2(tot[d0t][4 * g4 + 2], tot[d0t][4 * g4 + 3])};
        }
}

__global__ void __launch_bounds__(NTHREADS, 2) hymba_fwd(Args args) {
    extern __shared__ __attribute__((aligned(16))) unsigned char lds_raw[];
    cg::grid_group grid = cg::this_grid();
    Frame F;
    F.lds = (LAS unsigned char*)lds_raw;
    F.G = gridDim.x;

    const int lo = args.ph_lo, hi = args.ph_hi;
#define RELAUNDER() do { int tv = threadIdx.x; asm volatile("" : "+v"(tv)); F.tid = tv; F.lane = tv & 63; F.wave = __builtin_amdgcn_readfirstlane(tv >> 6); \
        int bv = blockIdx.x; asm volatile("" : "+s"(bv)); F.bid = bv; \
        const __attribute__((address_space(4))) unsigned long long* kv = (const __attribute__((address_space(4))) unsigned long long*)__builtin_amdgcn_kernarg_segment_ptr(); asm volatile("" : "+s"(kv)); F.kp = kv; \
        F.ws = (unsigned char*)kv[29]; F.out = (float*)kv[28]; } while (0)
#define PH(k) if (lo <= (k) && (k) < hi)
#define SEAM(k) do { if ((k) + 1 < hi) grid.sync(); } while (0)
#define WSB(off) ((bf16_t*)(F.ws + (off)))

    PH(0) { RELAUNDER();
#ifndef NO_P0
        p_prologue(F);
#endif
        SEAM(0); }
    PH(1) { RELAUNDER();
        pg8::Gemm g{WSB(WS_AB), WSB(WS_W1A), MTOK, NFF2, DM, DM}; pg8::StaticOrder S; S.init(MTOK, NFF2, F.G, F.bid); pg8::EpiSwiGLU E{WSB(WS_ACT)};
#ifndef NO_P1
        pg8::gemm_phase<pg8::EpiSwiGLU, DM, DM>(F.lds, g, S, E, F.tid);
#endif
        SEAM(1); }
    PH(2) { RELAUNDER();
        pg8::Gemm g{WSB(WS_ACT), WSB(WS_W1B), MTOK, DM, DFF, DFF}; pg8::StaticOrder S; S.init(MTOK, DM, F.G, F.bid); pg8::EpiResid E{WSB(WS_AB), F.out, ALPHA, 0.5f};
#ifndef NO_P2
        pg8::gemm_phase<pg8::EpiResid, DFF, DFF>(F.lds, g, S, E, F.tid);
#endif
        SEAM(2); }
    PH(3) { RELAUNDER(); p_layernorm<false>(F, F.out, INP(3), INP(4), WSB(WS_AB)); SEAM(3); }
    PH(4) { RELAUNDER();
        pg8::Gemm g{WSB(WS_AB), WSB(WS_WMI), MTOK, NPROJ, DM, DM}; pg8::StaticOrder S; S.init(MTOK, NPROJ, F.G, F.bid);
        pg8::EpiProj E{WSB(WS_ACT), WSB(WS_KCV), WSB(WS_VT), (const float*)(F.ws + WS_ROPE)};
#ifndef NO_P4
        pg8::gemm_phase<pg8::EpiProj, DM, DM>(F.lds, g, S, E, F.tid);
#endif
        SEAM(4); }
    PH(5) { RELAUNDER();
        const int ncmp = (F.G > 64) ? 32 : 0;
        if (F.bid < 32) {
            const int which = F.bid >> 4;
            pg8::Gemm g{WSB(WS_KCV) + (size_t)which * 32 * 2048 * 64, WSB(WS_WC1) + (size_t)which * 256 * 2048, 4096, 256, 2048, 1024};
            pg8::StaticOrder S; S.init(4096, 256, F.G > 16 ? F.G : 16, F.bid & 15);
            pg8::EpiCmp E{WSB(WS_HID) + (size_t)which * 4096 * 256, (const float*)(F.ws + WS_CBIAS) + which * 256};
#ifndef NO_P5A
            pg8::gemm_phase<pg8::EpiCmp, 2048, 1024>(F.lds, g, S, E, F.tid);
#endif
        }
        if (F.bid >= ncmp) for (int u = F.bid - ncmp; u < 256; u += F.G - ncmp) {
#ifndef NO_P5B
            lru_unit(F, u);
#endif
        }
        SEAM(5); }
    PH(6) { RELAUNDER(); p_kcvc(F); SEAM(6); }
    PH(7) { RELAUNDER();
        for (int L = F.bid; L < 1024; L += F.G) {
            const int rd = L >> 8, c = L & 255, bg = c & 31, a = c >> 5;
            const int qt = rd == 0 ? 31 - a : (rd == 1 ? 16 + a : (rd == 2 ? 15 - a : a));
#ifndef NO_P7
            attn_unit(F, bg >> 1, bg & 1, qt);
#endif
        }
        SEAM(7); }
    PH(8) { RELAUNDER(); p_rmsnorm(F, WSB(WS_Y), INP(19), INP(20)); SEAM(8); }
    PH(9) { RELAUNDER();
        pg8::Gemm g{WSB(WS_Y), WSB(WS_WMO), MTOK, DM, DM, DM}; pg8::StaticOrder S; S.init(MTOK, DM, F.G, F.bid); pg8::EpiResid E{WSB(WS_AB), F.out, ALPHA, 1.0f};
#ifndef NO_P9
        pg8::gemm_phase<pg8::EpiResid, DM, DM>(F.lds, g, S, E, F.tid);
#endif
        SEAM(9); }
    PH(10) { RELAUNDER(); p_layernorm<false>(F, F.out, INP(22), INP(23), WSB(WS_AB)); SEAM(10); }
    PH(11) { RELAUNDER();
        pg8::Gemm g{WSB(WS_AB), WSB(WS_W2A), MTOK, NFF2, DM, DM}; pg8::StaticOrder S; S.init(MTOK, NFF2, F.G, F.bid); pg8::EpiSwiGLU E{WSB(WS_ACT)};
#ifndef NO_P1
        pg8::gemm_phase<pg8::EpiSwiGLU, DM, DM>(F.lds, g, S, E, F.tid);
#endif
        SEAM(11); }
    PH(12) { RELAUNDER();
        pg8::Gemm g{WSB(WS_ACT), WSB(WS_W2B), MTOK, DM, DFF, DFF}; pg8::StaticOrder S; S.init(MTOK, DM, F.G, F.bid); pg8::EpiResid E{WSB(WS_AB), F.out, ALPHA, 0.5f};
#ifndef NO_P2
        pg8::gemm_phase<pg8::EpiResid, DFF, DFF>(F.lds, g, S, E, F.tid);
#endif
        SEAM(12); }
    PH(13) { RELAUNDER(); p_layernorm<true>(F, F.out, INP(26), INP(27), nullptr); }
}

extern "C" void kernel_launch(void* const* d_in, const int* in_sizes, int n_in, void* d_out, int out_size, void* d_ws, size_t ws_size, hipStream_t stream) {
    static int grid = 0;
    if (grid == 0) {
        if (n_in != 28 || out_size != MTOK * DM || ws_size < WS_END) { fprintf(stderr, "kernel_launch: unexpected shapes (n_in %d out %d ws %zu)\n", n_in, out_size, ws_size); grid = -1; return; }
        int dev = 0, cus = 0, per_cu = 0;
        (void)hipGetDevice(&dev); (void)hipDeviceGetAttribute(&cus, hipDeviceAttributeMultiprocessorCount, dev);
        if (hipFuncSetAttribute((const void*)hymba_fwd, hipFuncAttributeMaxDynamicSharedMemorySize, LDS_BYTES) != hipSuccess) { fprintf(stderr, "kernel_launch: hipFuncSetAttribute failed\n"); grid = -1; return; }
        if (hipOccupancyMaxActiveBlocksPerMultiprocessor(&per_cu, (const void*)hymba_fwd, NTHREADS, LDS_BYTES) != hipSuccess || per_cu < 1) { fprintf(stderr, "kernel_launch: occupancy query failed (%d)\n", per_cu); (void)hipGetLastError(); per_cu = 1; }
        if (per_cu > 1) per_cu = 1;
        grid = cus * per_cu;
        if (grid <= 0) { grid = -1; return; }
    }
    if (grid < 0) return;
    Args a{};
    for (int i = 0; i < 28; ++i) a.in[i] = (const float*)d_in[i];
    a.out = (float*)d_out; a.ws = (unsigned char*)d_ws; a.ph_lo = 0; a.ph_hi = NPHASE;
    void* kargs[] = {&a};
    hipError_t e = hipLaunchCooperativeKernel((const void*)hymba_fwd, dim3(grid), dim3(NTHREADS), kargs, LDS_BYTES, stream);
    if (e != hipSuccess) fprintf(stderr, "kernel_launch: cooperative launch failed: %s (grid %d)\n", hipGetErrorString(e), grid);
}
```

```cpp
#include <hip/hip_runtime.h>
#include <hip/hip_cooperative_groups.h>
#include <cstdio>
#include <cstdint>
namespace cg = cooperative_groups;

#define LAS __attribute__((address_space(3)))
typedef unsigned short bf16_t;
typedef short bf16x8 __attribute__((ext_vector_type(8)));
typedef short s16x4 __attribute__((ext_vector_type(4)));
typedef float f32x4 __attribute__((ext_vector_type(4)));
typedef float f32x16 __attribute__((ext_vector_type(16)));
typedef unsigned u32x4 __attribute__((ext_vector_type(4)));
typedef unsigned u32x2 __attribute__((ext_vector_type(2)));
typedef float f32x2_t __attribute__((ext_vector_type(2)));
typedef __bf16 bf16x2_t __attribute__((ext_vector_type(2)));

constexpr int DM = 1024, NBATCH = 16, SEQ = 2048, MTOK = NBATCH * SEQ;
constexpr int DFF = 2816, NFF2 = 5632, INCOLS = 2328, NPROJ = 2560;
constexpr float ALPHA = 1.189207115002721f;
constexpr float LN_EPS = 1e-5f, RMS_EPS = 1e-6f;
constexpr float L2E = 1.4426950408889634f;

constexpr size_t MiB = 1u << 20;
constexpr size_t WS_W1A = 2 * MiB, WS_W1B = 14 * MiB, WS_WMI = 20 * MiB, WS_WMO = 26 * MiB, WS_W2A = 28 * MiB, WS_W2B = 40 * MiB;
constexpr size_t WS_WC1 = 46 * MiB;
constexpr size_t WS_ROPE = 48 * MiB;
constexpr size_t WS_CBIAS = 48 * MiB + 512 * 1024;
constexpr size_t WS_KC = 49 * MiB;
constexpr size_t WS_VCT = 49 * MiB + 512 * 1024;
constexpr size_t WS_HID = 50 * MiB;
constexpr size_t WS_KCV = 54 * MiB;
constexpr size_t WS_VT = 72 * MiB;
constexpr size_t WS_AB = 96 * MiB;
constexpr size_t WS_Y = 160 * MiB;
constexpr size_t WS_ACT = 224 * MiB;
constexpr size_t WS_END = 400 * MiB;

__device__ __forceinline__ unsigned pk2(float lo, float hi) { f32x2_t v = {lo, hi}; bf16x2_t b = __builtin_convertvector(v, bf16x2_t); return __builtin_bit_cast(unsigned, b); }
__device__ __forceinline__ float bflo(unsigned w) { return __uint_as_float(w << 16); }
__device__ __forceinline__ float bfhi(unsigned w) { return __uint_as_float(w & 0xffff0000u); }
__device__ __forceinline__ float bf2f(bf16_t h) { return __uint_as_float((unsigned)h << 16); }
__device__ __forceinline__ float fsigmoid(float x) { return __builtin_amdgcn_rcpf(1.0f + __builtin_amdgcn_exp2f(-x * L2E)); }
#define LDS_WAIT() asm volatile("s_waitcnt lgkmcnt(0)" ::: "memory")

namespace pg8 {
constexpr int BM = 256, BK = 64, HALF = 128, HTB = HALF * BK * 2, STAGE_BYTES = 8 * HTB, NXCD = 8, WGM = 8;
__host__ __device__ __forceinline__ int lds_byte(int r, int c) { const int st = (r >> 4) * 2 + (c >> 5), rr = r & 15, cc = c & 31, ob = rr * 64 + cc * 2; return st * 1024 + (ob ^ (((ob >> 9) & 1) << 5)); }
__host__ __device__ __forceinline__ void stage_rc(int b, int& R, int& C) { const int st = b / 1024, sb = b % 1024, swz = sb ^ (((sb >> 9) & 1) << 5); R = (st >> 1) * 16 + swz / 64; C = (st & 1) * 32 + (swz % 64) / 2; }
__host__ __device__ __forceinline__ int perm32(int rho) { const int n = rho >> 4, i = rho & 15; return 8 * (i >> 2) + 4 * n + (i & 3); }
struct Unit { int pm, pn; };
struct Gemm { const bf16_t* A; const bf16_t* Bt; int M, N, K, lda; };
struct StaticOrder {
    int nM, nN, nwg, G, c;
    __device__ void init(int M, int N, int G_, int c_) { nM = M / BM; nN = N / BM; nwg = nM * nN; G = G_; c = c_; }
    __device__ bool next(int i, Unit& u) const {
        const long L = (long)i * G + c; if (L >= nwg) return false;
        int wgid = (int)L; { const int q = nwg / NXCD, r = nwg % NXCD, xcd = wgid % NXCD, off = wgid / NXCD; wgid = (xcd < r ? xcd * (q + 1) : r * (q + 1) + (xcd - r) * q) + off; }
        const int nig = WGM * nN, gid = wgid / nig, fm = gid * WGM, gsz = (nM - fm) < WGM ? (nM - fm) : WGM;
        u.pm = fm + ((wgid % nig) % gsz); u.pn = (wgid % nig) / gsz; return true;
    }
};

template <class Epi, int K, int lda>
__device__ __forceinline__ void gemm_phase(LAS unsigned char* lds, const Gemm g, const StaticOrder& S, const Epi& E, const int tid) {
    const int wid = __builtin_amdgcn_readfirstlane(tid >> 6), lane = tid & 63, wr = wid >> 2, wc = wid & 3, fr = lane & 15, fq = lane >> 4;
    constexpr int nt = K / BK;
    unsigned voffA[2], voffB[2];
#pragma unroll
    for (int i = 0; i < 2; ++i) { int R, C; stage_rc(tid * 16 + i * 8192, R, C); const int Rb = Epi::PERM ? ((R & ~31) + perm32(R & 31)) : R;
        voffA[i] = (unsigned)(R * lda + C) * 2u; voffB[i] = (unsigned)(Rb * K + C) * 2u; }
    const size_t kstep = (size_t)(BK * 2);
    const size_t hstepA = (size_t)HALF * lda * 2, hstepB = (size_t)HALF * K * 2;
    const size_t tstepA = 2 * hstepA, tstepB = 2 * hstepB;
    const unsigned ldsw = (unsigned)wid * 1024u;
    const int aoff = lds_byte(wr * 64 + fr, fq * 8), boff = lds_byte(wc * 32 + fr, fq * 8);
#define PG8_SA(b, h) (((b) * 2 + (h)) * HTB)
#define PG8_SB(b, h) ((4 + (b) * 2 + (h)) * HTB)
#define PG8_STAGE(bufoff, gbase, voff) do { _Pragma("unroll") for (int _i = 0; _i < 2; ++_i) \
        __builtin_amdgcn_global_load_lds((const unsigned*)((const char*)(gbase) + (voff)[_i]), (LAS unsigned*)(lds + (bufoff) + ldsw + _i * 8192), 16, 0, 0); } while (0)
#define PG8_LDA(dst, b, h) do { _Pragma("unroll") for (int m = 0; m < 4; ++m) _Pragma("unroll") for (int k = 0; k < 2; ++k) dst[m][k] = *(const LAS bf16x8*)(lds + PG8_SA(b, h) + aoff + m * 2048 + k * 1024); } while (0)
#define PG8_LDB(dst, b, h) do { _Pragma("unroll") for (int n = 0; n < 2; ++n) _Pragma("unroll") for (int k = 0; k < 2; ++k) dst[n][k] = *(const LAS bf16x8*)(lds + PG8_SB(b, h) + boff + n * 2048 + k * 1024); } while (0)
#define PG8_MMA(ai, bj, At, Bt) do { __builtin_amdgcn_s_setprio(1); _Pragma("unroll") for (int m = 0; m < 4; ++m) _Pragma("unroll") for (int n = 0; n < 2; ++n) _Pragma("unroll") for (int k = 0; k < 2; ++k) \
        acc[ai][bj][m][n] = __builtin_amdgcn_mfma_f32_16x16x32_bf16(Bt[n][k], At[m][k], acc[ai][bj][m][n], 0, 0, 0); __builtin_amdgcn_s_setprio(0); } while (0)
#define PG8_WAIT_V(n) asm volatile("s_waitcnt vmcnt(" #n ")" ::: "memory")
#define PG8_WAIT_L(n) asm volatile("s_waitcnt lgkmcnt(" #n ")" ::: "memory")
#define PG8_BAR __builtin_amdgcn_s_barrier()
#define PG8_SCHED __builtin_amdgcn_sched_barrier(0)
    Unit cur, nxt; int ui = 0;
    if (!S.next(0, cur)) return;
    f32x4 acc[2][2][4][2];
#pragma unroll
    for (int a = 0; a < 2; ++a)
#pragma unroll
        for (int b = 0; b < 2; ++b)
#pragma unroll
            for (int m = 0; m < 4; ++m)
#pragma unroll
                for (int n = 0; n < 2; ++n) acc[a][b][m][n] = (f32x4){0.f, 0.f, 0.f, 0.f};
    bf16x8 At[4][2], B0[2][2], B1[2][2];
    const char* cA = (const char*)g.A + (size_t)cur.pm * tstepA; const char* cB = (const char*)g.Bt + (size_t)cur.pn * tstepB;
    PG8_STAGE(PG8_SB(0, 0), cB, voffB); PG8_STAGE(PG8_SB(0, 1), cB + hstepB, voffB); PG8_STAGE(PG8_SA(0, 0), cA, voffA); PG8_STAGE(PG8_SA(0, 1), cA + hstepA, voffA);
    if (wr == 1) PG8_BAR;
    PG8_WAIT_V(2); PG8_BAR;
    PG8_STAGE(PG8_SB(1, 0), cB + kstep, voffB); PG8_STAGE(PG8_SA(1, 0), cA + kstep, voffA); PG8_STAGE(PG8_SB(1, 1), cB + hstepB + kstep, voffB);
    PG8_WAIT_V(6); PG8_BAR;
    for (;;) {
        const bool has_next = S.next(ui + 1, nxt);
        const char* nA = has_next ? (const char*)g.A + (size_t)nxt.pm * tstepA : cA; const char* nB = has_next ? (const char*)g.Bt + (size_t)nxt.pn * tstepB : cB;
        for (int t = 0; t < nt; t += 2) {
            const bool last = (t == nt - 2);
            const char* a1 = cA + (size_t)(t + 1) * kstep;
            const char* a2 = last ? nA : cA + (size_t)(t + 2) * kstep; const char* b2 = last ? nB : cB + (size_t)(t + 2) * kstep;
            const char* a3 = a2 + kstep; const char* b3 = b2 + kstep;
            PG8_LDB(B0, 0, 0); PG8_LDB(B1, 0, 1); PG8_SCHED; PG8_LDA(At, 0, 0); PG8_STAGE(PG8_SA(1, 1), a1 + hstepA, voffA);
            PG8_WAIT_V(8); PG8_WAIT_L(0); PG8_BAR; PG8_MMA(0, 0, At, B0); PG8_MMA(0, 1, At, B1); PG8_BAR; PG8_SCHED;
            PG8_LDA(At, 0, 1); PG8_STAGE(PG8_SB(0, 0), b2, voffB); PG8_STAGE(PG8_SB(0, 1), b2 + hstepB, voffB); PG8_STAGE(PG8_SA(0, 0), a2, voffA);
            PG8_WAIT_V(8); PG8_WAIT_L(0); PG8_BAR; PG8_MMA(1, 0, At, B0); PG8_MMA(1, 1, At, B1); PG8_BAR; PG8_SCHED;
            PG8_LDB(B0, 1, 0); PG8_LDB(B1, 1, 1); PG8_SCHED; PG8_LDA(At, 1, 0); PG8_STAGE(PG8_SA(0, 1), a2 + hstepA, voffA);
            PG8_WAIT_V(8); PG8_WAIT_L(0); PG8_BAR; PG8_MMA(0, 0, At, B0); PG8_MMA(0, 1, At, B1); PG8_BAR; PG8_SCHED;
            PG8_LDA(At, 1, 1); PG8_STAGE(PG8_SB(1, 0), b3, voffB); PG8_STAGE(PG8_SB(1, 1), b3 + hstepB, voffB); PG8_STAGE(PG8_SA(1, 0), a3, voffA);
            PG8_WAIT_V(8); PG8_WAIT_L(0); PG8_BAR; PG8_MMA(1, 0, At, B0); PG8_MMA(1, 1, At, B1); PG8_BAR; PG8_SCHED;
        }
        if (wr == 0) PG8_BAR;
        E(acc, cur, wr, wc, fr, fq);
        if (!has_next) break;
#pragma unroll
        for (int a = 0; a < 2; ++a)
#pragma unroll
            for (int b = 0; b < 2; ++b)
#pragma unroll
                for (int m = 0; m < 4; ++m)
#pragma unroll
                    for (int n = 0; n < 2; ++n) acc[a][b][m][n] = (f32x4){0.f, 0.f, 0.f, 0.f};
        cur = nxt; cA = nA; cB = nB; ++ui;
        if (wr == 1) PG8_BAR;
    }
    PG8_WAIT_V(0);
    PG8_BAR;
#undef PG8_SA
#undef PG8_SB
#undef PG8_STAGE
#undef PG8_LDA
#undef PG8_LDB
#undef PG8_MMA
#undef PG8_WAIT_V
#undef PG8_WAIT_L
#undef PG8_BAR
#undef PG8_SCHED
}

struct EpiSwiGLU {
    static constexpr bool PERM = true;
    bf16_t* O;
    __device__ __forceinline__ void operator()(const f32x4 (&acc)[2][2][4][2], const Unit& u, int wr, int wc, int fr, int fq) const {
        const int col = u.pn * 128 + wc * 32 + 8 * fq;
#pragma unroll
        for (int ai = 0; ai < 2; ++ai)
#pragma unroll
            for (int m = 0; m < 4; ++m) {
                const int row = u.pm * BM + ai * HALF + wr * 64 + m * 16 + fr;
                float o[8];
#pragma unroll
                for (int n = 0; n < 2; ++n)
#pragma unroll
                    for (int e = 0; e < 4; ++e) { const float gv = acc[ai][0][m][n][e], uv = acc[ai][1][m][n][e]; o[4 * n + e] = gv * fsigmoid(gv) * uv; }
                u32x4 w; w.x = pk2(o[0], o[1]); w.y = pk2(o[2], o[3]); w.z = pk2(o[4], o[5]); w.w = pk2(o[6], o[7]);
                *(u32x4*)(O + (size_t)row * DFF + col) = w;
            }
    }
};
struct EpiResid {
    static constexpr bool PERM = true;
    const bf16_t* res; bf16_t* out; float alpha, scale;
    __device__ __forceinline__ void operator()(const f32x4 (&acc)[2][2][4][2], const Unit& u, int wr, int wc, int fr, int fq) const {
        const int col0 = u.pn * BM + wc * 32 + 8 * fq;
#pragma unroll
        for (int ai = 0; ai < 2; ++ai)
#pragma unroll
            for (int m = 0; m < 4; ++m) {
                const size_t off = (size_t)(u.pm * BM + ai * HALF + wr * 64 + m * 16 + fr) * DM + col0;
#pragma unroll
                for (int bj = 0; bj < 2; ++bj) {
                    const u32x4 rv = *(const u32x4*)(res + off + bj * HALF);
                    const f32x4 a0 = acc[ai][bj][m][0], a1 = acc[ai][bj][m][1];
                    u32x4 w;
                    w.x = pk2(alpha * bflo(rv.x) + scale * a0[0], alpha * bfhi(rv.x) + scale * a0[1]); w.y = pk2(alpha * bflo(rv.y) + scale * a0[2], alpha * bfhi(rv.y) + scale * a0[3]);
                    w.z = pk2(alpha * bflo(rv.z) + scale * a1[0], alpha * bfhi(rv.z) + scale * a1[1]); w.w = pk2(alpha * bflo(rv.w) + scale * a1[2], alpha * bfhi(rv.w) + scale * a1[3]);
                    *(u32x4*)(out + off + bj * HALF) = w;
                }
            }
    }
};
struct EpiProj {
    static constexpr bool PERM = true;
    bf16_t* PROJ; bf16_t* KCV; bf16_t* VT; const float* ROPE;
    __device__ __forceinline__ void operator()(const f32x4 (&acc)[2][2][4][2], const Unit& u, int wr, int wc, int fr, int fq) const {
        const int pn = u.pn, hc = 32 * wc + 8 * fq;
#pragma unroll
        for (int ai = 0; ai < 2; ++ai)
#pragma unroll
            for (int m = 0; m < 4; ++m) {
                const int row = u.pm * BM + ai * HALF + wr * 64 + m * 16 + fr, b = row >> 11, t = row & 2047;
#pragma unroll
                for (int bj = 0; bj < 2; ++bj) {
                    f32x4 v0 = acc[ai][bj][m][0], v1 = acc[ai][bj][m][1];
                    const bool isq = (pn == 4 || pn == 5);
                    const bool rope = isq || (pn >= 6 && pn <= 8 && bj == 0);
                    if (rope) {
                        const int i0 = (hc & 63) >> 1;
                        const f32x4* rp = (const f32x4*)(ROPE + ((size_t)t * 32 + i0) * 2);
                        const f32x4 c0 = rp[0], c1 = rp[1];
                        float a, bb;
                        a = v0[0] * c0[0] - v0[1] * c0[1]; bb = v0[1] * c0[0] + v0[0] * c0[1]; v0[0] = a; v0[1] = bb;
                        a = v0[2] * c0[2] - v0[3] * c0[3]; bb = v0[3] * c0[2] + v0[2] * c0[3]; v0[2] = a; v0[3] = bb;
                        a = v1[0] * c1[0] - v1[1] * c1[1]; bb = v1[1] * c1[0] + v1[0] * c1[1]; v1[0] = a; v1[1] = bb;
                        a = v1[2] * c1[2] - v1[3] * c1[3]; bb = v1[3] * c1[2] + v1[2] * c1[3]; v1[2] = a; v1[3] = bb;
                        if (isq) { v0 = v0 * 0.125f; v1 = v1 * 0.125f; }
                    }
                    u32x4 w; w.x = pk2(v0[0], v0[1]); w.y = pk2(v0[2], v0[3]); w.z = pk2(v1[0], v1[1]); w.w = pk2(v1[2], v1[3]);
                    if (pn == 6) {
                        const int gg = hc >> 6, d = hc & 63;
                        *(u32x4*)(KCV + (((size_t)(bj * 32 + b * 2 + gg)) * 2048 + t) * 64 + d) = w;
                    } else if ((pn == 7 || pn == 8) && bj == 1) {
                        const int gg = hc >> 6, d = hc & 63;
                        bf16_t* vp = VT + (((size_t)((pn - 7) * 32 + b * 2 + gg)) * 64 + d) * 2048 + t;
                        vp[0 * 2048] = (bf16_t)(w.x & 0xffffu); vp[1 * 2048] = (bf16_t)(w.x >> 16); vp[2 * 2048] = (bf16_t)(w.y & 0xffffu); vp[3 * 2048] = (bf16_t)(w.y >> 16);
                        vp[4 * 2048] = (bf16_t)(w.z & 0xffffu); vp[5 * 2048] = (bf16_t)(w.z >> 16); vp[6 * 2048] = (bf16_t)(w.w & 0xffffu); vp[7 * 2048] = (bf16_t)(w.w >> 16);
                    } else {
                        *(u32x4*)(PROJ + (size_t)row * NPROJ + 256 * pn + 128 * bj + hc) = w;
                    }
                    asm volatile("" ::: "memory");
                }
            }
    }
};
struct EpiCmp {
    static constexpr bool PERM = true;
    bf16_t* O; const float* bias;
    __device__ __forceinline__ void operator()(const f32x4 (&acc)[2][2][4][2], const Unit& u, int wr, int wc, int fr, int fq) const {
#pragma unroll
        for (int ai = 0; ai < 2; ++ai)
#pragma unroll
            for (int m = 0; m < 4; ++m) {
                const int row = u.pm * BM + ai * HALF + wr * 64 + m * 16 + fr;
#pragma unroll
                for (int bj = 0; bj < 2; ++bj) {
                    const int col = 128 * bj + 32 * wc + 8 * fq;
                    const f32x4 b0 = *(const f32x4*)(bias + col), b1 = *(const f32x4*)(bias + col + 4);
                    f32x4 v0 = acc[ai][bj][m][0] + b0, v1 = acc[ai][bj][m][1] + b1;
#pragma unroll
                    for (int e = 0; e < 4; ++e) { v0[e] = v0[e] * fsigmoid(v0[e]); v1[e] = v1[e] * fsigmoid(v1[e]); }
                    u32x4 w; w.x = pk2(v0[0], v0[1]); w.y = pk2(v0[2], v0[3]); w.z = pk2(v1[0], v1[1]); w.w = pk2(v1[2], v1[3]);
                    *(u32x4*)(O + (size_t)row * 256 + col) = w;
                }
                asm volatile("" ::: "memory");
            }
    }
};
}

constexpr int NWAVES = 8, NTHREADS = 512;
constexpr int LDS_BYTES = 131072;
constexpr int NPHASE = 14;

struct Args { const float* in[28]; float* out; unsigned char* ws; int ph_lo, ph_hi; };

#define INP(k) ((const float*)F.kp[(k)])
struct Frame {
    LAS unsigned char* lds;
    int tid, lane, wave, G, bid;
    const __attribute__((address_space(4))) unsigned long long* kp;
    float* out; unsigned char* ws;
};

__device__ __forceinline__ float wave_sum(float v) {
#pragma unroll
    for (int o = 1; o < 64; o <<= 1) v += __shfl_xor(v, o);
    return v;
}
__device__ __forceinline__ int rope_d(int d) { return d < 32 ? 2 * d : 2 * (d - 32) + 1; }
__device__ __forceinline__ int map_swiglu(int n) { const int h = n >= DFF ? 1 : 0; const int c = n - h * DFF; return 256 * (c >> 7) + 128 * h + (c & 127); }
__device__ __forceinline__ int map_proj(int n) { const bool roped = (n >= 1024 && n < 1664) || (n >= 1792 && n < 1920) || (n >= 2048 && n < 2176); return roped ? ((n & ~63) + rope_d(n & 63)) : n; }

template <int MAP, bool KPERM>
__device__ __forceinline__ void tr_item(const float* W, int K, int N, bf16_t* WT, LAS float* scr, int item, int lane) {
    const int nblk = (N + 31) / 32, kb = item / nblk, nb = item % nblk, k0 = 64 * kb, n0 = 32 * nb;
    const int n4 = (lane & 7) * 4; const bool ok = (n0 + n4) < N;
    f32x4 ld[8];
#pragma unroll
    for (int i = 0; i < 8; ++i) { const int kk = 8 * i + (lane >> 3); ld[i] = ok ? *(const f32x4*)(W + (size_t)(k0 + kk) * N + n0 + n4) : (f32x4){0.f, 0.f, 0.f, 0.f}; }
#pragma unroll
    for (int i = 0; i < 8; ++i) { const int kk = 8 * i + (lane >> 3); LAS float* d = scr + kk * 33 + n4; d[0] = ld[i][0]; d[1] = ld[i][1]; d[2] = ld[i][2]; d[3] = ld[i][3]; }
    LDS_WAIT(); asm volatile("" ::: "memory");
    const int c = lane & 7;
#pragma unroll
    for (int j = 0; j < 4; ++j) {
        const int n = (lane >> 3) + 8 * j;
        if (n0 + n < N) {
            const LAS float* s = scr + n;
            float e[8];
#pragma unroll
            for (int q = 0; q < 8; ++q) { const int kk = KPERM ? ((q & 1) * 32 + 4 * c + (q >> 1)) : (8 * c + q); e[q] = s[kk * 33]; }
            const int dn = MAP == 1 ? map_swiglu(n0 + n) : (MAP == 2 ? map_proj(n0 + n) : (n0 + n));
            u32x4 o; o.x = pk2(e[0], e[1]); o.y = pk2(e[2], e[3]); o.z = pk2(e[4], e[5]); o.w = pk2(e[6], e[7]);
            *(u32x4*)(WT + (size_t)dn * K + k0 + 8 * c) = o;
        }
    }
    LDS_WAIT(); asm volatile("" ::: "memory");
}

__device__ __forceinline__ void p_prologue(Frame& F) {
    LAS float* scr = (LAS float*)(F.lds + F.wave * 16384);
    const int gw = F.bid * NWAVES + F.wave, NGW = F.G * NWAVES;
    bf16_t* W1A = (bf16_t*)(F.ws + WS_W1A); bf16_t* W1B = (bf16_t*)(F.ws + WS_W1B); bf16_t* WMI = (bf16_t*)(F.ws + WS_WMI); bf16_t* WMO = (bf16_t*)(F.ws + WS_WMO);
    bf16_t* W2A = (bf16_t*)(F.ws + WS_W2A); bf16_t* W2B = (bf16_t*)(F.ws + WS_W2B); bf16_t* WC1 = (bf16_t*)(F.ws + WS_WC1);
    constexpr int I_A = (DM / 64) * (NFF2 / 32), I_B = (DFF / 64) * (DM / 32), I_MI = (DM / 64) * ((INCOLS + 31) / 32), I_MO = (DM / 64) * (DM / 32), I_C = (2048 / 64) * (256 / 32);
    constexpr int NITEMS = 2 * I_A + 2 * I_B + I_MI + I_MO + 2 * I_C;
    for (int it = gw; it < NITEMS; it += NGW) {
        int r = it;
        if (r < I_A) { tr_item<1, false>(INP(1), DM, NFF2, W1A, scr, r, F.lane); continue; } r -= I_A;
        if (r < I_A) { tr_item<1, false>(INP(24), DM, NFF2, W2A, scr, r, F.lane); continue; } r -= I_A;
        if (r < I_B) { tr_item<0, false>(INP(2), DFF, DM, W1B, scr, r, F.lane); continue; } r -= I_B;
        if (r < I_B) { tr_item<0, false>(INP(25), DFF, DM, W2B, scr, r, F.lane); continue; } r -= I_B;
        if (r < I_MI) { tr_item<2, false>(INP(5), DM, INCOLS, WMI, scr, r, F.lane); continue; } r -= I_MI;
        if (r < I_MO) { tr_item<0, false>(INP(21), DM, DM, WMO, scr, r, F.lane); continue; } r -= I_MO;
        if (r < I_C) { tr_item<0, true>(INP(14), 2048, 256, WC1, scr, r, F.lane); continue; } r -= I_C;
        tr_item<0, false>(INP(17), 2048, 256, WC1 + (size_t)256 * 2048, scr, r, F.lane);
    }
    const int gt = F.bid * NTHREADS + F.tid, NGT = F.G * NTHREADS;
    { u32x4* z = (u32x4*)(WMI + (size_t)INCOLS * DM); const int nz = (NPROJ - INCOLS) * DM / 8;
      for (int i = gt; i < nz; i += NGT) z[i] = (u32x4){0u, 0u, 0u, 0u}; }
    { float* R = (float*)(F.ws + WS_ROPE);
      for (int i = gt; i < 2048 * 32; i += NGT) {
          const int t = i >> 5, k = i & 31;
          const float inv = __builtin_amdgcn_exp2f(-(float)k * 0.41524101186092029f);
          const float ang = (float)t * inv;
          const float kk = rintf(ang * 0.15915494309189535f);
          float rr = fmaf(-kk, 6.28318548202514648f, ang); rr = fmaf(-kk, -1.74845553e-7f, rr);
          const float fr = rr * 0.15915494309189535f;
          R[2 * i] = __builtin_amdgcn_cosf(fr); R[2 * i + 1] = __builtin_amdgcn_sinf(fr);
      } }
    { const float* x = INP(0); bf16_t* XB = (bf16_t*)(F.ws + WS_AB);
      for (int m = 2 * gw; m < MTOK; m += 2 * NGW) {
          const f32x4* xr = (const f32x4*)(x + (size_t)m * DM) + F.lane; u32x2* o = (u32x2*)(XB + (size_t)m * DM) + F.lane;
          f32x4 v[8];
#pragma unroll
          for (int j = 0; j < 8; ++j) v[j] = xr[64 * j];
#pragma unroll
          for (int j = 0; j < 8; ++j) o[64 * j] = (u32x2){pk2(v[j][0], v[j][1]), pk2(v[j][2], v[j][3])};
      } }
    if (F.bid < 64) {
        __syncthreads();
        const int wsel = F.bid >> 5, nb0 = (F.bid & 31) * 8;
        const float* pe = INP(wsel == 0 ? 13 : 16); const float* w1 = INP(wsel == 0 ? 14 : 17);
        float acc8[8];
#pragma unroll
        for (int e = 0; e < 8; ++e) acc8[e] = 0.f;
#pragma unroll
        for (int r4 = 0; r4 < 4; ++r4) {
            const int kk = F.tid * 4 + r4; const float pv = pe[kk];
            const f32x4 a = *(const f32x4*)(w1 + (size_t)kk * 256 + nb0), b = *(const f32x4*)(w1 + (size_t)kk * 256 + nb0 + 4);
            acc8[0] += pv * a[0]; acc8[1] += pv * a[1]; acc8[2] += pv * a[2]; acc8[3] += pv * a[3]; acc8[4] += pv * b[0]; acc8[5] += pv * b[1]; acc8[6] += pv * b[2]; acc8[7] += pv * b[3];
        }
        LAS float* red = (LAS float*)F.lds;
#pragma unroll
        for (int e = 0; e < 8; ++e) { const float sv = wave_sum(acc8[e]); if (F.lane == 0) red[F.wave * 8 + e] = sv; }
        __syncthreads();
        if (F.tid < 8) { float t = 0.f;
#pragma unroll
            for (int wv = 0; wv < 8; ++wv) t += red[wv * 8 + F.tid];
            ((float*)(F.ws + WS_CBIAS))[wsel * 256 + nb0 + F.tid] = t; }
        __syncthreads();
    }
}

template <bool OUT_F32>
__device__ __forceinline__ void p_layernorm(Frame& F, const bf16_t* Z, const float* g, const float* bta, bf16_t* OB, float* OF) {
    const int gw = F.bid * NWAVES + F.wave, NGW = F.G * NWAVES;
    float gv[16], bv[16];
#pragma unroll
    for (int e = 0; e < 16; ++e) { gv[e] = g[16 * F.lane + e]; bv[e] = bta[16 * F.lane + e]; }
    for (int m = 2 * gw; m < MTOK; m += 2 * NGW) {
        u32x4 raw[2][2];
#pragma unroll
        for (int rr = 0; rr < 2; ++rr) { const u32x4* zr = (const u32x4*)(Z + (size_t)(m + rr) * DM + 16 * F.lane); raw[rr][0] = zr[0]; raw[rr][1] = zr[1]; }
#pragma unroll
        for (int rr = 0; rr < 2; ++rr) {
            float v[16];
            const u32x4 a = raw[rr][0], b = raw[rr][1];
            v[0] = bflo(a.x); v[1] = bfhi(a.x); v[2] = bflo(a.y); v[3] = bfhi(a.y); v[4] = bflo(a.z); v[5] = bfhi(a.z); v[6] = bflo(a.w); v[7] = bfhi(a.w);
            v[8] = bflo(b.x); v[9] = bfhi(b.x); v[10] = bflo(b.y); v[11] = bfhi(b.y); v[12] = bflo(b.z); v[13] = bfhi(b.z); v[14] = bflo(b.w); v[15] = bfhi(b.w);
            float s = 0.f;
#pragma unroll
            for (int e = 0; e < 16; ++e) s += v[e];
            const float mean = wave_sum(s) * (1.f / DM); float s2 = 0.f;
#pragma unroll
            for (int e = 0; e < 16; ++e) { v[e] -= mean; s2 += v[e] * v[e]; }
            const float rstd = 1.f / sqrtf(wave_sum(s2) * (1.f / DM) + LN_EPS);
#pragma unroll
            for (int e = 0; e < 16; ++e) v[e] = v[e] * rstd * gv[e] + bv[e];
            if (OUT_F32) {
                f32x4* o = (f32x4*)(OF + (size_t)(m + rr) * DM + 16 * F.lane);
                o[0] = (f32x4){v[0], v[1], v[2], v[3]}; o[1] = (f32x4){v[4], v[5], v[6], v[7]}; o[2] = (f32x4){v[8], v[9], v[10], v[11]}; o[3] = (f32x4){v[12], v[13], v[14], v[15]};
            } else {
                u32x4* o = (u32x4*)(OB + (size_t)(m + rr) * DM + 16 * F.lane);
                u32x4 oa, ob; oa.x = pk2(v[0], v[1]); oa.y = pk2(v[2], v[3]); oa.z = pk2(v[4], v[5]); oa.w = pk2(v[6], v[7]);
                ob.x = pk2(v[8], v[9]); ob.y = pk2(v[10], v[11]); ob.z = pk2(v[12], v[13]); ob.w = pk2(v[14], v[15]);
                o[0] = oa; o[1] = ob;
            }
        }
    }
}

__device__ __forceinline__ void p_rmsnorm(Frame& F, bf16_t* Y, const float* gl, const float* gn) {
    const int gw = F.bid * NWAVES + F.wave, NGW = F.G * NWAVES;
    const float* gp = (F.lane < 32) ? (gl + 16 * F.lane) : (gn + 16 * (F.lane - 32));
    float gvv[16];
#pragma unroll
    for (int e = 0; e < 16; ++e) gvv[e] = gp[e];
    for (int m = gw; m < MTOK; m += NGW) {
        u32x4* yr = (u32x4*)(Y + (size_t)m * DM + 16 * F.lane);
        const u32x4 a = yr[0], b = yr[1];
        float v[16];
        v[0] = bflo(a.x); v[1] = bfhi(a.x); v[2] = bflo(a.y); v[3] = bfhi(a.y); v[4] = bflo(a.z); v[5] = bfhi(a.z); v[6] = bflo(a.w); v[7] = bfhi(a.w);
        v[8] = bflo(b.x); v[9] = bfhi(b.x); v[10] = bflo(b.y); v[11] = bfhi(b.y); v[12] = bflo(b.z); v[13] = bfhi(b.z); v[14] = bflo(b.w); v[15] = bfhi(b.w);
        float s = 0.f;
#pragma unroll
        for (int e = 0; e < 16; ++e) s += v[e] * v[e];
#pragma unroll
        for (int o = 1; o < 32; o <<= 1) s += __shfl_xor(s, o);
        const float r = 1.f / sqrtf(s * (1.f / 512.f) + RMS_EPS);
#pragma unroll
        for (int e = 0; e < 16; ++e) v[e] = v[e] * r * gvv[e];
        u32x4 oa, ob; oa.x = pk2(v[0], v[1]); oa.y = pk2(v[2], v[3]); oa.z = pk2(v[4], v[5]); oa.w = pk2(v[6], v[7]);
        ob.x = pk2(v[8], v[9]); ob.y = pk2(v[10], v[11]); ob.z = pk2(v[12], v[13]); ob.w = pk2(v[14], v[15]);
        yr[0] = oa; yr[1] = ob;
    }
}

__device__ __forceinline__ void p_kcvc(Frame& F) {
    const int gw = F.bid * NWAVES + F.wave, NGW = F.G * NWAVES;
    const bf16_t* HID = (const bf16_t*)(F.ws + WS_HID); bf16_t* KC = (bf16_t*)(F.ws + WS_KC); bf16_t* VCT = (bf16_t*)(F.ws + WS_VCT);
    for (int it = gw; it < 2 * 4096; it += NGW) {
        const int which = it >> 12, row = it & 4095, d = F.lane;
        const float* w2 = INP(which == 0 ? 15 : 18);
        const u32x4* hr = (const u32x4*)(HID + ((size_t)which * 4096 + row) * 256);
        float s = 0.f;
        for (int j8 = 0; j8 < 32; ++j8) {
            const u32x4 h = hr[j8]; const float* wp = w2 + (size_t)(8 * j8) * 64 + d;
            s += bflo(h.x) * wp[0] + bfhi(h.x) * wp[64] + bflo(h.y) * wp[128] + bfhi(h.y) * wp[192] + bflo(h.z) * wp[256] + bfhi(h.z) * wp[320] + bflo(h.w) * wp[384] + bfhi(h.w) * wp[448];
        }
        const unsigned hb = pk2(s, 0.f) & 0xffffu;
        if (which == 0) KC[(size_t)row * 64 + rope_d(d)] = (bf16_t)hb;
        else { const int bg = row >> 7, n = row & 127; VCT[((size_t)bg * 64 + d) * 128 + n] = (bf16_t)hb; }
    }
}

constexpr int LR_XBF = 0, LR_XF = 18432, LR_AS = 34816, LR_US = 51200, LR_WT = 67584, LR_SEGP = 76800, LR_SEGH = 78848, LR_CARRY = 80896;
__device__ __forceinline__ void lru_unit(Frame& F, int u) {
    const int b = u >> 4, h = (u >> 1) & 7, jh = u & 1;
    const int tid = F.tid, lane = F.lane, w = F.wave, quad = lane >> 4, l16 = lane & 15;
    const bf16_t* PROJ = (const bf16_t*)(F.ws + WS_ACT); bf16_t* Y = (bf16_t*)(F.ws + WS_Y);
    LAS unsigned char* lds = F.lds;
    LAS float* XF = (LAS float*)(lds + LR_XF); LAS float* AS = (LAS float*)(lds + LR_AS); LAS float* US = (LAS float*)(lds + LR_US);
    LAS float* SEGP = (LAS float*)(lds + LR_SEGP); LAS float* SEGH = (LAS float*)(lds + LR_SEGH); LAS float* CARRY = (LAS float*)(lds + LR_CARRY);
    LAS bf16_t* WT = (LAS bf16_t*)(lds + LR_WT);
    __syncthreads();
    for (int idx = tid; idx < 2 * 32 * 64; idx += NTHREADS) {
        const int gsel = idx >> 11, rem = idx & 2047, i = rem >> 5, j = rem & 31;
        const float* wsrc = INP(gsel == 0 ? 8 : 10);
        const float v = wsrc[((size_t)(h * 64 + i)) * 64 + 32 * jh + j];
        WT[(gsel * 32 + j) * 72 + i] = (bf16_t)(pk2(v, 0.f) & 0xffffu);
    }
    if (tid < 32) CARRY[tid] = 0.f;
    float ba[2], bx[2], c8[2];
#pragma unroll
    for (int nt = 0; nt < 2; ++nt) { const int c = 64 * h + 32 * jh + nt * 16 + l16; ba[nt] = INP(9)[c]; bx[nt] = INP(11)[c]; c8[nt] = 8.0f * log1pf(expf(-INP(12)[c])); }
    const int ca0 = 8 * (tid & 7);
    float cw[4][8], cb[8];
#pragma unroll
    for (int e = 0; e < 8; ++e) { cb[e] = INP(7)[64 * h + ca0 + e];
#pragma unroll
        for (int jt = 0; jt < 4; ++jt) cw[jt][e] = INP(6)[jt * 512 + 64 * h + ca0 + e]; }
    __syncthreads();
    for (int tb = 0; tb < 16; ++tb) {
        const int t0 = tb * 128;
#pragma unroll
        for (int half = 0; half < 2; ++half) {
            const int tt = (tid >> 3) + 64 * half, t = t0 + tt;
            float a[8];
#pragma unroll
            for (int e = 0; e < 8; ++e) a[e] = cb[e];
#pragma unroll
            for (int jt = 0; jt < 4; ++jt) {
                const int ts = t - 3 + jt;
                if (ts >= 0) {
                    const u32x4 raw = *(const u32x4*)(PROJ + ((size_t)(b * 2048 + ts)) * NPROJ + 64 * h + ca0);
                    a[0] += cw[jt][0] * bflo(raw.x); a[1] += cw[jt][1] * bfhi(raw.x); a[2] += cw[jt][2] * bflo(raw.y); a[3] += cw[jt][3] * bfhi(raw.y);
                    a[4] += cw[jt][4] * bflo(raw.z); a[5] += cw[jt][5] * bfhi(raw.z); a[6] += cw[jt][6] * bflo(raw.w); a[7] += cw[jt][7] * bfhi(raw.w);
                }
            }
            u32x4 pw; pw.x = pk2(a[0], a[1]); pw.y = pk2(a[2], a[3]); pw.z = pk2(a[4], a[5]); pw.w = pk2(a[6], a[7]);
            *(LAS u32x4*)(lds + LR_XBF + tt * 144 + ca0 * 2) = pw;
            if ((ca0 >> 5) == jh) {
                LAS f32x4* xf = (LAS f32x4*)(XF + tt * 32 + (ca0 & 31));
                xf[0] = (f32x4){a[0], a[1], a[2], a[3]}; xf[1] = (f32x4){a[4], a[5], a[6], a[7]};
            }
        }
        __syncthreads();
        {
            bf16x8 af[2];
#pragma unroll
            for (int s = 0; s < 2; ++s) af[s] = *(const LAS bf16x8*)(lds + LR_XBF + (16 * w + l16) * 144 + (s * 32 + quad * 8) * 2);
            f32x4 acc[2][2];
#pragma unroll
            for (int gsel = 0; gsel < 2; ++gsel)
#pragma unroll
                for (int nt = 0; nt < 2; ++nt) {
                    f32x4 c = {0.f, 0.f, 0.f, 0.f};
#pragma unroll
                    for (int s = 0; s < 2; ++s) { const bf16x8 bfr = *(const LAS bf16x8*)(lds + LR_WT + ((gsel * 32 + nt * 16 + l16) * 72 + s * 32 + quad * 8) * 2); c = __builtin_amdgcn_mfma_f32_16x16x32_bf16(af[s], bfr, c, 0, 0, 0); }
                    acc[gsel][nt] = c;
                }
#pragma unroll
            for (int nt = 0; nt < 2; ++nt)
#pragma unroll
                for (int j = 0; j < 4; ++j) {
                    const int tt = 16 * w + quad * 4 + j, ch = nt * 16 + l16;
                    const float r = fsigmoid(acc[0][nt][j] + ba[nt]), ig = fsigmoid(acc[1][nt][j] + bx[nt]);
                    const float la = -c8[nt] * r, av = expf(la);
                    const float mult = (t0 + tt == 0) ? 1.0f : sqrtf(-expm1f(2.0f * la));
                    AS[tt * 32 + ch] = av; US[tt * 32 + ch] = mult * ig * XF[tt * 32 + ch];
                }
        }
        __syncthreads();
        {
            const int ch = tid & 31, seg = tid >> 5;
            float P = 1.f, Hh = 0.f;
#pragma unroll
            for (int s = 0; s < 8; ++s) { const int ix = (seg * 8 + s) * 32 + ch; const float a = AS[ix]; Hh = a * Hh + US[ix]; P *= a; }
            SEGP[seg * 32 + ch] = P; SEGH[seg * 32 + ch] = Hh;
            __syncthreads();
            float c = CARRY[ch];
            for (int s2 = 0; s2 < seg; ++s2) c = SEGP[s2 * 32 + ch] * c + SEGH[s2 * 32 + ch];
#pragma unroll
            for (int s = 0; s < 8; ++s) { const int ix = (seg * 8 + s) * 32 + ch; c = AS[ix] * c + US[ix]; US[ix] = c; }
            __syncthreads();
            if (seg == 15) CARRY[ch] = c;
        }
        {
            const int tt = tid >> 2, cc = (tid & 3) * 8; const size_t row = (size_t)(b * 2048 + t0 + tt);
            const u32x4 raw = *(const u32x4*)(PROJ + row * NPROJ + 512 + 64 * h + 32 * jh + cc);
            float gt[8] = {bflo(raw.x), bfhi(raw.x), bflo(raw.y), bfhi(raw.y), bflo(raw.z), bfhi(raw.z), bflo(raw.w), bfhi(raw.w)};
            float o[8];
#pragma unroll
            for (int e = 0; e < 8; ++e) {
                const float x = gt[e], z = 0.7978845608028654f * (x + 0.044715f * x * x * x);
                const float th = 1.0f - 2.0f * __builtin_amdgcn_rcpf(1.0f + __builtin_amdgcn_exp2f(2.0f * z * L2E));
                o[e] = US[tt * 32 + cc + e] * (0.5f * x * (1.0f + th));
            }
            u32x4 pw; pw.x = pk2(o[0], o[1]); pw.y = pk2(o[2], o[3]); pw.z = pk2(o[4], o[5]); pw.w = pk2(o[6], o[7]);
            *(u32x4*)(Y + row * DM + 64 * h + 32 * jh + cc) = pw;
        }
    }
    __syncthreads();
}

constexpr int AT_KC = 0, AT_VC = 18432, AT_K = 35328, AT_V = 44544, AT_IMPP = 53248, AT_IMP = 87040, AT_SEL = 95488;
__device__ __forceinline__ int crow(int r, int hi) { return (r & 3) + 8 * (r >> 2) + 4 * hi; }
#define MFMA32(a, b, c) __builtin_amdgcn_mfma_f32_32x32x16_bf16((a), (b), (c), 0, 0, 0)
__device__ __forceinline__ f32x16 qk_tile(const LAS unsigned char* Kl, int krow0, const bf16x8 (&qf)[4], int i, int hi) {
    f32x16 p;
#pragma unroll
    for (int r = 0; r < 16; ++r) p[r] = 0.f;
    const LAS unsigned char* kp = Kl + (krow0 + i) * 144 + hi * 16;
#pragma unroll
    for (int d0 = 0; d0 < 4; ++d0) { const bf16x8 a = *(const LAS bf16x8*)(kp + d0 * 32); p = MFMA32(a, qf[d0], p); }
    return p;
}
__device__ __forceinline__ bf16x8 pack8(const f32x16& p, int s) {
    u32x4 w; w.x = pk2(p[8 * s], p[8 * s + 1]); w.y = pk2(p[8 * s + 2], p[8 * s + 3]); w.z = pk2(p[8 * s + 4], p[8 * s + 5]); w.w = pk2(p[8 * s + 6], p[8 * s + 7]);
    return __builtin_bit_cast(bf16x8, w);
}
__device__ __forceinline__ void pv_step(f32x16 (&o)[2], const LAS unsigned char* Vl, int VS, int kbase, bf16x8 pb, int i, int hi) {
#pragma unroll
    for (int d0t = 0; d0t < 2; ++d0t) {
        const LAS unsigned char* vp = Vl + (32 * d0t + i) * VS + (kbase + 4 * hi) * 2;
        const s16x4 lo = *(const LAS s16x4*)vp, hi4 = *(const LAS s16x4*)(vp + 16);
        const bf16x8 a = __builtin_shufflevector(lo, hi4, 0, 1, 2, 3, 4, 5, 6, 7);
        o[d0t] = MFMA32(a, pb, o[d0t]);
    }
}
template <int MODE>
__device__ __forceinline__ void attn_branch(const bf16_t* Kg, const bf16_t* VTg, int kt_lo, int kt_hi, unsigned selw, unsigned unionmask, int tq,
                                            const bf16x8 (&qf)[4], LAS unsigned char* lds, int tid, int i, int hi, float gate, f32x16 (&tot)[2]) {
    f32x16 o[2];
#pragma unroll
    for (int r = 0; r < 16; ++r) { o[0][r] = 0.f; o[1][r] = 0.f; }
    float m = -INFINITY, l = 0.f;
    for (int kt = kt_lo; kt <= kt_hi; ++kt) {
        if (MODE == 1 && !((unionmask >> kt) & 1u)) continue;
        {
            const int row = tid >> 3, ch = tid & 7;
            const u32x4 kv = *(const u32x4*)(Kg + (size_t)(kt * 64 + row) * NPROJ + ch * 8);
            const u32x4 vv = *(const u32x4*)(VTg + (size_t)row * 2048 + kt * 64 + ch * 8);
            *(LAS u32x4*)(lds + AT_K + row * 144 + ch * 16) = kv;
            LAS u32x2* vd = (LAS u32x2*)(lds + AT_V + row * 136 + ch * 16); vd[0] = (u32x2){vv.x, vv.y}; vd[1] = (u32x2){vv.z, vv.w};
        }
        __syncthreads();
        f32x16 p0 = qk_tile(lds + AT_K, 0, qf, i, hi), p1 = qk_tile(lds + AT_K, 32, qf, i, hi);
        const bool selbit = (MODE == 1) ? (((selw >> kt) & 1u) != 0u) : true;
        float mx = -INFINITY;
        const int rel = tq - kt * 64 - 4 * hi;
#pragma unroll
        for (int r = 0; r < 16; ++r) {
            const int cr0 = (r & 3) + 8 * (r >> 2), cr1 = cr0 + 32;
            const bool v0 = selbit && cr0 <= rel && (MODE == 1 || cr0 >= rel - 511);
            const bool v1 = selbit && cr1 <= rel && (MODE == 1 || cr1 >= rel - 511);
            p0[r] = v0 ? p0[r] : -INFINITY; p1[r] = v1 ? p1[r] : -INFINITY;
            mx = fmaxf(mx, fmaxf(p0[r], p1[r]));
        }
        mx = fmaxf(mx, __shfl_xor(mx, 32));
        const float mnew = fmaxf(m, mx), msafe = (mnew == -INFINITY) ? 0.f : mnew;
        const float alpha = __builtin_amdgcn_exp2f((m - msafe) * L2E);
        float ls = 0.f;
#pragma unroll
        for (int r = 0; r < 16; ++r) { p0[r] = __builtin_amdgcn_exp2f((p0[r] - msafe) * L2E); p1[r] = __builtin_amdgcn_exp2f((p1[r] - msafe) * L2E); ls += p0[r] + p1[r]; }
        l = l * alpha + ls; m = mnew;
#pragma unroll
        for (int r = 0; r < 16; ++r) { o[0][r] *= alpha; o[1][r] *= alpha; }
        pv_step(o, lds + AT_V, 136, 0, pack8(p0, 0), i, hi);
        pv_step(o, lds + AT_V, 136, 16, pack8(p0, 1), i, hi);
        pv_step(o, lds + AT_V, 136, 32, pack8(p1, 0), i, hi);
        pv_step(o, lds + AT_V, 136, 48, pack8(p1, 1), i, hi);
        __syncthreads();
    }
    l += __shfl_xor(l, 32);
    const float sc = gate / l;
#pragma unroll
    for (int r = 0; r < 16; ++r) { tot[0][r] += o[0][r] * sc; tot[1][r] += o[1][r] * sc; }
}

__device__ __forceinline__ void attn_unit(Frame& F, int b, int g, int qt) {
    const int tid = F.tid, lane = F.lane, w = F.wave, i = lane & 31, hi = lane >> 5, r = w >> 1;
    const int bg = b * 2 + g, t0 = qt * 64, tl = 32 * (w & 1) + i, tq = t0 + tl;
    const size_t row = (size_t)b * 2048 + tq;
    LAS unsigned char* lds = F.lds;
    const bf16_t* PROJ = (const bf16_t*)(F.ws + WS_ACT); bf16_t* Y = (bf16_t*)(F.ws + WS_Y);
    const bf16_t* KC = (const bf16_t*)(F.ws + WS_KC); const bf16_t* VCT = (const bf16_t*)(F.ws + WS_VCT); const bf16_t* VT = (const bf16_t*)(F.ws + WS_VT);
    bf16x8 qf[4];
    { const bf16_t* qp = PROJ + row * NPROJ + 1024 + 64 * (4 * g + r) + 8 * hi;
#pragma unroll
      for (int d0 = 0; d0 < 4; ++d0) qf[d0] = *(const bf16x8*)(qp + 16 * d0); }
    float g0, g1, g2;
    { const bf16_t* gp = PROJ + row * NPROJ + 2304 + (4 * g + r) * 3; g0 = fsigmoid(bf2f(gp[0])); g1 = fsigmoid(bf2f(gp[1])); g2 = fsigmoid(bf2f(gp[2])); }
#pragma unroll
    for (int c2 = 0; c2 < 2; ++c2) {
        const int idx = tid + NTHREADS * c2;
        { const int rk = idx >> 3, ch = idx & 7; const u32x4 v = *(const u32x4*)(KC + ((size_t)bg * 128 + rk) * 64 + ch * 8); *(LAS u32x4*)(lds + AT_KC + rk * 144 + ch * 16) = v; }
        { const int rd = idx >> 4, ch = idx & 15; const u32x4 v = *(const u32x4*)(VCT + ((size_t)bg * 64 + rd) * 128 + ch * 8);
          LAS u32x2* vd = (LAS u32x2*)(lds + AT_VC + rd * 264 + ch * 16); vd[0] = (u32x2){v.x, v.y}; vd[1] = (u32x2){v.z, v.w}; }
    }
    __syncthreads();
    f32x16 tot[2];
    {
        f32x16 p[4];
#pragma unroll
        for (int kt = 0; kt < 4; ++kt) p[kt] = qk_tile(lds + AT_KC, 32 * kt, qf, i, hi);
        const int nv = tq >= 31 ? (((tq - 31) >> 4) + 1) : 0;
        const int nvl = nv - 4 * hi;
        float mx = -INFINITY;
#pragma unroll
        for (int kt = 0; kt < 4; ++kt)
#pragma unroll
            for (int rr = 0; rr < 16; ++rr) { const int nc = 32 * kt + (rr & 3) + 8 * (rr >> 2); p[kt][rr] = (nc < nvl) ? p[kt][rr] : -INFINITY; mx = fmaxf(mx, p[kt][rr]); }
        mx = fmaxf(mx, __shfl_xor(mx, 32));
        const float msafe = (mx == -INFINITY) ? 0.f : mx;
        float ls = 0.f;
#pragma unroll
        for (int kt = 0; kt < 4; ++kt)
#pragma unroll
            for (int rr = 0; rr < 16; ++rr) { p[kt][rr] = __builtin_amdgcn_exp2f((p[kt][rr] - msafe) * L2E); ls += p[kt][rr]; }
        ls += __shfl_xor(ls, 32);
        const float inv = ls > 0.f ? 1.0f / ls : 0.f;
#pragma unroll
        for (int kt = 0; kt < 4; ++kt)
#pragma unroll
            for (int rr = 0; rr < 16; ++rr) p[kt][rr] *= inv;
        float Qs[16], rl[16];
#pragma unroll
        for (int q4 = 0; q4 < 16; ++q4) {
            const int kt = q4 >> 2, g4 = q4 & 3;
            Qs[q4] = (p[kt][4 * g4] + p[kt][4 * g4 + 1]) + (p[kt][4 * g4 + 2] + p[kt][4 * g4 + 3]);
            rl[q4] = __shfl_xor(p[kt][4 * g4 + 3], 32);
        }
        LAS float* impp = (LAS float*)(lds + AT_IMPP) + (r * 64 + tl) * 33;
#pragma unroll
        for (int q4 = 0; q4 < 16; ++q4) {
            const float ex = hi ? rl[q4] : (q4 > 0 ? rl[q4 > 0 ? q4 - 1 : 0] : 0.f);
            impp[8 * (q4 >> 2) + 2 * (q4 & 3) + hi] = Qs[q4] + ex;
        }
        f32x16 o[2];
#pragma unroll
        for (int rr = 0; rr < 16; ++rr) { o[0][rr] = 0.f; o[1][rr] = 0.f; }
#pragma unroll
        for (int kt = 0; kt < 4; ++kt)
#pragma unroll
            for (int s = 0; s < 2; ++s) pv_step(o, lds + AT_VC, 264, 32 * kt + 16 * s, pack8(p[kt], s), i, hi);
#pragma unroll
        for (int rr = 0; rr < 16; ++rr) { tot[0][rr] = o[0][rr] * g0; tot[1][rr] = o[1][rr] * g0; }
    }
    __syncthreads();
    {
        LAS float* IMPP = (LAS float*)(lds + AT_IMPP); LAS float* IMP = (LAS float*)(lds + AT_IMP); LAS unsigned* SEL = (LAS unsigned*)(lds + AT_SEL);
#pragma unroll
        for (int it = 0; it < 4; ++it) {
            const int idx = tid + NTHREADS * it, tt = idx >> 5, j = idx & 31;
            IMP[tt * 33 + j] = ((IMPP[(0 * 64 + tt) * 33 + j] + IMPP[(1 * 64 + tt) * 33 + j]) + IMPP[(2 * 64 + tt) * 33 + j]) + IMPP[(3 * 64 + tt) * 33 + j];
        }
        __syncthreads();
#pragma unroll 1
        for (int it = 0; it < 4; ++it) {
            const int idx = tid + NTHREADS * it, tt = idx >> 5, j = idx & 31;
            const float v = IMP[tt * 33 + j];
            int cnt = 0;
#pragma unroll 2
            for (int j2 = 1; j2 <= qt - 2; ++j2) { const float v2 = IMP[tt * 33 + j2]; cnt += ((v2 > v) || (v2 == v && j2 < j)) ? 1 : 0; }
            const bool forced = (j == 0) || (j == qt) || (j == qt - 1);
            const bool sel = (j <= qt) && (forced || (j >= 1 && j <= qt - 2 && cnt < 13));
            const unsigned long long bal = __ballot(sel);
            if ((lane & 31) == 0) SEL[tt] = (lane < 32) ? (unsigned)bal : (unsigned)(bal >> 32);
        }
        __syncthreads();
    }
    unsigned selw, unionmask;
    { LAS unsigned* SEL = (LAS unsigned*)(lds + AT_SEL); selw = SEL[tl]; unsigned uu = SEL[lane];
#pragma unroll
      for (int o = 1; o < 64; o <<= 1) uu |= __shfl_xor(uu, o);
      unionmask = uu; }
    unionmask = __builtin_amdgcn_readfirstlane(unionmask);
    attn_branch<0>(PROJ + (size_t)b * 2048 * NPROJ + 2048 + 64 * g, VT + ((size_t)(32 + bg) * 64) * 2048, qt - 8 > 0 ? qt - 8 : 0, qt, 0u, 0u, tq, qf, lds, tid, i, hi, g2, tot);
    attn_branch<1>(PROJ + (size_t)b * 2048 * NPROJ + 1792 + 64 * g, VT + ((size_t)bg * 64) * 2048, 0, qt, selw, unionmask, tq, qf, lds, tid, i, hi, g1, tot);
    bf16_t* yp = Y + row * DM + 512 + 64 * (4 * g + r);
#pragma unroll
    for (int d0t = 0; d0t < 2; ++d0t)
#pragma unroll
        for (int g4 = 0; g4 < 4; ++g4) {
            const int d = 32 * d0t + 8 * g4 + 4 * hi;
            *(u32x2*)(yp + d) = (u32x2){pk2(tot[d0t][4 * g4], tot[d0t][4 * g4 + 1]), pk2(tot[d0t][4 * g4 + 2], tot[d0t][4 * g4 + 3])};
        }
}

__global__ void __launch_bounds__(NTHREADS, 2) hymba_fwd(Args args) {
    extern __shared__ __attribute__((aligned(16))) unsigned char lds_raw[];
    cg::grid_group grid = cg::this_grid();
    Frame F;
    F.lds = (LAS unsigned char*)lds_raw;
    F.G = gridDim.x;

    const int lo = args.ph_lo, hi = args.ph_hi;
#define RELAUNDER() do { int tv = threadIdx.x; asm volatile("" : "+v"(tv)); F.tid = tv; F.lane = tv & 63; F.wave = __builtin_amdgcn_readfirstlane(tv >> 6); \
        int bv = blockIdx.x; asm volatile("" : "+s"(bv)); F.bid = bv; \
        const __attribute__((address_space(4))) unsigned long long* kv = (const __attribute__((address_space(4))) unsigned long long*)__builtin_amdgcn_kernarg_segment_ptr(); asm volatile("" : "+s"(kv)); F.kp = kv; \
        F.ws = (unsigned char*)kv[29]; F.out = (float*)kv[28]; } while (0)
#ifndef REPMASK
#define REPMASK 0
#endif
#define PH(k) if (lo <= (k) && (k) < hi) for (int rep_ = 0; rep_ < 1 + ((REPMASK >> (k)) & 1); ++rep_)
#define SEAM(k) do { if ((k) + 1 < hi || rep_ < ((REPMASK >> (k)) & 1)) grid.sync(); } while (0)
#define WSB(off) ((bf16_t*)(F.ws + (off)))

    PH(0) { RELAUNDER();
#ifndef NO_P0
        p_prologue(F);
#endif
        SEAM(0); }
    PH(1) { RELAUNDER();
        pg8::Gemm g{WSB(WS_AB), WSB(WS_W1A), MTOK, NFF2, DM, DM}; pg8::StaticOrder S; S.init(MTOK, NFF2, F.G, F.bid); pg8::EpiSwiGLU E{WSB(WS_ACT)};
#ifndef NO_P1
        pg8::gemm_phase<pg8::EpiSwiGLU, DM, DM>(F.lds, g, S, E, F.tid);
#endif
        SEAM(1); }
    PH(2) { RELAUNDER();
        pg8::Gemm g{WSB(WS_ACT), WSB(WS_W1B), MTOK, DM, DFF, DFF}; pg8::StaticOrder S; S.init(MTOK, DM, F.G, F.bid); pg8::EpiResid E{WSB(WS_AB), WSB(WS_Y), ALPHA, 0.5f};
#ifndef NO_P2
        pg8::gemm_phase<pg8::EpiResid, DFF, DFF>(F.lds, g, S, E, F.tid);
#endif
        SEAM(2); }
    PH(3) { RELAUNDER(); p_layernorm<false>(F, WSB(WS_Y), INP(3), INP(4), WSB(WS_AB), nullptr); SEAM(3); }
    PH(4) { RELAUNDER();
        pg8::Gemm g{WSB(WS_AB), WSB(WS_WMI), MTOK, NPROJ, DM, DM}; pg8::StaticOrder S; S.init(MTOK, NPROJ, F.G, F.bid);
        pg8::EpiProj E{WSB(WS_ACT), WSB(WS_KCV), WSB(WS_VT), (const float*)(F.ws + WS_ROPE)};
#ifndef NO_P4
        pg8::gemm_phase<pg8::EpiProj, DM, DM>(F.lds, g, S, E, F.tid);
#endif
        SEAM(4); }
    PH(5) { RELAUNDER();
        const int ncmp = (F.G > 64) ? 32 : 0;
        if (F.bid < 32) {
            const int which = F.bid >> 4;
            pg8::Gemm g{WSB(WS_KCV) + (size_t)which * 32 * 2048 * 64, WSB(WS_WC1) + (size_t)which * 256 * 2048, 4096, 256, 2048, 1024};
            pg8::StaticOrder S; S.init(4096, 256, F.G > 16 ? F.G : 16, F.bid & 15);
            pg8::EpiCmp E{WSB(WS_HID) + (size_t)which * 4096 * 256, (const float*)(F.ws + WS_CBIAS) + which * 256};
#ifndef NO_P5A
            pg8::gemm_phase<pg8::EpiCmp, 2048, 1024>(F.lds, g, S, E, F.tid);
#endif
        }
        if (F.bid >= ncmp) for (int u = F.bid - ncmp; u < 256; u += F.G - ncmp) {
#ifndef NO_P5B
            lru_unit(F, u);
#endif
        }
        SEAM(5); }
    PH(6) { RELAUNDER(); p_kcvc(F); SEAM(6); }
    PH(7) { RELAUNDER();
        for (int L = F.bid; L < 1024; L += F.G) {
            const int rd = L >> 8, c = L & 255, bg = c & 31, a = c >> 5;
            const int qt = rd == 0 ? 31 - a : (rd == 1 ? 16 + a : (rd == 2 ? 15 - a : a));
#ifndef NO_P7
            attn_unit(F, bg >> 1, bg & 1, qt);
#endif
        }
        SEAM(7); }
    PH(8) { RELAUNDER(); p_rmsnorm(F, WSB(WS_Y), INP(19), INP(20)); SEAM(8); }
    PH(9) { RELAUNDER();
        pg8::Gemm g{WSB(WS_Y), WSB(WS_WMO), MTOK, DM, DM, DM}; pg8::StaticOrder S; S.init(MTOK, DM, F.G, F.bid); pg8::EpiResid E{WSB(WS_AB), WSB(WS_ACT), ALPHA, 1.0f};
#ifndef NO_P9
        pg8::gemm_phase<pg8::EpiResid, DM, DM>(F.lds, g, S, E, F.tid);
#endif
        SEAM(9); }
    PH(10) { RELAUNDER(); p_layernorm<false>(F, WSB(WS_ACT), INP(22), INP(23), WSB(WS_AB), nullptr); SEAM(10); }
    PH(11) { RELAUNDER();
        pg8::Gemm g{WSB(WS_AB), WSB(WS_W2A), MTOK, NFF2, DM, DM}; pg8::StaticOrder S; S.init(MTOK, NFF2, F.G, F.bid); pg8::EpiSwiGLU E{WSB(WS_ACT)};
#ifndef NO_P1
        pg8::gemm_phase<pg8::EpiSwiGLU, DM, DM>(F.lds, g, S, E, F.tid);
#endif
        SEAM(11); }
    PH(12) { RELAUNDER();
        pg8::Gemm g{WSB(WS_ACT), WSB(WS_W2B), MTOK, DM, DFF, DFF}; pg8::StaticOrder S; S.init(MTOK, DM, F.G, F.bid); pg8::EpiResid E{WSB(WS_AB), WSB(WS_Y), ALPHA, 0.5f};
#ifndef NO_P2
        pg8::gemm_phase<pg8::EpiResid, DFF, DFF>(F.lds, g, S, E, F.tid);
#endif
        SEAM(12); }
    PH(13) { RELAUNDER(); p_layernorm<true>(F, WSB(WS_Y), INP(26), INP(27), nullptr, F.out); }
}

extern "C" void kernel_launch(void* const* d_in, const int* in_sizes, int n_in, void* d_out, int out_size, void* d_ws, size_t ws_size, hipStream_t stream) {
    static int grid = 0;
    if (grid == 0) {
        if (n_in != 28 || out_size != MTOK * DM || ws_size < WS_END) { fprintf(stderr, "kernel_launch: unexpected shapes (n_in %d out %d ws %zu)\n", n_in, out_size, ws_size); grid = -1; return; }
        int dev = 0, cus = 0, per_cu = 0;
        (void)hipGetDevice(&dev); (void)hipDeviceGetAttribute(&cus, hipDeviceAttributeMultiprocessorCount, dev);
        if (hipFuncSetAttribute((const void*)hymba_fwd, hipFuncAttributeMaxDynamicSharedMemorySize, LDS_BYTES) != hipSuccess) { fprintf(stderr, "kernel_launch: hipFuncSetAttribute failed\n"); grid = -1; return; }
        if (hipOccupancyMaxActiveBlocksPerMultiprocessor(&per_cu, (const void*)hymba_fwd, NTHREADS, LDS_BYTES) != hipSuccess || per_cu < 1) { fprintf(stderr, "kernel_launch: occupancy query failed (%d)\n", per_cu); (void)hipGetLastError(); per_cu = 1; }
        if (per_cu > 1) per_cu = 1;
        grid = cus * per_cu;
        if (grid <= 0) { grid = -1; return; }
    }
    if (grid < 0) return;
    Args a{};
    for (int i = 0; i < 28; ++i) a.in[i] = (const float*)d_in[i];
    a.out = (float*)d_out; a.ws = (unsigned char*)d_ws; a.ph_lo = 0; a.ph_hi = NPHASE;
    void* kargs[] = {&a};
    hipError_t e = hipLaunchCooperativeKernel((const void*)hymba_fwd, dim3(grid), dim3(NTHREADS), kargs, LDS_BYTES, stream);
    if (e != hipSuccess) fprintf(stderr, "kernel_launch: cooperative launch failed: %s (grid %d)\n", hipGetErrorString(e), grid);
}
```

```cpp
#include <hip/hip_runtime.h>
#include <hip/hip_cooperative_groups.h>
#include <cstdio>
#include <cstdint>
namespace cg = cooperative_groups;

#define LAS __attribute__((address_space(3)))
typedef unsigned short bf16_t;
typedef short bf16x8 __attribute__((ext_vector_type(8)));
typedef short s16x4 __attribute__((ext_vector_type(4)));
typedef float f32x4 __attribute__((ext_vector_type(4)));
typedef float f32x16 __attribute__((ext_vector_type(16)));
typedef unsigned u32x4 __attribute__((ext_vector_type(4)));
typedef unsigned u32x2 __attribute__((ext_vector_type(2)));
typedef float f32x2_t __attribute__((ext_vector_type(2)));
typedef __bf16 bf16x2_t __attribute__((ext_vector_type(2)));

constexpr int DM = 1024, NBATCH = 16, SEQ = 2048, MTOK = NBATCH * SEQ;
constexpr int DFF = 2816, NFF2 = 5632, INCOLS = 2328, NPROJ = 2560;
constexpr float ALPHA = 1.189207115002721f;
constexpr float LN_EPS = 1e-5f, RMS_EPS = 1e-6f;
constexpr float L2E = 1.4426950408889634f;

constexpr size_t MiB = 1u << 20;
constexpr size_t WS_W1A = 2 * MiB, WS_W1B = 14 * MiB, WS_WMI = 20 * MiB, WS_WMO = 26 * MiB, WS_W2A = 28 * MiB, WS_W2B = 40 * MiB;
constexpr size_t WS_WC1 = 46 * MiB;
constexpr size_t WS_ROPE = 48 * MiB;
constexpr size_t WS_CBIAS = 48 * MiB + 512 * 1024;
constexpr size_t WS_KC = 49 * MiB;
constexpr size_t WS_VCT = 49 * MiB + 512 * 1024;
constexpr size_t WS_HID = 50 * MiB;
constexpr size_t WS_KCV = 54 * MiB;
constexpr size_t WS_VT = 72 * MiB;
constexpr size_t WS_AB = 96 * MiB;
constexpr size_t WS_Y = 160 * MiB;
constexpr size_t WS_ACT = 224 * MiB;
constexpr size_t WS_END = 400 * MiB;

__device__ __forceinline__ unsigned pk2(float lo, float hi) { f32x2_t v = {lo, hi}; bf16x2_t b = __builtin_convertvector(v, bf16x2_t); return __builtin_bit_cast(unsigned, b); }
__device__ __forceinline__ float bflo(unsigned w) { return __uint_as_float(w << 16); }
__device__ __forceinline__ float bfhi(unsigned w) { return __uint_as_float(w & 0xffff0000u); }
__device__ __forceinline__ float bf2f(bf16_t h) { return __uint_as_float((unsigned)h << 16); }
__device__ __forceinline__ float fsigmoid(float x) { return __builtin_amdgcn_rcpf(1.0f + __builtin_amdgcn_exp2f(-x * L2E)); }
#define LDS_WAIT() asm volatile("s_waitcnt lgkmcnt(0)" ::: "memory")

namespace pg8 {
constexpr int BM = 256, BK = 64, HALF = 128, HTB = HALF * BK * 2, STAGE_BYTES = 8 * HTB, NXCD = 8, WGM = 8;
__host__ __device__ __forceinline__ int lds_byte(int r, int c) { const int st = (r >> 4) * 2 + (c >> 5), rr = r & 15, cc = c & 31, ob = rr * 64 + cc * 2; return st * 1024 + (ob ^ (((ob >> 9) & 1) << 5)); }
__host__ __device__ __forceinline__ void stage_rc(int b, int& R, int& C) { const int st = b / 1024, sb = b % 1024, swz = sb ^ (((sb >> 9) & 1) << 5); R = (st >> 1) * 16 + swz / 64; C = (st & 1) * 32 + (swz % 64) / 2; }
__host__ __device__ __forceinline__ int perm32(int rho) { const int n = rho >> 4, i = rho & 15; return 8 * (i >> 2) + 4 * n + (i & 3); }
struct Unit { int pm, pn; };
struct Gemm { const bf16_t* A; const bf16_t* Bt; int M, N, K, lda; };
struct StaticOrder {
    int nM, nN, nwg, G, c;
    __device__ void init(int M, int N, int G_, int c_) { nM = M / BM; nN = N / BM; nwg = nM * nN; G = G_; c = c_; }
    __device__ bool next(int i, Unit& u) const {
        const long L = (long)i * G + c; if (L >= nwg) return false;
        int wgid = (int)L; { const int q = nwg / NXCD, r = nwg % NXCD, xcd = wgid % NXCD, off = wgid / NXCD; wgid = (xcd < r ? xcd * (q + 1) : r * (q + 1) + (xcd - r) * q) + off; }
        const int nig = WGM * nN, gid = wgid / nig, fm = gid * WGM, gsz = (nM - fm) < WGM ? (nM - fm) : WGM;
        u.pm = fm + ((wgid % nig) % gsz); u.pn = (wgid % nig) / gsz; return true;
    }
};

template <class Epi, int K, int lda>
__device__ __forceinline__ void gemm_phase(LAS unsigned char* lds, const Gemm g, const StaticOrder& S, const Epi& E, const int tid) {
    const int wid = __builtin_amdgcn_readfirstlane(tid >> 6), lane = tid & 63, wr = wid >> 2, wc = wid & 3, fr = lane & 15, fq = lane >> 4;
    constexpr int nt = K / BK;
    unsigned voffA[2], voffB[2];
#pragma unroll
    for (int i = 0; i < 2; ++i) { int R, C; stage_rc(tid * 16 + i * 8192, R, C); const int Rb = Epi::PERM ? ((R & ~31) + perm32(R & 31)) : R;
        voffA[i] = (unsigned)(R * lda + C) * 2u; voffB[i] = (unsigned)(Rb * K + C) * 2u; }
    const size_t kstep = (size_t)(BK * 2);
    const size_t hstepA = (size_t)HALF * lda * 2, hstepB = (size_t)HALF * K * 2;
    const size_t tstepA = 2 * hstepA, tstepB = 2 * hstepB;
    const unsigned ldsw = (unsigned)wid * 1024u;
    const int aoff = lds_byte(wr * 64 + fr, fq * 8), boff = lds_byte(wc * 32 + fr, fq * 8);
#define PG8_SA(b, h) (((b) * 2 + (h)) * HTB)
#define PG8_SB(b, h) ((4 + (b) * 2 + (h)) * HTB)
#define PG8_STAGE(bufoff, gbase, voff) do { _Pragma("unroll") for (int _i = 0; _i < 2; ++_i) \
        __builtin_amdgcn_global_load_lds((const unsigned*)((const char*)(gbase) + (voff)[_i]), (LAS unsigned*)(lds + (bufoff) + ldsw + _i * 8192), 16, 0, 0); } while (0)
#define PG8_LDA(dst, b, h) do { _Pragma("unroll") for (int m = 0; m < 4; ++m) _Pragma("unroll") for (int k = 0; k < 2; ++k) dst[m][k] = *(const LAS bf16x8*)(lds + PG8_SA(b, h) + aoff + m * 2048 + k * 1024); } while (0)
#define PG8_LDB(dst, b, h) do { _Pragma("unroll") for (int n = 0; n < 2; ++n) _Pragma("unroll") for (int k = 0; k < 2; ++k) dst[n][k] = *(const LAS bf16x8*)(lds + PG8_SB(b, h) + boff + n * 2048 + k * 1024); } while (0)
#define PG8_MMA(ai, bj, At, Bt) do { __builtin_amdgcn_s_setprio(1); _Pragma("unroll") for (int m = 0; m < 4; ++m) _Pragma("unroll") for (int n = 0; n < 2; ++n) _Pragma("unroll") for (int k = 0; k < 2; ++k) \
        acc[ai][bj][m][n] = __builtin_amdgcn_mfma_f32_16x16x32_bf16(Bt[n][k], At[m][k], acc[ai][bj][m][n], 0, 0, 0); __builtin_amdgcn_s_setprio(0); } while (0)
#define PG8_WAIT_V(n) asm volatile("s_waitcnt vmcnt(" #n ")" ::: "memory")
#define PG8_WAIT_L(n) asm volatile("s_waitcnt lgkmcnt(" #n ")" ::: "memory")
#define PG8_BAR __builtin_amdgcn_s_barrier()
#define PG8_SCHED __builtin_amdgcn_sched_barrier(0)
    Unit cur, nxt; int ui = 0;
    if (!S.next(0, cur)) return;
    f32x4 acc[2][2][4][2];
#pragma unroll
    for (int a = 0; a < 2; ++a)
#pragma unroll
        for (int b = 0; b < 2; ++b)
#pragma unroll
            for (int m = 0; m < 4; ++m)
#pragma unroll
                for (int n = 0; n < 2; ++n) acc[a][b][m][n] = (f32x4){0.f, 0.f, 0.f, 0.f};
    bf16x8 At[4][2], B0[2][2], B1[2][2];
    const char* cA = (const char*)g.A + (size_t)cur.pm * tstepA; const char* cB = (const char*)g.Bt + (size_t)cur.pn * tstepB;
    PG8_STAGE(PG8_SB(0, 0), cB, voffB); PG8_STAGE(PG8_SB(0, 1), cB + hstepB, voffB); PG8_STAGE(PG8_SA(0, 0), cA, voffA); PG8_STAGE(PG8_SA(0, 1), cA + hstepA, voffA);
    if (wr == 1) PG8_BAR;
    PG8_WAIT_V(2); PG8_BAR;
    PG8_STAGE(PG8_SB(1, 0), cB + kstep, voffB); PG8_STAGE(PG8_SA(1, 0), cA + kstep, voffA); PG8_STAGE(PG8_SB(1, 1), cB + hstepB + kstep, voffB);
    PG8_WAIT_V(6); PG8_BAR;
    for (;;) {
        const bool has_next = S.next(ui + 1, nxt);
        const char* nA = has_next ? (const char*)g.A + (size_t)nxt.pm * tstepA : cA; const char* nB = has_next ? (const char*)g.Bt + (size_t)nxt.pn * tstepB : cB;
        for (int t = 0; t < nt; t += 2) {
            const bool last = (t == nt - 2);
            const char* a1 = cA + (size_t)(t + 1) * kstep;
            const char* a2 = last ? nA : cA + (size_t)(t + 2) * kstep; const char* b2 = last ? nB : cB + (size_t)(t + 2) * kstep;
            const char* a3 = a2 + kstep; const char* b3 = b2 + kstep;
            PG8_LDB(B0, 0, 0); PG8_LDB(B1, 0, 1); PG8_SCHED; PG8_LDA(At, 0, 0); PG8_STAGE(PG8_SA(1, 1), a1 + hstepA, voffA);
            PG8_WAIT_V(8); PG8_WAIT_L(0); PG8_BAR; PG8_MMA(0, 0, At, B0); PG8_MMA(0, 1, At, B1); PG8_BAR; PG8_SCHED;
            PG8_LDA(At, 0, 1); PG8_STAGE(PG8_SB(0, 0), b2, voffB); PG8_STAGE(PG8_SB(0, 1), b2 + hstepB, voffB); PG8_STAGE(PG8_SA(0, 0), a2, voffA);
            PG8_WAIT_V(8); PG8_WAIT_L(0); PG8_BAR; PG8_MMA(1, 0, At, B0); PG8_MMA(1, 1, At, B1); PG8_BAR; PG8_SCHED;
            PG8_LDB(B0, 1, 0); PG8_LDB(B1, 1, 1); PG8_SCHED; PG8_LDA(At, 1, 0); PG8_STAGE(PG8_SA(0, 1), a2 + hstepA, voffA);
            PG8_WAIT_V(8); PG8_WAIT_L(0); PG8_BAR; PG8_MMA(0, 0, At, B0); PG8_MMA(0, 1, At, B1); PG8_BAR; PG8_SCHED;
            PG8_LDA(At, 1, 1); PG8_STAGE(PG8_SB(1, 0), b3, voffB); PG8_STAGE(PG8_SB(1, 1), b3 + hstepB, voffB); PG8_STAGE(PG8_SA(1, 0), a3, voffA);
            PG8_WAIT_V(8); PG8_WAIT_L(0); PG8_BAR; PG8_MMA(1, 0, At, B0); PG8_MMA(1, 1, At, B1); PG8_BAR; PG8_SCHED;
        }
        if (wr == 0) PG8_BAR;
        E(acc, cur, wr, wc, fr, fq);
        if (!has_next) break;
#pragma unroll
        for (int a = 0; a < 2; ++a)
#pragma unroll
            for (int b = 0; b < 2; ++b)
#pragma unroll
                for (int m = 0; m < 4; ++m)
#pragma unroll
                    for (int n = 0; n < 2; ++n) acc[a][b][m][n] = (f32x4){0.f, 0.f, 0.f, 0.f};
        cur = nxt; cA = nA; cB = nB; ++ui;
        if (wr == 1) PG8_BAR;
    }
    PG8_WAIT_V(0);
    PG8_BAR;
#undef PG8_SA
#undef PG8_SB
#undef PG8_STAGE
#undef PG8_LDA
#undef PG8_LDB
#undef PG8_MMA
#undef PG8_WAIT_V
#undef PG8_WAIT_L
#undef PG8_BAR
#undef PG8_SCHED
}

struct EpiSwiGLU {
    static constexpr bool PERM = true;
    bf16_t* O;
    __device__ __forceinline__ void operator()(const f32x4 (&acc)[2][2][4][2], const Unit& u, int wr, int wc, int fr, int fq) const {
        const int col = u.pn * 128 + wc * 32 + 8 * fq;
#pragma unroll
        for (int ai = 0; ai < 2; ++ai)
#pragma unroll
            for (int m = 0; m < 4; ++m) {
                const int row = u.pm * BM + ai * HALF + wr * 64 + m * 16 + fr;
                float o[8];
#pragma unroll
                for (int n = 0; n < 2; ++n)
#pragma unroll
                    for (int e = 0; e < 4; ++e) { const float gv = acc[ai][0][m][n][e], uv = acc[ai][1][m][n][e]; o[4 * n + e] = gv * fsigmoid(gv) * uv; }
                u32x4 w; w.x = pk2(o[0], o[1]); w.y = pk2(o[2], o[3]); w.z = pk2(o[4], o[5]); w.w = pk2(o[6], o[7]);
                *(u32x4*)(O + (size_t)row * DFF + col) = w;
            }
    }
};
struct EpiResid {
    static constexpr bool PERM = true;
    const bf16_t* res; bf16_t* out; float alpha, scale;
    __device__ __forceinline__ void operator()(const f32x4 (&acc)[2][2][4][2], const Unit& u, int wr, int wc, int fr, int fq) const {
        const int col0 = u.pn * BM + wc * 32 + 8 * fq;
#pragma unroll
        for (int ai = 0; ai < 2; ++ai)
#pragma unroll
            for (int m = 0; m < 4; ++m) {
                const size_t off = (size_t)(u.pm * BM + ai * HALF + wr * 64 + m * 16 + fr) * DM + col0;
#pragma unroll
                for (int bj = 0; bj < 2; ++bj) {
                    const u32x4 rv = *(const u32x4*)(res + off + bj * HALF);
                    const f32x4 a0 = acc[ai][bj][m][0], a1 = acc[ai][bj][m][1];
                    u32x4 w;
                    w.x = pk2(alpha * bflo(rv.x) + scale * a0[0], alpha * bfhi(rv.x) + scale * a0[1]); w.y = pk2(alpha * bflo(rv.y) + scale * a0[2], alpha * bfhi(rv.y) + scale * a0[3]);
                    w.z = pk2(alpha * bflo(rv.z) + scale * a1[0], alpha * bfhi(rv.z) + scale * a1[1]); w.w = pk2(alpha * bflo(rv.w) + scale * a1[2], alpha * bfhi(rv.w) + scale * a1[3]);
                    *(u32x4*)(out + off + bj * HALF) = w;
                }
            }
    }
};
struct EpiProj {
    static constexpr bool PERM = true;
    bf16_t* PROJ; bf16_t* KCV; bf16_t* VT; const float* ROPE;
    __device__ __forceinline__ void operator()(const f32x4 (&acc)[2][2][4][2], const Unit& u, int wr, int wc, int fr, int fq) const {
        const int pn = u.pn, hc = 32 * wc + 8 * fq;
#pragma unroll
        for (int ai = 0; ai < 2; ++ai)
#pragma unroll
            for (int m = 0; m < 4; ++m) {
                const int row = u.pm * BM + ai * HALF + wr * 64 + m * 16 + fr, b = row >> 11, t = row & 2047;
#pragma unroll
                for (int bj = 0; bj < 2; ++bj) {
                    f32x4 v0 = acc[ai][bj][m][0], v1 = acc[ai][bj][m][1];
                    const bool isq = (pn == 4 || pn == 5);
                    const bool rope = isq || (pn >= 6 && pn <= 8 && bj == 0);
                    if (rope) {
                        const int i0 = (hc & 63) >> 1;
                        const f32x4* rp = (const f32x4*)(ROPE + ((size_t)t * 32 + i0) * 2);
                        const f32x4 c0 = rp[0], c1 = rp[1];
                        float a, bb;
                        a = v0[0] * c0[0] - v0[1] * c0[1]; bb = v0[1] * c0[0] + v0[0] * c0[1]; v0[0] = a; v0[1] = bb;
                        a = v0[2] * c0[2] - v0[3] * c0[3]; bb = v0[3] * c0[2] + v0[2] * c0[3]; v0[2] = a; v0[3] = bb;
                        a = v1[0] * c1[0] - v1[1] * c1[1]; bb = v1[1] * c1[0] + v1[0] * c1[1]; v1[0] = a; v1[1] = bb;
                        a = v1[2] * c1[2] - v1[3] * c1[3]; bb = v1[3] * c1[2] + v1[2] * c1[3]; v1[2] = a; v1[3] = bb;
                        if (isq) { v0 = v0 * 0.125f; v1 = v1 * 0.125f; }
                    }
                    u32x4 w; w.x = pk2(v0[0], v0[1]); w.y = pk2(v0[2], v0[3]); w.z = pk2(v1[0], v1[1]); w.w = pk2(v1[2], v1[3]);
                    if (pn == 6) {
                        const int gg = hc >> 6, d = hc & 63;
                        *(u32x4*)(KCV + (((size_t)(bj * 32 + b * 2 + gg)) * 2048 + t) * 64 + d) = w;
                    } else if ((pn == 7 || pn == 8) && bj == 1) {
                        const int gg = hc >> 6, d = hc & 63;
                        bf16_t* vp = VT + (((size_t)((pn - 7) * 32 + b * 2 + gg)) * 64 + d) * 2048 + t;
                        vp[0 * 2048] = (bf16_t)(w.x & 0xffffu); vp[1 * 2048] = (bf16_t)(w.x >> 16); vp[2 * 2048] = (bf16_t)(w.y & 0xffffu); vp[3 * 2048] = (bf16_t)(w.y >> 16);
                        vp[4 * 2048] = (bf16_t)(w.z & 0xffffu); vp[5 * 2048] = (bf16_t)(w.z >> 16); vp[6 * 2048] = (bf16_t)(w.w & 0xffffu); vp[7 * 2048] = (bf16_t)(w.w >> 16);
                    } else {
                        *(u32x4*)(PROJ + (size_t)row * NPROJ + 256 * pn + 128 * bj + hc) = w;
                    }
                    asm volatile("" ::: "memory");
                }
            }
    }
};
struct EpiCmp {
    static constexpr bool PERM = true;
    bf16_t* O; const float* bias;
    __device__ __forceinline__ void operator()(const f32x4 (&acc)[2][2][4][2], const Unit& u, int wr, int wc, int fr, int fq) const {
#pragma unroll
        for (int ai = 0; ai < 2; ++ai)
#pragma unroll
            for (int m = 0; m < 4; ++m) {
                const int row = u.pm * BM + ai * HALF + wr * 64 + m * 16 + fr;
#pragma unroll
                for (int bj = 0; bj < 2; ++bj) {
                    const int col = 128 * bj + 32 * wc + 8 * fq;
                    const f32x4 b0 = *(const f32x4*)(bias + col), b1 = *(const f32x4*)(bias + col + 4);
                    f32x4 v0 = acc[ai][bj][m][0] + b0, v1 = acc[ai][bj][m][1] + b1;
#pragma unroll
                    for (int e = 0; e < 4; ++e) { v0[e] = v0[e] * fsigmoid(v0[e]); v1[e] = v1[e] * fsigmoid(v1[e]); }
                    u32x4 w; w.x = pk2(v0[0], v0[1]); w.y = pk2(v0[2], v0[3]); w.z = pk2(v1[0], v1[1]); w.w = pk2(v1[2], v1[3]);
                    *(u32x4*)(O + (size_t)row * 256 + col) = w;
                }
                asm volatile("" ::: "memory");
            }
    }
};
}

constexpr int NWAVES = 8, NTHREADS = 512;
constexpr int LDS_BYTES = 131072 + 256;
constexpr size_t WS_CTL = 0, CTL_BYTES = 16384;
constexpr int NPHASE = 14;

struct Args { const float* in[28]; float* out; unsigned char* ws; int ph_lo, ph_hi; };

#define INP(k) ((const float*)F.kp[(k)])
struct Frame {
    LAS unsigned char* lds;
    int tid, lane, wave, G, bid;
    const __attribute__((address_space(4))) unsigned long long* kp;
    float* out; unsigned char* ws;
};

__device__ __forceinline__ float wave_sum(float v) {
#pragma unroll
    for (int o = 1; o < 64; o <<= 1) v += __shfl_xor(v, o);
    return v;
}
__device__ __forceinline__ int rope_d(int d) { return d < 32 ? 2 * d : 2 * (d - 32) + 1; }
__device__ __forceinline__ int map_swiglu(int n) { const int h = n >= DFF ? 1 : 0; const int c = n - h * DFF; return 256 * (c >> 7) + 128 * h + (c & 127); }
__device__ __forceinline__ int map_proj(int n) { const bool roped = (n >= 1024 && n < 1664) || (n >= 1792 && n < 1920) || (n >= 2048 && n < 2176); return roped ? ((n & ~63) + rope_d(n & 63)) : n; }

template <int MAP, bool KPERM>
__device__ __forceinline__ void tr_item(const float* W, int K, int N, bf16_t* WT, LAS float* scr, int item, int lane) {
    const int nblk = (N + 31) / 32, kb = item / nblk, nb = item % nblk, k0 = 64 * kb, n0 = 32 * nb;
    const int n4 = (lane & 7) * 4; const bool ok = (n0 + n4) < N;
    f32x4 ld[8];
#pragma unroll
    for (int i = 0; i < 8; ++i) { const int kk = 8 * i + (lane >> 3); ld[i] = ok ? *(const f32x4*)(W + (size_t)(k0 + kk) * N + n0 + n4) : (f32x4){0.f, 0.f, 0.f, 0.f}; }
#pragma unroll
    for (int i = 0; i < 8; ++i) { const int kk = 8 * i + (lane >> 3); LAS float* d = scr + kk * 33 + n4; d[0] = ld[i][0]; d[1] = ld[i][1]; d[2] = ld[i][2]; d[3] = ld[i][3]; }
    LDS_WAIT(); asm volatile("" ::: "memory");
    const int c = lane & 7;
#pragma unroll
    for (int j = 0; j < 4; ++j) {
        const int n = (lane >> 3) + 8 * j;
        if (n0 + n < N) {
            const LAS float* s = scr + n;
            float e[8];
#pragma unroll
            for (int q = 0; q < 8; ++q) { const int kk = KPERM ? ((q & 1) * 32 + 4 * c + (q >> 1)) : (8 * c + q); e[q] = s[kk * 33]; }
            const int dn = MAP == 1 ? map_swiglu(n0 + n) : (MAP == 2 ? map_proj(n0 + n) : (n0 + n));
            u32x4 o; o.x = pk2(e[0], e[1]); o.y = pk2(e[2], e[3]); o.z = pk2(e[4], e[5]); o.w = pk2(e[6], e[7]);
            *(u32x4*)(WT + (size_t)dn * K + k0 + 8 * c) = o;
        }
    }
    LDS_WAIT(); asm volatile("" ::: "memory");
}

__device__ __forceinline__ void p_prologue(Frame& F) {
    LAS float* scr = (LAS float*)(F.lds + F.wave * 16384);
    const int gw = F.bid * NWAVES + F.wave, NGW = F.G * NWAVES;
    bf16_t* W1A = (bf16_t*)(F.ws + WS_W1A); bf16_t* W1B = (bf16_t*)(F.ws + WS_W1B); bf16_t* WMI = (bf16_t*)(F.ws + WS_WMI); bf16_t* WMO = (bf16_t*)(F.ws + WS_WMO);
    bf16_t* W2A = (bf16_t*)(F.ws + WS_W2A); bf16_t* W2B = (bf16_t*)(F.ws + WS_W2B); bf16_t* WC1 = (bf16_t*)(F.ws + WS_WC1);
    constexpr int I_A = (DM / 64) * (NFF2 / 32), I_B = (DFF / 64) * (DM / 32), I_MI = (DM / 64) * ((INCOLS + 31) / 32), I_MO = (DM / 64) * (DM / 32), I_C = (2048 / 64) * (256 / 32);
    constexpr int NITEMS = 2 * I_A + 2 * I_B + I_MI + I_MO + 2 * I_C;
    for (int it = gw; it < NITEMS; it += NGW) {
        int r = it;
        if (r < I_A) { tr_item<1, false>(INP(1), DM, NFF2, W1A, scr, r, F.lane); continue; } r -= I_A;
        if (r < I_A) { tr_item<1, false>(INP(24), DM, NFF2, W2A, scr, r, F.lane); continue; } r -= I_A;
        if (r < I_B) { tr_item<0, false>(INP(2), DFF, DM, W1B, scr, r, F.lane); continue; } r -= I_B;
        if (r < I_B) { tr_item<0, false>(INP(25), DFF, DM, W2B, scr, r, F.lane); continue; } r -= I_B;
        if (r < I_MI) { tr_item<2, false>(INP(5), DM, INCOLS, WMI, scr, r, F.lane); continue; } r -= I_MI;
        if (r < I_MO) { tr_item<0, false>(INP(21), DM, DM, WMO, scr, r, F.lane); continue; } r -= I_MO;
        if (r < I_C) { tr_item<0, true>(INP(14), 2048, 256, WC1, scr, r, F.lane); continue; } r -= I_C;
        tr_item<0, false>(INP(17), 2048, 256, WC1 + (size_t)256 * 2048, scr, r, F.lane);
    }
    const int gt = F.bid * NTHREADS + F.tid, NGT = F.G * NTHREADS;
    { u32x4* z = (u32x4*)(WMI + (size_t)INCOLS * DM); const int nz = (NPROJ - INCOLS) * DM / 8;
      for (int i = gt; i < nz; i += NGT) z[i] = (u32x4){0u, 0u, 0u, 0u}; }
    { float* R = (float*)(F.ws + WS_ROPE);
      for (int i = gt; i < 2048 * 32; i += NGT) {
          const int t = i >> 5, k = i & 31;
          const float inv = __builtin_amdgcn_exp2f(-(float)k * 0.41524101186092029f);
          const float ang = (float)t * inv;
          const float kk = rintf(ang * 0.15915494309189535f);
          float rr = fmaf(-kk, 6.28318548202514648f, ang); rr = fmaf(-kk, -1.74845553e-7f, rr);
          const float fr = rr * 0.15915494309189535f;
          R[2 * i] = __builtin_amdgcn_cosf(fr); R[2 * i + 1] = __builtin_amdgcn_sinf(fr);
      } }
    { const float* x = INP(0); bf16_t* XB = (bf16_t*)(F.ws + WS_AB);
      for (int m = 2 * gw; m < MTOK; m += 2 * NGW) {
          const f32x4* xr = (const f32x4*)(x + (size_t)m * DM) + F.lane; u32x2* o = (u32x2*)(XB + (size_t)m * DM) + F.lane;
          f32x4 v[8];
#pragma unroll
          for (int j = 0; j < 8; ++j) v[j] = xr[64 * j];
#pragma unroll
          for (int j = 0; j < 8; ++j) o[64 * j] = (u32x2){pk2(v[j][0], v[j][1]), pk2(v[j][2], v[j][3])};
      } }
    if (F.bid < 64) {
        __syncthreads();
        const int wsel = F.bid >> 5, nb0 = (F.bid & 31) * 8;
        const float* pe = INP(wsel == 0 ? 13 : 16); const float* w1 = INP(wsel == 0 ? 14 : 17);
        float acc8[8];
#pragma unroll
        for (int e = 0; e < 8; ++e) acc8[e] = 0.f;
#pragma unroll
        for (int r4 = 0; r4 < 4; ++r4) {
            const int kk = F.tid * 4 + r4; const float pv = pe[kk];
            const f32x4 a = *(const f32x4*)(w1 + (size_t)kk * 256 + nb0), b = *(const f32x4*)(w1 + (size_t)kk * 256 + nb0 + 4);
            acc8[0] += pv * a[0]; acc8[1] += pv * a[1]; acc8[2] += pv * a[2]; acc8[3] += pv * a[3]; acc8[4] += pv * b[0]; acc8[5] += pv * b[1]; acc8[6] += pv * b[2]; acc8[7] += pv * b[3];
        }
        LAS float* red = (LAS float*)F.lds;
#pragma unroll
        for (int e = 0; e < 8; ++e) { const float sv = wave_sum(acc8[e]); if (F.lane == 0) red[F.wave * 8 + e] = sv; }
        __syncthreads();
        if (F.tid < 8) { float t = 0.f;
#pragma unroll
            for (int wv = 0; wv < 8; ++wv) t += red[wv * 8 + F.tid];
            ((float*)(F.ws + WS_CBIAS))[wsel * 256 + nb0 + F.tid] = t; }
        __syncthreads();
    }
}

template <bool OUT_F32>
__device__ __forceinline__ void p_layernorm(Frame& F, const bf16_t* Z, const float* g, const float* bta, bf16_t* OB, float* OF) {
    const int gw = F.bid * NWAVES + F.wave, NGW = F.G * NWAVES;
    float gv[16], bv[16];
#pragma unroll
    for (int e = 0; e < 16; ++e) { gv[e] = g[16 * F.lane + e]; bv[e] = bta[16 * F.lane + e]; }
    for (int m = 2 * gw; m < MTOK; m += 2 * NGW) {
        u32x4 raw[2][2];
#pragma unroll
        for (int rr = 0; rr < 2; ++rr) { const u32x4* zr = (const u32x4*)(Z + (size_t)(m + rr) * DM + 16 * F.lane); raw[rr][0] = zr[0]; raw[rr][1] = zr[1]; }
#pragma unroll
        for (int rr = 0; rr < 2; ++rr) {
            float v[16];
            const u32x4 a = raw[rr][0], b = raw[rr][1];
            v[0] = bflo(a.x); v[1] = bfhi(a.x); v[2] = bflo(a.y); v[3] = bfhi(a.y); v[4] = bflo(a.z); v[5] = bfhi(a.z); v[6] = bflo(a.w); v[7] = bfhi(a.w);
            v[8] = bflo(b.x); v[9] = bfhi(b.x); v[10] = bflo(b.y); v[11] = bfhi(b.y); v[12] = bflo(b.z); v[13] = bfhi(b.z); v[14] = bflo(b.w); v[15] = bfhi(b.w);
            float s = 0.f;
#pragma unroll
            for (int e = 0; e < 16; ++e) s += v[e];
            const float mean = wave_sum(s) * (1.f / DM); float s2 = 0.f;
#pragma unroll
            for (int e = 0; e < 16; ++e) { v[e] -= mean; s2 += v[e] * v[e]; }
            const float rstd = 1.f / sqrtf(wave_sum(s2) * (1.f / DM) + LN_EPS);
#pragma unroll
            for (int e = 0; e < 16; ++e) v[e] = v[e] * rstd * gv[e] + bv[e];
            if (OUT_F32) {
                f32x4* o = (f32x4*)(OF + (size_t)(m + rr) * DM + 16 * F.lane);
                o[0] = (f32x4){v[0], v[1], v[2], v[3]}; o[1] = (f32x4){v[4], v[5], v[6], v[7]}; o[2] = (f32x4){v[8], v[9], v[10], v[11]}; o[3] = (f32x4){v[12], v[13], v[14], v[15]};
            } else {
                u32x4* o = (u32x4*)(OB + (size_t)(m + rr) * DM + 16 * F.lane);
                u32x4 oa, ob; oa.x = pk2(v[0], v[1]); oa.y = pk2(v[2], v[3]); oa.z = pk2(v[4], v[5]); oa.w = pk2(v[6], v[7]);
                ob.x = pk2(v[8], v[9]); ob.y = pk2(v[10], v[11]); ob.z = pk2(v[12], v[13]); ob.w = pk2(v[14], v[15]);
                o[0] = oa; o[1] = ob;
            }
        }
    }
}

__device__ __forceinline__ void p_rmsnorm(Frame& F, bf16_t* Y, const float* gl, const float* gn) {
    const int gw = F.bid * NWAVES + F.wave, NGW = F.G * NWAVES;
    const float* gp = (F.lane < 32) ? (gl + 16 * F.lane) : (gn + 16 * (F.lane - 32));
    float gvv[16];
#pragma unroll
    for (int e = 0; e < 16; ++e) gvv[e] = gp[e];
    for (int m = gw; m < MTOK; m += NGW) {
        u32x4* yr = (u32x4*)(Y + (size_t)m * DM + 16 * F.lane);
        const u32x4 a = yr[0], b = yr[1];
        float v[16];
        v[0] = bflo(a.x); v[1] = bfhi(a.x); v[2] = bflo(a.y); v[3] = bfhi(a.y); v[4] = bflo(a.z); v[5] = bfhi(a.z); v[6] = bflo(a.w); v[7] = bfhi(a.w);
        v[8] = bflo(b.x); v[9] = bfhi(b.x); v[10] = bflo(b.y); v[11] = bfhi(b.y); v[12] = bflo(b.z); v[13] = bfhi(b.z); v[14] = bflo(b.w); v[15] = bfhi(b.w);
        float s = 0.f;
#pragma unroll
        for (int e = 0; e < 16; ++e) s += v[e] * v[e];
#pragma unroll
        for (int o = 1; o < 32; o <<= 1) s += __shfl_xor(s, o);
        const float r = 1.f / sqrtf(s * (1.f / 512.f) + RMS_EPS);
#pragma unroll
        for (int e = 0; e < 16; ++e) v[e] = v[e] * r * gvv[e];
        u32x4 oa, ob; oa.x = pk2(v[0], v[1]); oa.y = pk2(v[2], v[3]); oa.z = pk2(v[4], v[5]); oa.w = pk2(v[6], v[7]);
        ob.x = pk2(v[8], v[9]); ob.y = pk2(v[10], v[11]); ob.z = pk2(v[12], v[13]); ob.w = pk2(v[14], v[15]);
        yr[0] = oa; yr[1] = ob;
    }
}

__device__ __forceinline__ void p_kcvc(Frame& F) {
    const int gw = F.bid * NWAVES + F.wave, NGW = F.G * NWAVES;
    const bf16_t* HID = (const bf16_t*)(F.ws + WS_HID); bf16_t* KC = (bf16_t*)(F.ws + WS_KC); bf16_t* VCT = (bf16_t*)(F.ws + WS_VCT);
    for (int it = gw; it < 2 * 4096; it += NGW) {
        const int which = it >> 12, row = it & 4095, d = F.lane;
        const float* w2 = INP(which == 0 ? 15 : 18);
        const u32x4* hr = (const u32x4*)(HID + ((size_t)which * 4096 + row) * 256);
        float s = 0.f;
        for (int j8 = 0; j8 < 32; ++j8) {
            const u32x4 h = hr[j8]; const float* wp = w2 + (size_t)(8 * j8) * 64 + d;
            s += bflo(h.x) * wp[0] + bfhi(h.x) * wp[64] + bflo(h.y) * wp[128] + bfhi(h.y) * wp[192] + bflo(h.z) * wp[256] + bfhi(h.z) * wp[320] + bflo(h.w) * wp[384] + bfhi(h.w) * wp[448];
        }
        const unsigned hb = pk2(s, 0.f) & 0xffffu;
        if (which == 0) KC[(size_t)row * 64 + rope_d(d)] = (bf16_t)hb;
        else { const int bg = row >> 7, n = row & 127; VCT[((size_t)bg * 64 + d) * 128 + n] = (bf16_t)hb; }
    }
}

constexpr int LR_XBF = 0, LR_XF = 18432, LR_AS = 34816, LR_US = 51200, LR_WT = 67584, LR_SEGP = 76800, LR_SEGH = 78848, LR_CARRY = 80896;
__device__ __forceinline__ void lru_unit(Frame& F, int u) {
    const int b = u >> 4, h = (u >> 1) & 7, jh = u & 1;
    const int tid = F.tid, lane = F.lane, w = F.wave, quad = lane >> 4, l16 = lane & 15;
    const bf16_t* PROJ = (const bf16_t*)(F.ws + WS_ACT); bf16_t* Y = (bf16_t*)(F.ws + WS_Y);
    LAS unsigned char* lds = F.lds;
    LAS float* XF = (LAS float*)(lds + LR_XF); LAS float* AS = (LAS float*)(lds + LR_AS); LAS float* US = (LAS float*)(lds + LR_US);
    LAS float* SEGP = (LAS float*)(lds + LR_SEGP); LAS float* SEGH = (LAS float*)(lds + LR_SEGH); LAS float* CARRY = (LAS float*)(lds + LR_CARRY);
    LAS bf16_t* WT = (LAS bf16_t*)(lds + LR_WT);
    __syncthreads();
    for (int idx = tid; idx < 2 * 32 * 64; idx += NTHREADS) {
        const int gsel = idx >> 11, rem = idx & 2047, i = rem >> 5, j = rem & 31;
        const float* wsrc = INP(gsel == 0 ? 8 : 10);
        const float v = wsrc[((size_t)(h * 64 + i)) * 64 + 32 * jh + j];
        WT[(gsel * 32 + j) * 72 + i] = (bf16_t)(pk2(v, 0.f) & 0xffffu);
    }
    if (tid < 32) CARRY[tid] = 0.f;
    float ba[2], bx[2], c8[2];
#pragma unroll
    for (int nt = 0; nt < 2; ++nt) { const int c = 64 * h + 32 * jh + nt * 16 + l16; ba[nt] = INP(9)[c]; bx[nt] = INP(11)[c]; c8[nt] = 8.0f * log1pf(expf(-INP(12)[c])); }
    const int ca0 = 8 * (tid & 7);
    float cw[4][8], cb[8];
#pragma unroll
    for (int e = 0; e < 8; ++e) { cb[e] = INP(7)[64 * h + ca0 + e];
#pragma unroll
        for (int jt = 0; jt < 4; ++jt) cw[jt][e] = INP(6)[jt * 512 + 64 * h + ca0 + e]; }
    __syncthreads();
    for (int tb = 0; tb < 16; ++tb) {
        const int t0 = tb * 128;
#pragma unroll
        for (int half = 0; half < 2; ++half) {
            const int tt = (tid >> 3) + 64 * half, t = t0 + tt;
            float a[8];
#pragma unroll
            for (int e = 0; e < 8; ++e) a[e] = cb[e];
#pragma unroll
            for (int jt = 0; jt < 4; ++jt) {
                const int ts = t - 3 + jt;
                if (ts >= 0) {
                    const u32x4 raw = *(const u32x4*)(PROJ + ((size_t)(b * 2048 + ts)) * NPROJ + 64 * h + ca0);
                    a[0] += cw[jt][0] * bflo(raw.x); a[1] += cw[jt][1] * bfhi(raw.x); a[2] += cw[jt][2] * bflo(raw.y); a[3] += cw[jt][3] * bfhi(raw.y);
                    a[4] += cw[jt][4] * bflo(raw.z); a[5] += cw[jt][5] * bfhi(raw.z); a[6] += cw[jt][6] * bflo(raw.w); a[7] += cw[jt][7] * bfhi(raw.w);
                }
            }
            u32x4 pw; pw.x = pk2(a[0], a[1]); pw.y = pk2(a[2], a[3]); pw.z = pk2(a[4], a[5]); pw.w = pk2(a[6], a[7]);
            *(LAS u32x4*)(lds + LR_XBF + tt * 144 + ca0 * 2) = pw;
            if ((ca0 >> 5) == jh) {
                LAS f32x4* xf = (LAS f32x4*)(XF + tt * 32 + (ca0 & 31));
                xf[0] = (f32x4){a[0], a[1], a[2], a[3]}; xf[1] = (f32x4){a[4], a[5], a[6], a[7]};
            }
        }
        __syncthreads();
        {
            bf16x8 af[2];
#pragma unroll
            for (int s = 0; s < 2; ++s) af[s] = *(const LAS bf16x8*)(lds + LR_XBF + (16 * w + l16) * 144 + (s * 32 + quad * 8) * 2);
            f32x4 acc[2][2];
#pragma unroll
            for (int gsel = 0; gsel < 2; ++gsel)
#pragma unroll
                for (int nt = 0; nt < 2; ++nt) {
                    f32x4 c = {0.f, 0.f, 0.f, 0.f};
#pragma unroll
                    for (int s = 0; s < 2; ++s) { const bf16x8 bfr = *(const LAS bf16x8*)(lds + LR_WT + ((gsel * 32 + nt * 16 + l16) * 72 + s * 32 + quad * 8) * 2); c = __builtin_amdgcn_mfma_f32_16x16x32_bf16(af[s], bfr, c, 0, 0, 0); }
                    acc[gsel][nt] = c;
                }
#pragma unroll
            for (int nt = 0; nt < 2; ++nt)
#pragma unroll
                for (int j = 0; j < 4; ++j) {
                    const int tt = 16 * w + quad * 4 + j, ch = nt * 16 + l16;
                    const float r = fsigmoid(acc[0][nt][j] + ba[nt]), ig = fsigmoid(acc[1][nt][j] + bx[nt]);
                    const float la = -c8[nt] * r, av = expf(la);
                    const float mult = (t0 + tt == 0) ? 1.0f : sqrtf(-expm1f(2.0f * la));
                    AS[tt * 32 + ch] = av; US[tt * 32 + ch] = mult * ig * XF[tt * 32 + ch];
                }
        }
        __syncthreads();
        {
            const int ch = tid & 31, seg = tid >> 5;
            float P = 1.f, Hh = 0.f;
#pragma unroll
            for (int s = 0; s < 8; ++s) { const int ix = (seg * 8 + s) * 32 + ch; const float a = AS[ix]; Hh = a * Hh + US[ix]; P *= a; }
            SEGP[seg * 32 + ch] = P; SEGH[seg * 32 + ch] = Hh;
            __syncthreads();
            float c = CARRY[ch];
            for (int s2 = 0; s2 < seg; ++s2) c = SEGP[s2 * 32 + ch] * c + SEGH[s2 * 32 + ch];
#pragma unroll
            for (int s = 0; s < 8; ++s) { const int ix = (seg * 8 + s) * 32 + ch; c = AS[ix] * c + US[ix]; US[ix] = c; }
            __syncthreads();
            if (seg == 15) CARRY[ch] = c;
        }
        {
            const int tt = tid >> 2, cc = (tid & 3) * 8; const size_t row = (size_t)(b * 2048 + t0 + tt);
            const u32x4 raw = *(const u32x4*)(PROJ + row * NPROJ + 512 + 64 * h + 32 * jh + cc);
            float gt[8] = {bflo(raw.x), bfhi(raw.x), bflo(raw.y), bfhi(raw.y), bflo(raw.z), bfhi(raw.z), bflo(raw.w), bfhi(raw.w)};
            float o[8];
#pragma unroll
            for (int e = 0; e < 8; ++e) {
                const float x = gt[e], z = 0.7978845608028654f * (x + 0.044715f * x * x * x);
                const float th = 1.0f - 2.0f * __builtin_amdgcn_rcpf(1.0f + __builtin_amdgcn_exp2f(2.0f * z * L2E));
                o[e] = US[tt * 32 + cc + e] * (0.5f * x * (1.0f + th));
            }
            u32x4 pw; pw.x = pk2(o[0], o[1]); pw.y = pk2(o[2], o[3]); pw.z = pk2(o[4], o[5]); pw.w = pk2(o[6], o[7]);
            *(u32x4*)(Y + row * DM + 64 * h + 32 * jh + cc) = pw;
        }
    }
    __syncthreads();
}

constexpr int AT_KC = 0, AT_VC = 18432, AT_K = 35328, AT_V = 44544, AT_IMPP = 53248, AT_IMP = 87040, AT_SEL = 95488;
__device__ __forceinline__ int crow(int r, int hi) { return (r & 3) + 8 * (r >> 2) + 4 * hi; }
#define MFMA32(a, b, c) __builtin_amdgcn_mfma_f32_32x32x16_bf16((a), (b), (c), 0, 0, 0)
__device__ __forceinline__ f32x16 qk_tile(const LAS unsigned char* Kl, int krow0, const bf16x8 (&qf)[4], int i, int hi) {
    f32x16 p;
#pragma unroll
    for (int r = 0; r < 16; ++r) p[r] = 0.f;
    const LAS unsigned char* kp = Kl + (krow0 + i) * 144 + hi * 16;
#pragma unroll
    for (int d0 = 0; d0 < 4; ++d0) { const bf16x8 a = *(const LAS bf16x8*)(kp + d0 * 32); p = MFMA32(a, qf[d0], p); }
    return p;
}
__device__ __forceinline__ bf16x8 pack8(const f32x16& p, int s) {
    u32x4 w; w.x = pk2(p[8 * s], p[8 * s + 1]); w.y = pk2(p[8 * s + 2], p[8 * s + 3]); w.z = pk2(p[8 * s + 4], p[8 * s + 5]); w.w = pk2(p[8 * s + 6], p[8 * s + 7]);
    return __builtin_bit_cast(bf16x8, w);
}
__device__ __forceinline__ void pv_step(f32x16 (&o)[2], const LAS unsigned char* Vl, int VS, int kbase, bf16x8 pb, int i, int hi) {
#pragma unroll
    for (int d0t = 0; d0t < 2; ++d0t) {
        const LAS unsigned char* vp = Vl + (32 * d0t + i) * VS + (kbase + 4 * hi) * 2;
        const s16x4 lo = *(const LAS s16x4*)vp, hi4 = *(const LAS s16x4*)(vp + 16);
        const bf16x8 a = __builtin_shufflevector(lo, hi4, 0, 1, 2, 3, 4, 5, 6, 7);
        o[d0t] = MFMA32(a, pb, o[d0t]);
    }
}
template <int MODE>
__device__ __forceinline__ void attn_branch(const bf16_t* Kg, const bf16_t* VTg, int kt_lo, int kt_hi, unsigned selw, unsigned unionmask, int tq,
                                            const bf16x8 (&qf)[4], LAS unsigned char* lds, int tid, int i, int hi, float gate, f32x16 (&tot)[2]) {
    f32x16 o[2];
#pragma unroll
    for (int r = 0; r < 16; ++r) { o[0][r] = 0.f; o[1][r] = 0.f; }
    float m = -INFINITY, l = 0.f;
    for (int kt = kt_lo; kt <= kt_hi; ++kt) {
        if (MODE == 1 && !((unionmask >> kt) & 1u)) continue;
        {
            const int row = tid >> 3, ch = tid & 7;
            const u32x4 kv = *(const u32x4*)(Kg + (size_t)(kt * 64 + row) * NPROJ + ch * 8);
            const u32x4 vv = *(const u32x4*)(VTg + (size_t)row * 2048 + kt * 64 + ch * 8);
            *(LAS u32x4*)(lds + AT_K + row * 144 + ch * 16) = kv;
            LAS u32x2* vd = (LAS u32x2*)(lds + AT_V + row * 136 + ch * 16); vd[0] = (u32x2){vv.x, vv.y}; vd[1] = (u32x2){vv.z, vv.w};
        }
        __syncthreads();
        f32x16 p0 = qk_tile(lds + AT_K, 0, qf, i, hi), p1 = qk_tile(lds + AT_K, 32, qf, i, hi);
        const bool selbit = (MODE == 1) ? (((selw >> kt) & 1u) != 0u) : true;
        float mx = -INFINITY;
        const int rel = tq - kt * 64 - 4 * hi;
#pragma unroll
        for (int r = 0; r < 16; ++r) {
            const int cr0 = (r & 3) + 8 * (r >> 2), cr1 = cr0 + 32;
            const bool v0 = selbit && cr0 <= rel && (MODE == 1 || cr0 >= rel - 511);
            const bool v1 = selbit && cr1 <= rel && (MODE == 1 || cr1 >= rel - 511);
            p0[r] = v0 ? p0[r] : -INFINITY; p1[r] = v1 ? p1[r] : -INFINITY;
            mx = fmaxf(mx, fmaxf(p0[r], p1[r]));
        }
        mx = fmaxf(mx, __shfl_xor(mx, 32));
        const float mnew = fmaxf(m, mx), msafe = (mnew == -INFINITY) ? 0.f : mnew;
        const float alpha = __builtin_amdgcn_exp2f((m - msafe) * L2E);
        float ls = 0.f;
#pragma unroll
        for (int r = 0; r < 16; ++r) { p0[r] = __builtin_amdgcn_exp2f((p0[r] - msafe) * L2E); p1[r] = __builtin_amdgcn_exp2f((p1[r] - msafe) * L2E); ls += p0[r] + p1[r]; }
        l = l * alpha + ls; m = mnew;
#pragma unroll
        for (int r = 0; r < 16; ++r) { o[0][r] *= alpha; o[1][r] *= alpha; }
        pv_step(o, lds + AT_V, 136, 0, pack8(p0, 0), i, hi);
        pv_step(o, lds + AT_V, 136, 16, pack8(p0, 1), i, hi);
        pv_step(o, lds + AT_V, 136, 32, pack8(p1, 0), i, hi);
        pv_step(o, lds + AT_V, 136, 48, pack8(p1, 1), i, hi);
        __syncthreads();
    }
    l += __shfl_xor(l, 32);
    const float sc = gate / l;
#pragma unroll
    for (int r = 0; r < 16; ++r) { tot[0][r] += o[0][r] * sc; tot[1][r] += o[1][r] * sc; }
}

__device__ __forceinline__ void attn_unit(Frame& F, int b, int g, int qt) {
    const int tid = F.tid, lane = F.lane, w = F.wave, i = lane & 31, hi = lane >> 5, r = w >> 1;
    const int bg = b * 2 + g, t0 = qt * 64, tl = 32 * (w & 1) + i, tq = t0 + tl;
    const size_t row = (size_t)b * 2048 + tq;
    LAS unsigned char* lds = F.lds;
    const bf16_t* PROJ = (const bf16_t*)(F.ws + WS_ACT); bf16_t* Y = (bf16_t*)(F.ws + WS_Y);
    const bf16_t* KC = (const bf16_t*)(F.ws + WS_KC); const bf16_t* VCT = (const bf16_t*)(F.ws + WS_VCT); const bf16_t* VT = (const bf16_t*)(F.ws + WS_VT);
    bf16x8 qf[4];
    { const bf16_t* qp = PROJ + row * NPROJ + 1024 + 64 * (4 * g + r) + 8 * hi;
#pragma unroll
      for (int d0 = 0; d0 < 4; ++d0) qf[d0] = *(const bf16x8*)(qp + 16 * d0); }
    float g0, g1, g2;
    { const bf16_t* gp = PROJ + row * NPROJ + 2304 + (4 * g + r) * 3; g0 = fsigmoid(bf2f(gp[0])); g1 = fsigmoid(bf2f(gp[1])); g2 = fsigmoid(bf2f(gp[2])); }
#pragma unroll
    for (int c2 = 0; c2 < 2; ++c2) {
        const int idx = tid + NTHREADS * c2;
        { const int rk = idx >> 3, ch = idx & 7; const u32x4 v = *(const u32x4*)(KC + ((size_t)bg * 128 + rk) * 64 + ch * 8); *(LAS u32x4*)(lds + AT_KC + rk * 144 + ch * 16) = v; }
        { const int rd = idx >> 4, ch = idx & 15; const u32x4 v = *(const u32x4*)(VCT + ((size_t)bg * 64 + rd) * 128 + ch * 8);
          LAS u32x2* vd = (LAS u32x2*)(lds + AT_VC + rd * 264 + ch * 16); vd[0] = (u32x2){v.x, v.y}; vd[1] = (u32x2){v.z, v.w}; }
    }
    __syncthreads();
    f32x16 tot[2];
    {
        f32x16 p[4];
#pragma unroll
        for (int kt = 0; kt < 4; ++kt) p[kt] = qk_tile(lds + AT_KC, 32 * kt, qf, i, hi);
        const int nv = tq >= 31 ? (((tq - 31) >> 4) + 1) : 0;
        const int nvl = nv - 4 * hi;
        float mx = -INFINITY;
#pragma unroll
        for (int kt = 0; kt < 4; ++kt)
#pragma unroll
            for (int rr = 0; rr < 16; ++rr) { const int nc = 32 * kt + (rr & 3) + 8 * (rr >> 2); p[kt][rr] = (nc < nvl) ? p[kt][rr] : -INFINITY; mx = fmaxf(mx, p[kt][rr]); }
        mx = fmaxf(mx, __shfl_xor(mx, 32));
        const float msafe = (mx == -INFINITY) ? 0.f : mx;
        float ls = 0.f;
#pragma unroll
        for (int kt = 0; kt < 4; ++kt)
#pragma unroll
            for (int rr = 0; rr < 16; ++rr) { p[kt][rr] = __builtin_amdgcn_exp2f((p[kt][rr] - msafe) * L2E); ls += p[kt][rr]; }
        ls += __shfl_xor(ls, 32);
        const float inv = ls > 0.f ? 1.0f / ls : 0.f;
#pragma unroll
        for (int kt = 0; kt < 4; ++kt)
#pragma unroll
            for (int rr = 0; rr < 16; ++rr) p[kt][rr] *= inv;
        float Qs[16], rl[16];
#pragma unroll
        for (int q4 = 0; q4 < 16; ++q4) {
            const int kt = q4 >> 2, g4 = q4 & 3;
            Qs[q4] = (p[kt][4 * g4] + p[kt][4 * g4 + 1]) + (p[kt][4 * g4 + 2] + p[kt][4 * g4 + 3]);
            rl[q4] = __shfl_xor(p[kt][4 * g4 + 3], 32);
        }
        LAS float* impp = (LAS float*)(lds + AT_IMPP) + (r * 64 + tl) * 33;
#pragma unroll
        for (int q4 = 0; q4 < 16; ++q4) {
            const float ex = hi ? rl[q4] : (q4 > 0 ? rl[q4 > 0 ? q4 - 1 : 0] : 0.f);
            impp[8 * (q4 >> 2) + 2 * (q4 & 3) + hi] = Qs[q4] + ex;
        }
        f32x16 o[2];
#pragma unroll
        for (int rr = 0; rr < 16; ++rr) { o[0][rr] = 0.f; o[1][rr] = 0.f; }
#pragma unroll
        for (int kt = 0; kt < 4; ++kt)
#pragma unroll
            for (int s = 0; s < 2; ++s) pv_step(o, lds + AT_VC, 264, 32 * kt + 16 * s, pack8(p[kt], s), i, hi);
#pragma unroll
        for (int rr = 0; rr < 16; ++rr) { tot[0][rr] = o[0][rr] * g0; tot[1][rr] = o[1][rr] * g0; }
    }
    __syncthreads();
    {
        LAS float* IMPP = (LAS float*)(lds + AT_IMPP); LAS float* IMP = (LAS float*)(lds + AT_IMP); LAS unsigned* SEL = (LAS unsigned*)(lds + AT_SEL);
#pragma unroll
        for (int it = 0; it < 4; ++it) {
            const int idx = tid + NTHREADS * it, tt = idx >> 5, j = idx & 31;
            IMP[tt * 33 + j] = ((IMPP[(0 * 64 + tt) * 33 + j] + IMPP[(1 * 64 + tt) * 33 + j]) + IMPP[(2 * 64 + tt) * 33 + j]) + IMPP[(3 * 64 + tt) * 33 + j];
        }
        __syncthreads();
#pragma unroll 1
        for (int it = 0; it < 4; ++it) {
            const int idx = tid + NTHREADS * it, tt = idx >> 5, j = idx & 31;
            const float v = IMP[tt * 33 + j];
            int cnt = 0;
#pragma unroll 2
            for (int j2 = 1; j2 <= qt - 2; ++j2) { const float v2 = IMP[tt * 33 + j2]; cnt += ((v2 > v) || (v2 == v && j2 < j)) ? 1 : 0; }
            const bool forced = (j == 0) || (j == qt) || (j == qt - 1);
            const bool sel = (j <= qt) && (forced || (j >= 1 && j <= qt - 2 && cnt < 13));
            const unsigned long long bal = __ballot(sel);
            if ((lane & 31) == 0) SEL[tt] = (lane < 32) ? (unsigned)bal : (unsigned)(bal >> 32);
        }
        __syncthreads();
    }
    unsigned selw, unionmask;
    { LAS unsigned* SEL = (LAS unsigned*)(lds + AT_SEL); selw = SEL[tl]; unsigned uu = SEL[lane];
#pragma unroll
      for (int o = 1; o < 64; o <<= 1) uu |= __shfl_xor(uu, o);
      unionmask = uu; }
    unionmask = __builtin_amdgcn_readfirstlane(unionmask);
    attn_branch<0>(PROJ + (size_t)b * 2048 * NPROJ + 2048 + 64 * g, VT + ((size_t)(32 + bg) * 64) * 2048, qt - 8 > 0 ? qt - 8 : 0, qt, 0u, 0u, tq, qf, lds, tid, i, hi, g2, tot);
    attn_branch<1>(PROJ + (size_t)b * 2048 * NPROJ + 1792 + 64 * g, VT + ((size_t)bg * 64) * 2048, 0, qt, selw, unionmask, tq, qf, lds, tid, i, hi, g1, tot);
    bf16_t* yp = Y + row * DM + 512 + 64 * (4 * g + r);
#pragma unroll
    for (int d0t = 0; d0t < 2; ++d0t)
#pragma unroll
        for (int g4 = 0; g4 < 4; ++g4) {
            const int d = 32 * d0t + 8 * g4 + 4 * hi;
            *(u32x2*)(yp + d) = (u32x2){pk2(tot[d0t][4 * g4], tot[d0t][4 * g4 + 1]), pk2(tot[d0t][4 * g4 + 2], tot[d0t][4 * g4 + 3])};
        }
}


#define XB_TMO      128
#define XB_XCNT(j)  (256  + 64 * (j))
#define XB_XSUB(j)  (1280 + 64 * (j))
#define XB_XGEN(j)  (2304 + 64 * (j))
#define XB_TOP      3328
#define XB_TOPGEN   3392
#define XCD_BAR_WORDS 3456
#define XB_SPIN_CAP (1u << 20)
__device__ __forceinline__ unsigned xb_ld(unsigned* p)              { return __hip_atomic_load(p, __ATOMIC_RELAXED, __HIP_MEMORY_SCOPE_AGENT); }
__device__ __forceinline__ unsigned xb_add(unsigned* p, unsigned v) { return __hip_atomic_fetch_add(p, v, __ATOMIC_RELAXED, __HIP_MEMORY_SCOPE_AGENT); }
__device__ __forceinline__ unsigned xb_xcc_id() { return (unsigned)__builtin_amdgcn_s_getreg((3 << 11) | 20) & 0xFu; }
#define XB_SPIN(cond, bar) do { unsigned _sp = 0; while (cond) { __builtin_amdgcn_s_sleep(1); \
    if ((++_sp & 255u) == 0u) { if (xb_ld(&(bar)[XB_TMO])) break; if (_sp > XB_SPIN_CAP) { atomicAdd(&(bar)[XB_TMO], 1u); break; } } } } while (0)
struct XcdBarrier { unsigned* bar; unsigned x; volatile LAS unsigned* st; };
__device__ __forceinline__ XcdBarrier xcd_barrier_post(unsigned* bar, volatile LAS unsigned* st) {
    XcdBarrier b; b.bar = bar; b.x = xb_xcc_id(); b.st = st;
    if (threadIdx.x == 0) (void)xb_add(&bar[XB_XCNT(b.x)], 1u);
    return b;
}
__device__ __forceinline__ void xcd_barrier_complete(unsigned* bar, unsigned x, unsigned& nloc, unsigned& nx) {
    const unsigned G = gridDim.x * gridDim.y * gridDim.z;
    unsigned sum, cnt, mine, sp = 0u;
    for (;;) {
        sum = 0u; cnt = 0u; mine = 0u;
#pragma unroll
        for (unsigned j = 0; j < 16; ++j) { const unsigned c = xb_ld(&bar[XB_XCNT(j)]); sum += c; cnt += (c > 0u) ? 1u : 0u; mine = (j == x) ? c : mine; }
        if (sum == G) break;
        __builtin_amdgcn_s_sleep(1);
        if ((++sp & 255u) == 0u) { if (xb_ld(&bar[XB_TMO])) break; if (sp > XB_SPIN_CAP) { atomicAdd(&bar[XB_TMO], 1u); break; } }
    }
    nloc = mine > 0u ? mine : 1u; nx = cnt > 0u ? cnt : 1u;
}
__device__ __forceinline__ void xcd_barrier(const XcdBarrier& b) {
    asm volatile("s_waitcnt vmcnt(0)" ::: "memory");
    __syncthreads();
    if (threadIdx.x == 0) {
        unsigned* bar = b.bar;
        __builtin_amdgcn_s_waitcnt(0);
        unsigned nloc = b.st[0], nx = b.st[1];
        if (nloc == 0u) { xcd_barrier_complete(bar, b.x, nloc, nx); b.st[0] = nloc; b.st[1] = nx; }
        const unsigned old = xb_add(&bar[XB_XSUB(b.x)], 1u);
        const unsigned gen = old / nloc;
        if (old + 1u == (gen + 1u) * nloc) {
            __builtin_amdgcn_fence(__ATOMIC_RELEASE, "agent");
            asm volatile("s_waitcnt vmcnt(0)" ::: "memory");
            const unsigned og = xb_add(&bar[XB_TOP], 1u);
            const unsigned tg = og / nx;
            if (og + 1u == (tg + 1u) * nx) xb_add(&bar[XB_TOPGEN], 1u);
            else XB_SPIN(xb_ld(&bar[XB_TOPGEN]) == tg, bar);
            __builtin_amdgcn_fence(__ATOMIC_ACQUIRE, "agent");
            xb_add(&bar[XB_XGEN(b.x)], 1u);
            asm volatile("s_waitcnt vmcnt(0)" ::: "memory");
        } else {
            XB_SPIN(xb_ld(&bar[XB_XGEN(b.x)]) == gen, bar);
            __builtin_amdgcn_fence(__ATOMIC_ACQUIRE, "agent");
            asm volatile("s_waitcnt vmcnt(0)" ::: "memory");
        }
    }
    __syncthreads();
}

__global__ void __launch_bounds__(NTHREADS, 2) hymba_fwd(Args args) {
    extern __shared__ __attribute__((aligned(16))) unsigned char lds_raw[];
    cg::grid_group grid = cg::this_grid();
    Frame F;
    F.lds = (LAS unsigned char*)lds_raw;
    F.G = gridDim.x;
    if (threadIdx.x < 64) ((LAS unsigned*)(F.lds + 131072))[threadIdx.x] = 0u;
    __syncthreads();
    const XcdBarrier xbar = xcd_barrier_post((unsigned*)(args.ws + WS_CTL), (volatile LAS unsigned*)(F.lds + 131072));
    if (args.ph_hi > 1000) grid.sync();

    const int lo = args.ph_lo, hi = args.ph_hi;
#define RELAUNDER() do { int tv = threadIdx.x; asm volatile("" : "+v"(tv)); F.tid = tv; F.lane = tv & 63; F.wave = __builtin_amdgcn_readfirstlane(tv >> 6); \
        int bv = blockIdx.x; asm volatile("" : "+s"(bv)); F.bid = bv; \
        const __attribute__((address_space(4))) unsigned long long* kv = (const __attribute__((address_space(4))) unsigned long long*)__builtin_amdgcn_kernarg_segment_ptr(); asm volatile("" : "+s"(kv)); F.kp = kv; \
        F.ws = (unsigned char*)kv[29]; F.out = (float*)kv[28]; } while (0)
#ifndef REPMASK
#define REPMASK 0
#endif
#define PH(k) if (lo <= (k) && (k) < hi) for (int rep_ = 0; rep_ < 1 + ((REPMASK >> (k)) & 1); ++rep_)
#define SEAM(k) do { if ((k) + 1 < hi || rep_ < ((REPMASK >> (k)) & 1)) xcd_barrier(xbar); } while (0)
#define WSB(off) ((bf16_t*)(F.ws + (off)))

    PH(0) { RELAUNDER();
#ifndef NO_P0
        p_prologue(F);
#endif
        SEAM(0); }
    PH(1) { RELAUNDER();
        pg8::Gemm g{WSB(WS_AB), WSB(WS_W1A), MTOK, NFF2, DM, DM}; pg8::StaticOrder S; S.init(MTOK, NFF2, F.G, F.bid); pg8::EpiSwiGLU E{WSB(WS_ACT)};
#ifndef NO_P1
        pg8::gemm_phase<pg8::EpiSwiGLU, DM, DM>(F.lds, g, S, E, F.tid);
#endif
        SEAM(1); }
    PH(2) { RELAUNDER();
        pg8::Gemm g{WSB(WS_ACT), WSB(WS_W1B), MTOK, DM, DFF, DFF}; pg8::StaticOrder S; S.init(MTOK, DM, F.G, F.bid); pg8::EpiResid E{WSB(WS_AB), WSB(WS_Y), ALPHA, 0.5f};
#ifndef NO_P2
        pg8::gemm_phase<pg8::EpiResid, DFF, DFF>(F.lds, g, S, E, F.tid);
#endif
        SEAM(2); }
    PH(3) { RELAUNDER(); p_layernorm<false>(F, WSB(WS_Y), INP(3), INP(4), WSB(WS_AB), nullptr); SEAM(3); }
    PH(4) { RELAUNDER();
        pg8::Gemm g{WSB(WS_AB), WSB(WS_WMI), MTOK, NPROJ, DM, DM}; pg8::StaticOrder S; S.init(MTOK, NPROJ, F.G, F.bid);
        pg8::EpiProj E{WSB(WS_ACT), WSB(WS_KCV), WSB(WS_VT), (const float*)(F.ws + WS_ROPE)};
#ifndef NO_P4
        pg8::gemm_phase<pg8::EpiProj, DM, DM>(F.lds, g, S, E, F.tid);
#endif
        SEAM(4); }
    PH(5) { RELAUNDER();
        const int ncmp = (F.G > 64) ? 32 : 0;
        if (F.bid < 32) {
            const int which = F.bid >> 4;
            pg8::Gemm g{WSB(WS_KCV) + (size_t)which * 32 * 2048 * 64, WSB(WS_WC1) + (size_t)which * 256 * 2048, 4096, 256, 2048, 1024};
            pg8::StaticOrder S; S.init(4096, 256, F.G > 16 ? F.G : 16, F.bid & 15);
            pg8::EpiCmp E{WSB(WS_HID) + (size_t)which * 4096 * 256, (const float*)(F.ws + WS_CBIAS) + which * 256};
#ifndef NO_P5A
            pg8::gemm_phase<pg8::EpiCmp, 2048, 1024>(F.lds, g, S, E, F.tid);
#endif
        }
        if (F.bid >= ncmp) for (int u = F.bid - ncmp; u < 256; u += F.G - ncmp) {
#ifndef NO_P5B
            lru_unit(F, u);
#endif
        }
        SEAM(5); }
    PH(6) { RELAUNDER(); p_kcvc(F); SEAM(6); }
    PH(7) { RELAUNDER();
        for (int L = F.bid; L < 1024; L += F.G) {
            const int rd = L >> 8, c = L & 255, bg = c & 31, a = c >> 5;
            const int qt = rd == 0 ? 31 - a : (rd == 1 ? 16 + a : (rd == 2 ? 15 - a : a));
#ifndef NO_P7
            attn_unit(F, bg >> 1, bg & 1, qt);
#endif
        }
        SEAM(7); }
    PH(8) { RELAUNDER(); p_rmsnorm(F, WSB(WS_Y), INP(19), INP(20)); SEAM(8); }
    PH(9) { RELAUNDER();
        pg8::Gemm g{WSB(WS_Y), WSB(WS_WMO), MTOK, DM, DM, DM}; pg8::StaticOrder S; S.init(MTOK, DM, F.G, F.bid); pg8::EpiResid E{WSB(WS_AB), WSB(WS_ACT), ALPHA, 1.0f};
#ifndef NO_P9
        pg8::gemm_phase<pg8::EpiResid, DM, DM>(F.lds, g, S, E, F.tid);
#endif
        SEAM(9); }
    PH(10) { RELAUNDER(); p_layernorm<false>(F, WSB(WS_ACT), INP(22), INP(23), WSB(WS_AB), nullptr); SEAM(10); }
    PH(11) { RELAUNDER();
        pg8::Gemm g{WSB(WS_AB), WSB(WS_W2A), MTOK, NFF2, DM, DM}; pg8::StaticOrder S; S.init(MTOK, NFF2, F.G, F.bid); pg8::EpiSwiGLU E{WSB(WS_ACT)};
#ifndef NO_P1
        pg8::gemm_phase<pg8::EpiSwiGLU, DM, DM>(F.lds, g, S, E, F.tid);
#endif
        SEAM(11); }
    PH(12) { RELAUNDER();
        pg8::Gemm g{WSB(WS_ACT), WSB(WS_W2B), MTOK, DM, DFF, DFF}; pg8::StaticOrder S; S.init(MTOK, DM, F.G, F.bid); pg8::EpiResid E{WSB(WS_AB), WSB(WS_Y), ALPHA, 0.5f};
#ifndef NO_P2
        pg8::gemm_phase<pg8::EpiResid, DFF, DFF>(F.lds, g, S, E, F.tid);
#endif
        SEAM(12); }
    PH(13) { RELAUNDER(); p_layernorm<true>(F, WSB(WS_Y), INP(26), INP(27), nullptr, F.out); }
}

extern "C" void kernel_launch(void* const* d_in, const int* in_sizes, int n_in, void* d_out, int out_size, void* d_ws, size_t ws_size, hipStream_t stream) {
    static int grid = 0;
    if (grid == 0) {
        if (n_in != 28 || out_size != MTOK * DM || ws_size < WS_END) { fprintf(stderr, "kernel_launch: unexpected shapes (n_in %d out %d ws %zu)\n", n_in, out_size, ws_size); grid = -1; return; }
        int dev = 0, cus = 0, per_cu = 0;
        (void)hipGetDevice(&dev); (void)hipDeviceGetAttribute(&cus, hipDeviceAttributeMultiprocessorCount, dev);
        if (hipFuncSetAttribute((const void*)hymba_fwd, hipFuncAttributeMaxDynamicSharedMemorySize, LDS_BYTES) != hipSuccess) { fprintf(stderr, "kernel_launch: hipFuncSetAttribute failed\n"); grid = -1; return; }
        if (hipOccupancyMaxActiveBlocksPerMultiprocessor(&per_cu, (const void*)hymba_fwd, NTHREADS, LDS_BYTES) != hipSuccess || per_cu < 1) { fprintf(stderr, "kernel_launch: occupancy query failed (%d)\n", per_cu); (void)hipGetLastError(); per_cu = 1; }
        if (per_cu > 1) per_cu = 1;
        grid = cus * per_cu;
        if (grid <= 0) { grid = -1; return; }
    }
    if (grid < 0) return;
    if (hipMemsetAsync((char*)d_ws + WS_CTL, 0, CTL_BYTES, stream) != hipSuccess) { fprintf(stderr, "kernel_launch: memset failed\n"); return; }
    Args a{};
    for (int i = 0; i < 28; ++i) a.in[i] = (const float*)d_in[i];
    a.out = (float*)d_out; a.ws = (unsigned char*)d_ws; a.ph_lo = 0; a.ph_hi = NPHASE;
    void* kargs[] = {&a};
    hipError_t e = hipLaunchCooperativeKernel((const void*)hymba_fwd, dim3(grid), dim3(NTHREADS), kargs, LDS_BYTES, stream);
    if (e != hipSuccess) fprintf(stderr, "kernel_launch: cooperative launch failed: %s (grid %d)\n", hipGetErrorString(e), grid);
}
```

```cpp
#include <hip/hip_runtime.h>
#include <hip/hip_cooperative_groups.h>
#include <cstdio>
#include <cstdint>
namespace cg = cooperative_groups;

#define LAS __attribute__((address_space(3)))
typedef unsigned short bf16_t;
typedef short bf16x8 __attribute__((ext_vector_type(8)));
typedef short s16x4 __attribute__((ext_vector_type(4)));
typedef float f32x4 __attribute__((ext_vector_type(4)));
typedef float f32x16 __attribute__((ext_vector_type(16)));
typedef unsigned u32x4 __attribute__((ext_vector_type(4)));
typedef unsigned u32x2 __attribute__((ext_vector_type(2)));
typedef float f32x2_t __attribute__((ext_vector_type(2)));
typedef __bf16 bf16x2_t __attribute__((ext_vector_type(2)));

constexpr int DM = 1024, NBATCH = 16, SEQ = 2048, MTOK = NBATCH * SEQ;
constexpr int DFF = 2816, NFF2 = 5632, INCOLS = 2328, NPROJ = 2560;
constexpr float ALPHA = 1.189207115002721f;
constexpr float LN_EPS = 1e-5f, RMS_EPS = 1e-6f;
constexpr float L2E = 1.4426950408889634f;

constexpr size_t MiB = 1u << 20;
constexpr size_t WS_W1A = 2 * MiB, WS_W1B = 14 * MiB, WS_WMI = 20 * MiB, WS_WMO = 26 * MiB, WS_W2A = 28 * MiB, WS_W2B = 40 * MiB;
constexpr size_t WS_WC1 = 46 * MiB;
constexpr size_t WS_ROPE = 48 * MiB;
constexpr size_t WS_CBIAS = 48 * MiB + 512 * 1024;
constexpr size_t WS_KC = 49 * MiB;
constexpr size_t WS_VCT = 49 * MiB + 512 * 1024;
constexpr size_t WS_HID = 50 * MiB;
constexpr size_t WS_KCV = 54 * MiB;
constexpr size_t WS_VT = 72 * MiB;
constexpr size_t WS_AB = 96 * MiB;
constexpr size_t WS_Y = 160 * MiB;
constexpr size_t WS_ACT = 224 * MiB;
constexpr size_t WS_END = 400 * MiB;

__device__ __forceinline__ unsigned pk2(float lo, float hi) { f32x2_t v = {lo, hi}; bf16x2_t b = __builtin_convertvector(v, bf16x2_t); return __builtin_bit_cast(unsigned, b); }
__device__ __forceinline__ float bflo(unsigned w) { return __uint_as_float(w << 16); }
__device__ __forceinline__ float bfhi(unsigned w) { return __uint_as_float(w & 0xffff0000u); }
__device__ __forceinline__ float bf2f(bf16_t h) { return __uint_as_float((unsigned)h << 16); }
__device__ __forceinline__ float fsigmoid(float x) { return __builtin_amdgcn_rcpf(1.0f + __builtin_amdgcn_exp2f(-x * L2E)); }
#define LDS_WAIT() asm volatile("s_waitcnt lgkmcnt(0)" ::: "memory")

namespace pg8 {
constexpr int BM = 256, BK = 64, HALF = 128, HTB = HALF * BK * 2, STAGE_BYTES = 8 * HTB, NXCD = 8, WGM = 8;
__host__ __device__ __forceinline__ int lds_byte(int r, int c) { const int st = (r >> 4) * 2 + (c >> 5), rr = r & 15, cc = c & 31, ob = rr * 64 + cc * 2; return st * 1024 + (ob ^ (((ob >> 9) & 1) << 5)); }
__host__ __device__ __forceinline__ void stage_rc(int b, int& R, int& C) { const int st = b / 1024, sb = b % 1024, swz = sb ^ (((sb >> 9) & 1) << 5); R = (st >> 1) * 16 + swz / 64; C = (st & 1) * 32 + (swz % 64) / 2; }
__host__ __device__ __forceinline__ int perm32(int rho) { const int n = rho >> 4, i = rho & 15; return 8 * (i >> 2) + 4 * n + (i & 3); }
struct Unit { int pm, pn; };
struct Gemm { const bf16_t* A; const bf16_t* Bt; int M, N, K, lda; };
struct StaticOrder {
    int nM, nN, nwg, G, c;
    __device__ void init(int M, int N, int G_, int c_) { nM = M / BM; nN = N / BM; nwg = nM * nN; G = G_; c = c_; }
    __device__ bool next(int i, Unit& u) const {
        const long L = (long)i * G + c; if (L >= nwg) return false;
        int wgid = (int)L; { const int q = nwg / NXCD, r = nwg % NXCD, xcd = wgid % NXCD, off = wgid / NXCD; wgid = (xcd < r ? xcd * (q + 1) : r * (q + 1) + (xcd - r) * q) + off; }
        const int nig = WGM * nN, gid = wgid / nig, fm = gid * WGM, gsz = (nM - fm) < WGM ? (nM - fm) : WGM;
        u.pm = fm + ((wgid % nig) % gsz); u.pn = (wgid % nig) / gsz; return true;
    }
};

template <class Epi, int K, int lda>
__device__ __forceinline__ void gemm_phase(LAS unsigned char* lds, const Gemm g, const StaticOrder& S, const Epi& E, const int tid) {
    const int wid = __builtin_amdgcn_readfirstlane(tid >> 6), lane = tid & 63, wr = wid >> 2, wc = wid & 3, fr = lane & 15, fq = lane >> 4;
    constexpr int nt = K / BK;
    unsigned voffA[2], voffB[2];
#pragma unroll
    for (int i = 0; i < 2; ++i) { int R, C; stage_rc(tid * 16 + i * 8192, R, C); const int Rb = Epi::PERM ? ((R & ~31) + perm32(R & 31)) : R;
        voffA[i] = (unsigned)(R * lda + C) * 2u; voffB[i] = (unsigned)(Rb * K + C) * 2u; }
    const size_t kstep = (size_t)(BK * 2);
    const size_t hstepA = (size_t)HALF * lda * 2, hstepB = (size_t)HALF * K * 2;
    const size_t tstepA = 2 * hstepA, tstepB = 2 * hstepB;
    const unsigned ldsw = (unsigned)wid * 1024u;
    const int aoff = lds_byte(wr * 64 + fr, fq * 8), boff = lds_byte(wc * 32 + fr, fq * 8);
#define PG8_SA(b, h) (((b) * 2 + (h)) * HTB)
#define PG8_SB(b, h) ((4 + (b) * 2 + (h)) * HTB)
#define PG8_STAGE(bufoff, gbase, voff) do { _Pragma("unroll") for (int _i = 0; _i < 2; ++_i) \
        __builtin_amdgcn_global_load_lds((const unsigned*)((const char*)(gbase) + (voff)[_i]), (LAS unsigned*)(lds + (bufoff) + ldsw + _i * 8192), 16, 0, 0); } while (0)
#define PG8_LDA(dst, b, h) do { _Pragma("unroll") for (int m = 0; m < 4; ++m) _Pragma("unroll") for (int k = 0; k < 2; ++k) dst[m][k] = *(const LAS bf16x8*)(lds + PG8_SA(b, h) + aoff + m * 2048 + k * 1024); } while (0)
#define PG8_LDB(dst, b, h) do { _Pragma("unroll") for (int n = 0; n < 2; ++n) _Pragma("unroll") for (int k = 0; k < 2; ++k) dst[n][k] = *(const LAS bf16x8*)(lds + PG8_SB(b, h) + boff + n * 2048 + k * 1024); } while (0)
#define PG8_MMA(ai, bj, At, Bt) do { __builtin_amdgcn_s_setprio(1); _Pragma("unroll") for (int m = 0; m < 4; ++m) _Pragma("unroll") for (int n = 0; n < 2; ++n) _Pragma("unroll") for (int k = 0; k < 2; ++k) \
        acc[ai][bj][m][n] = __builtin_amdgcn_mfma_f32_16x16x32_bf16(Bt[n][k], At[m][k], acc[ai][bj][m][n], 0, 0, 0); __builtin_amdgcn_s_setprio(0); } while (0)
#define PG8_WAIT_V(n) asm volatile("s_waitcnt vmcnt(" #n ")" ::: "memory")
#define PG8_WAIT_L(n) asm volatile("s_waitcnt lgkmcnt(" #n ")" ::: "memory")
#define PG8_BAR __builtin_amdgcn_s_barrier()
#define PG8_SCHED __builtin_amdgcn_sched_barrier(0)
    Unit cur, nxt; int ui = 0;
    if (!S.next(0, cur)) return;
    f32x4 acc[2][2][4][2];
#pragma unroll
    for (int a = 0; a < 2; ++a)
#pragma unroll
        for (int b = 0; b < 2; ++b)
#pragma unroll
            for (int m = 0; m < 4; ++m)
#pragma unroll
                for (int n = 0; n < 2; ++n) acc[a][b][m][n] = (f32x4){0.f, 0.f, 0.f, 0.f};
    bf16x8 At[4][2], B0[2][2], B1[2][2];
    const char* cA = (const char*)g.A + (size_t)cur.pm * tstepA; const char* cB = (const char*)g.Bt + (size_t)cur.pn * tstepB;
    PG8_STAGE(PG8_SB(0, 0), cB, voffB); PG8_STAGE(PG8_SB(0, 1), cB + hstepB, voffB); PG8_STAGE(PG8_SA(0, 0), cA, voffA); PG8_STAGE(PG8_SA(0, 1), cA + hstepA, voffA);
    if (wr == 1) PG8_BAR;
    PG8_WAIT_V(2); PG8_BAR;
    PG8_STAGE(PG8_SB(1, 0), cB + kstep, voffB); PG8_STAGE(PG8_SA(1, 0), cA + kstep, voffA); PG8_STAGE(PG8_SB(1, 1), cB + hstepB + kstep, voffB);
    PG8_WAIT_V(6); PG8_BAR;
    for (;;) {
        const bool has_next = S.next(ui + 1, nxt);
        const char* nA = has_next ? (const char*)g.A + (size_t)nxt.pm * tstepA : cA; const char* nB = has_next ? (const char*)g.Bt + (size_t)nxt.pn * tstepB : cB;
        for (int t = 0; t < nt; t += 2) {
            const bool last = (t == nt - 2);
            const char* a1 = cA + (size_t)(t + 1) * kstep;
            const char* a2 = last ? nA : cA + (size_t)(t + 2) * kstep; const char* b2 = last ? nB : cB + (size_t)(t + 2) * kstep;
            const char* a3 = a2 + kstep; const char* b3 = b2 + kstep;
            PG8_LDB(B0, 0, 0); PG8_LDB(B1, 0, 1); PG8_SCHED; PG8_LDA(At, 0, 0); PG8_STAGE(PG8_SA(1, 1), a1 + hstepA, voffA);
            PG8_WAIT_V(8); PG8_WAIT_L(0); PG8_BAR; PG8_MMA(0, 0, At, B0); PG8_MMA(0, 1, At, B1); PG8_BAR; PG8_SCHED;
            PG8_LDA(At, 0, 1); PG8_STAGE(PG8_SB(0, 0), b2, voffB); PG8_STAGE(PG8_SB(0, 1), b2 + hstepB, voffB); PG8_STAGE(PG8_SA(0, 0), a2, voffA);
            PG8_WAIT_V(8); PG8_WAIT_L(0); PG8_BAR; PG8_MMA(1, 0, At, B0); PG8_MMA(1, 1, At, B1); PG8_BAR; PG8_SCHED;
            PG8_LDB(B0, 1, 0); PG8_LDB(B1, 1, 1); PG8_SCHED; PG8_LDA(At, 1, 0); PG8_STAGE(PG8_SA(0, 1), a2 + hstepA, voffA);
            PG8_WAIT_V(8); PG8_WAIT_L(0); PG8_BAR; PG8_MMA(0, 0, At, B0); PG8_MMA(0, 1, At, B1); PG8_BAR; PG8_SCHED;
            PG8_LDA(At, 1, 1); PG8_STAGE(PG8_SB(1, 0), b3, voffB); PG8_STAGE(PG8_SB(1, 1), b3 + hstepB, voffB); PG8_STAGE(PG8_SA(1, 0), a3, voffA);
            PG8_WAIT_V(8); PG8_WAIT_L(0); PG8_BAR; PG8_MMA(1, 0, At, B0); PG8_MMA(1, 1, At, B1); PG8_BAR; PG8_SCHED;
        }
        if (wr == 0) PG8_BAR;
        E(acc, cur, wr, wc, fr, fq);
        if (!has_next) break;
#pragma unroll
        for (int a = 0; a < 2; ++a)
#pragma unroll
            for (int b = 0; b < 2; ++b)
#pragma unroll
                for (int m = 0; m < 4; ++m)
#pragma unroll
                    for (int n = 0; n < 2; ++n) acc[a][b][m][n] = (f32x4){0.f, 0.f, 0.f, 0.f};
        cur = nxt; cA = nA; cB = nB; ++ui;
        if (wr == 1) PG8_BAR;
    }
    PG8_WAIT_V(0);
    PG8_BAR;
#undef PG8_SA
#undef PG8_SB
#undef PG8_STAGE
#undef PG8_LDA
#undef PG8_LDB
#undef PG8_MMA
#undef PG8_WAIT_V
#undef PG8_WAIT_L
#undef PG8_BAR
#undef PG8_SCHED
}

struct EpiSwiGLU {
    static constexpr bool PERM = true;
    bf16_t* O;
    __device__ __forceinline__ void operator()(const f32x4 (&acc)[2][2][4][2], const Unit& u, int wr, int wc, int fr, int fq) const {
        const int col = u.pn * 128 + wc * 32 + 8 * fq;
#pragma unroll
        for (int ai = 0; ai < 2; ++ai)
#pragma unroll
            for (int m = 0; m < 4; ++m) {
                const int row = u.pm * BM + ai * HALF + wr * 64 + m * 16 + fr;
                float o[8];
#pragma unroll
                for (int n = 0; n < 2; ++n)
#pragma unroll
                    for (int e = 0; e < 4; ++e) { const float gv = acc[ai][0][m][n][e], uv = acc[ai][1][m][n][e]; o[4 * n + e] = gv * fsigmoid(gv) * uv; }
                u32x4 w; w.x = pk2(o[0], o[1]); w.y = pk2(o[2], o[3]); w.z = pk2(o[4], o[5]); w.w = pk2(o[6], o[7]);
                *(u32x4*)(O + (size_t)row * DFF + col) = w;
            }
    }
};
struct EpiResid {
    static constexpr bool PERM = true;
    const bf16_t* res; bf16_t* out; float alpha, scale;
    __device__ __forceinline__ void operator()(const f32x4 (&acc)[2][2][4][2], const Unit& u, int wr, int wc, int fr, int fq) const {
        const int col0 = u.pn * BM + wc * 32 + 8 * fq;
#pragma unroll
        for (int ai = 0; ai < 2; ++ai)
#pragma unroll
            for (int m = 0; m < 4; ++m) {
                const size_t off = (size_t)(u.pm * BM + ai * HALF + wr * 64 + m * 16 + fr) * DM + col0;
#pragma unroll
                for (int bj = 0; bj < 2; ++bj) {
                    const u32x4 rv = *(const u32x4*)(res + off + bj * HALF);
                    const f32x4 a0 = acc[ai][bj][m][0], a1 = acc[ai][bj][m][1];
                    u32x4 w;
                    w.x = pk2(alpha * bflo(rv.x) + scale * a0[0], alpha * bfhi(rv.x) + scale * a0[1]); w.y = pk2(alpha * bflo(rv.y) + scale * a0[2], alpha * bfhi(rv.y) + scale * a0[3]);
                    w.z = pk2(alpha * bflo(rv.z) + scale * a1[0], alpha * bfhi(rv.z) + scale * a1[1]); w.w = pk2(alpha * bflo(rv.w) + scale * a1[2], alpha * bfhi(rv.w) + scale * a1[3]);
                    *(u32x4*)(out + off + bj * HALF) = w;
                }
            }
    }
};
struct EpiProj {
    static constexpr bool PERM = true;
    bf16_t* PROJ; bf16_t* KCV; bf16_t* VT; const float* ROPE;
    __device__ __forceinline__ void operator()(const f32x4 (&acc)[2][2][4][2], const Unit& u, int wr, int wc, int fr, int fq) const {
        const int pn = u.pn, hc = 32 * wc + 8 * fq;
#pragma unroll
        for (int ai = 0; ai < 2; ++ai)
#pragma unroll
            for (int m = 0; m < 4; ++m) {
                const int row = u.pm * BM + ai * HALF + wr * 64 + m * 16 + fr, b = row >> 11, t = row & 2047;
#pragma unroll
                for (int bj = 0; bj < 2; ++bj) {
                    f32x4 v0 = acc[ai][bj][m][0], v1 = acc[ai][bj][m][1];
                    const bool isq = (pn == 4 || pn == 5);
                    const bool rope = isq || (pn >= 6 && pn <= 8 && bj == 0);
                    if (rope) {
                        const int i0 = (hc & 63) >> 1;
                        const f32x4* rp = (const f32x4*)(ROPE + ((size_t)t * 32 + i0) * 2);
                        const f32x4 c0 = rp[0], c1 = rp[1];
                        float a, bb;
                        a = v0[0] * c0[0] - v0[1] * c0[1]; bb = v0[1] * c0[0] + v0[0] * c0[1]; v0[0] = a; v0[1] = bb;
                        a = v0[2] * c0[2] - v0[3] * c0[3]; bb = v0[3] * c0[2] + v0[2] * c0[3]; v0[2] = a; v0[3] = bb;
                        a = v1[0] * c1[0] - v1[1] * c1[1]; bb = v1[1] * c1[0] + v1[0] * c1[1]; v1[0] = a; v1[1] = bb;
                        a = v1[2] * c1[2] - v1[3] * c1[3]; bb = v1[3] * c1[2] + v1[2] * c1[3]; v1[2] = a; v1[3] = bb;
                        if (isq) { v0 = v0 * 0.125f; v1 = v1 * 0.125f; }
                    }
                    u32x4 w; w.x = pk2(v0[0], v0[1]); w.y = pk2(v0[2], v0[3]); w.z = pk2(v1[0], v1[1]); w.w = pk2(v1[2], v1[3]);
                    if (pn == 6) {
                        const int gg = hc >> 6, d = hc & 63;
                        *(u32x4*)(KCV + (((size_t)(bj * 32 + b * 2 + gg)) * 2048 + t) * 64 + d) = w;
                    } else if ((pn == 7 || pn == 8) && bj == 1) {
                        const int gg = hc >> 6, d = hc & 63;
                        bf16_t* vp = VT + (((size_t)((pn - 7) * 32 + b * 2 + gg)) * 64 + d) * 2048 + t;
                        vp[0 * 2048] = (bf16_t)(w.x & 0xffffu); vp[1 * 2048] = (bf16_t)(w.x >> 16); vp[2 * 2048] = (bf16_t)(w.y & 0xffffu); vp[3 * 2048] = (bf16_t)(w.y >> 16);
                        vp[4 * 2048] = (bf16_t)(w.z & 0xffffu); vp[5 * 2048] = (bf16_t)(w.z >> 16); vp[6 * 2048] = (bf16_t)(w.w & 0xffffu); vp[7 * 2048] = (bf16_t)(w.w >> 16);
                    } else {
                        *(u32x4*)(PROJ + (size_t)row * NPROJ + 256 * pn + 128 * bj + hc) = w;
                    }
                    asm volatile("" ::: "memory");
                }
            }
    }
};
struct EpiCmp {
    static constexpr bool PERM = true;
    bf16_t* O; const float* bias;
    __device__ __forceinline__ void operator()(const f32x4 (&acc)[2][2][4][2], const Unit& u, int wr, int wc, int fr, int fq) const {
#pragma unroll
        for (int ai = 0; ai < 2; ++ai)
#pragma unroll
            for (int m = 0; m < 4; ++m) {
                const int row = u.pm * BM + ai * HALF + wr * 64 + m * 16 + fr;
#pragma unroll
                for (int bj = 0; bj < 2; ++bj) {
                    const int col = 128 * bj + 32 * wc + 8 * fq;
                    const f32x4 b0 = *(const f32x4*)(bias + col), b1 = *(const f32x4*)(bias + col + 4);
                    f32x4 v0 = acc[ai][bj][m][0] + b0, v1 = acc[ai][bj][m][1] + b1;
#pragma unroll
                    for (int e = 0; e < 4; ++e) { v0[e] = v0[e] * fsigmoid(v0[e]); v1[e] = v1[e] * fsigmoid(v1[e]); }
                    u32x4 w; w.x = pk2(v0[0], v0[1]); w.y = pk2(v0[2], v0[3]); w.z = pk2(v1[0], v1[1]); w.w = pk2(v1[2], v1[3]);
                    *(u32x4*)(O + (size_t)row * 256 + col) = w;
                }
                asm volatile("" ::: "memory");
            }
    }
};
}

constexpr int NWAVES = 8, NTHREADS = 512;
constexpr int LDS_BYTES = 131072 + 256;
constexpr size_t WS_CTL = 0, CTL_BYTES = 16384;
constexpr int NPHASE = 14;

struct Args { const float* in[28]; float* out; unsigned char* ws; int ph_lo, ph_hi; };

#define INP(k) ((const float*)F.kp[(k)])
struct Frame {
    LAS unsigned char* lds;
    int tid, lane, wave, G, bid;
    const __attribute__((address_space(4))) unsigned long long* kp;
    float* out; unsigned char* ws;
};

__device__ __forceinline__ float wave_sum(float v) {
#pragma unroll
    for (int o = 1; o < 64; o <<= 1) v += __shfl_xor(v, o);
    return v;
}
__device__ __forceinline__ int rope_d(int d) { return d < 32 ? 2 * d : 2 * (d - 32) + 1; }
__device__ __forceinline__ int map_swiglu(int n) { const int h = n >= DFF ? 1 : 0; const int c = n - h * DFF; return 256 * (c >> 7) + 128 * h + (c & 127); }
__device__ __forceinline__ int map_proj(int n) { const bool roped = (n >= 1024 && n < 1664) || (n >= 1792 && n < 1920) || (n >= 2048 && n < 2176); return roped ? ((n & ~63) + rope_d(n & 63)) : n; }

template <int MAP, bool KPERM>
__device__ __forceinline__ void tr_item(const float* W, int K, int N, bf16_t* WT, LAS float* scr, int item, int lane) {
    const int nblk = (N + 31) / 32, kb = item / nblk, nb = item % nblk, k0 = 64 * kb, n0 = 32 * nb;
    const int n4 = (lane & 7) * 4; const bool ok = (n0 + n4) < N;
    f32x4 ld[8];
#pragma unroll
    for (int i = 0; i < 8; ++i) { const int kk = 8 * i + (lane >> 3); ld[i] = ok ? *(const f32x4*)(W + (size_t)(k0 + kk) * N + n0 + n4) : (f32x4){0.f, 0.f, 0.f, 0.f}; }
#pragma unroll
    for (int i = 0; i < 8; ++i) { const int kk = 8 * i + (lane >> 3); LAS float* d = scr + kk * 33 + n4; d[0] = ld[i][0]; d[1] = ld[i][1]; d[2] = ld[i][2]; d[3] = ld[i][3]; }
    LDS_WAIT(); asm volatile("" ::: "memory");
    const int c = lane & 7;
#pragma unroll
    for (int j = 0; j < 4; ++j) {
        const int n = (lane >> 3) + 8 * j;
        if (n0 + n < N) {
            const LAS float* s = scr + n;
            float e[8];
#pragma unroll
            for (int q = 0; q < 8; ++q) { const int kk = KPERM ? ((q & 1) * 32 + 4 * c + (q >> 1)) : (8 * c + q); e[q] = s[kk * 33]; }
            const int dn = MAP == 1 ? map_swiglu(n0 + n) : (MAP == 2 ? map_proj(n0 + n) : (n0 + n));
            u32x4 o; o.x = pk2(e[0], e[1]); o.y = pk2(e[2], e[3]); o.z = pk2(e[4], e[5]); o.w = pk2(e[6], e[7]);
            *(u32x4*)(WT + (size_t)dn * K + k0 + 8 * c) = o;
        }
    }
    LDS_WAIT(); asm volatile("" ::: "memory");
}

__device__ __forceinline__ void p_prologue(Frame& F) {
    LAS float* scr = (LAS float*)(F.lds + F.wave * 16384);
    const int gw = F.bid * NWAVES + F.wave, NGW = F.G * NWAVES;
    bf16_t* W1A = (bf16_t*)(F.ws + WS_W1A); bf16_t* W1B = (bf16_t*)(F.ws + WS_W1B); bf16_t* WMI = (bf16_t*)(F.ws + WS_WMI); bf16_t* WMO = (bf16_t*)(F.ws + WS_WMO);
    bf16_t* W2A = (bf16_t*)(F.ws + WS_W2A); bf16_t* W2B = (bf16_t*)(F.ws + WS_W2B); bf16_t* WC1 = (bf16_t*)(F.ws + WS_WC1);
    constexpr int I_A = (DM / 64) * (NFF2 / 32), I_B = (DFF / 64) * (DM / 32), I_MI = (DM / 64) * ((INCOLS + 31) / 32), I_MO = (DM / 64) * (DM / 32), I_C = (2048 / 64) * (256 / 32);
    constexpr int NITEMS = 2 * I_A + 2 * I_B + I_MI + I_MO + 2 * I_C;
    for (int it = gw; it < NITEMS; it += NGW) {
        int r = it;
        if (r < I_A) { tr_item<1, false>(INP(1), DM, NFF2, W1A, scr, r, F.lane); continue; } r -= I_A;
        if (r < I_A) { tr_item<1, false>(INP(24), DM, NFF2, W2A, scr, r, F.lane); continue; } r -= I_A;
        if (r < I_B) { tr_item<0, false>(INP(2), DFF, DM, W1B, scr, r, F.lane); continue; } r -= I_B;
        if (r < I_B) { tr_item<0, false>(INP(25), DFF, DM, W2B, scr, r, F.lane); continue; } r -= I_B;
        if (r < I_MI) { tr_item<2, false>(INP(5), DM, INCOLS, WMI, scr, r, F.lane); continue; } r -= I_MI;
        if (r < I_MO) { tr_item<0, false>(INP(21), DM, DM, WMO, scr, r, F.lane); continue; } r -= I_MO;
        if (r < I_C) { tr_item<0, true>(INP(14), 2048, 256, WC1, scr, r, F.lane); continue; } r -= I_C;
        tr_item<0, false>(INP(17), 2048, 256, WC1 + (size_t)256 * 2048, scr, r, F.lane);
    }
    const int gt = F.bid * NTHREADS + F.tid, NGT = F.G * NTHREADS;
    { u32x4* z = (u32x4*)(WMI + (size_t)INCOLS * DM); const int nz = (NPROJ - INCOLS) * DM / 8;
      for (int i = gt; i < nz; i += NGT) z[i] = (u32x4){0u, 0u, 0u, 0u}; }
    { float* R = (float*)(F.ws + WS_ROPE);
      for (int i = gt; i < 2048 * 32; i += NGT) {
          const int t = i >> 5, k = i & 31;
          const float inv = __builtin_amdgcn_exp2f(-(float)k * 0.41524101186092029f);
          const float ang = (float)t * inv;
          const float kk = rintf(ang * 0.15915494309189535f);
          float rr = fmaf(-kk, 6.28318548202514648f, ang); rr = fmaf(-kk, -1.74845553e-7f, rr);
          const float fr = rr * 0.15915494309189535f;
          R[2 * i] = __builtin_amdgcn_cosf(fr); R[2 * i + 1] = __builtin_amdgcn_sinf(fr);
      } }
    { const float* x = INP(0); bf16_t* XB = (bf16_t*)(F.ws + WS_AB);
      for (int m = 2 * gw; m < MTOK; m += 2 * NGW) {
          const f32x4* xr = (const f32x4*)(x + (size_t)m * DM) + F.lane; u32x2* o = (u32x2*)(XB + (size_t)m * DM) + F.lane;
          f32x4 v[8];
#pragma unroll
          for (int j = 0; j < 8; ++j) v[j] = xr[64 * j];
#pragma unroll
          for (int j = 0; j < 8; ++j) o[64 * j] = (u32x2){pk2(v[j][0], v[j][1]), pk2(v[j][2], v[j][3])};
      } }
    if (F.bid < 64) {
        __syncthreads();
        const int wsel = F.bid >> 5, nb0 = (F.bid & 31) * 8;
        const float* pe = INP(wsel == 0 ? 13 : 16); const float* w1 = INP(wsel == 0 ? 14 : 17);
        float acc8[8];
#pragma unroll
        for (int e = 0; e < 8; ++e) acc8[e] = 0.f;
#pragma unroll
        for (int r4 = 0; r4 < 4; ++r4) {
            const int kk = F.tid * 4 + r4; const float pv = pe[kk];
            const f32x4 a = *(const f32x4*)(w1 + (size_t)kk * 256 + nb0), b = *(const f32x4*)(w1 + (size_t)kk * 256 + nb0 + 4);
            acc8[0] += pv * a[0]; acc8[1] += pv * a[1]; acc8[2] += pv * a[2]; acc8[3] += pv * a[3]; acc8[4] += pv * b[0]; acc8[5] += pv * b[1]; acc8[6] += pv * b[2]; acc8[7] += pv * b[3];
        }
        LAS float* red = (LAS float*)F.lds;
#pragma unroll
        for (int e = 0; e < 8; ++e) { const float sv = wave_sum(acc8[e]); if (F.lane == 0) red[F.wave * 8 + e] = sv; }
        __syncthreads();
        if (F.tid < 8) { float t = 0.f;
#pragma unroll
            for (int wv = 0; wv < 8; ++wv) t += red[wv * 8 + F.tid];
            ((float*)(F.ws + WS_CBIAS))[wsel * 256 + nb0 + F.tid] = t; }
        __syncthreads();
    }
}

template <bool OUT_F32>
__device__ __forceinline__ void p_layernorm(Frame& F, const bf16_t* Z, const float* g, const float* bta, bf16_t* OB, float* OF) {
    const int gw = F.bid * NWAVES + F.wave, NGW = F.G * NWAVES;
    float gv[16], bv[16];
#pragma unroll
    for (int e = 0; e < 16; ++e) { gv[e] = g[16 * F.lane + e]; bv[e] = bta[16 * F.lane + e]; }
    for (int m = 2 * gw; m < MTOK; m += 2 * NGW) {
        u32x4 raw[2][2];
#pragma unroll
        for (int rr = 0; rr < 2; ++rr) { const u32x4* zr = (const u32x4*)(Z + (size_t)(m + rr) * DM + 16 * F.lane); raw[rr][0] = zr[0]; raw[rr][1] = zr[1]; }
#pragma unroll
        for (int rr = 0; rr < 2; ++rr) {
            float v[16];
            const u32x4 a = raw[rr][0], b = raw[rr][1];
            v[0] = bflo(a.x); v[1] = bfhi(a.x); v[2] = bflo(a.y); v[3] = bfhi(a.y); v[4] = bflo(a.z); v[5] = bfhi(a.z); v[6] = bflo(a.w); v[7] = bfhi(a.w);
            v[8] = bflo(b.x); v[9] = bfhi(b.x); v[10] = bflo(b.y); v[11] = bfhi(b.y); v[12] = bflo(b.z); v[13] = bfhi(b.z); v[14] = bflo(b.w); v[15] = bfhi(b.w);
            float s = 0.f;
#pragma unroll
            for (int e = 0; e < 16; ++e) s += v[e];
            const float mean = wave_sum(s) * (1.f / DM); float s2 = 0.f;
#pragma unroll
            for (int e = 0; e < 16; ++e) { v[e] -= mean; s2 += v[e] * v[e]; }
            const float rstd = 1.f / sqrtf(wave_sum(s2) * (1.f / DM) + LN_EPS);
#pragma unroll
            for (int e = 0; e < 16; ++e) v[e] = v[e] * rstd * gv[e] + bv[e];
            if (OUT_F32) {
                f32x4* o = (f32x4*)(OF + (size_t)(m + rr) * DM + 16 * F.lane);
                o[0] = (f32x4){v[0], v[1], v[2], v[3]}; o[1] = (f32x4){v[4], v[5], v[6], v[7]}; o[2] = (f32x4){v[8], v[9], v[10], v[11]}; o[3] = (f32x4){v[12], v[13], v[14], v[15]};
            } else {
                u32x4* o = (u32x4*)(OB + (size_t)(m + rr) * DM + 16 * F.lane);
                u32x4 oa, ob; oa.x = pk2(v[0], v[1]); oa.y = pk2(v[2], v[3]); oa.z = pk2(v[4], v[5]); oa.w = pk2(v[6], v[7]);
                ob.x = pk2(v[8], v[9]); ob.y = pk2(v[10], v[11]); ob.z = pk2(v[12], v[13]); ob.w = pk2(v[14], v[15]);
                o[0] = oa; o[1] = ob;
            }
        }
    }
}

__device__ __forceinline__ void p_rmsnorm(Frame& F, bf16_t* Y, const float* gl, const float* gn) {
    const int gw = F.bid * NWAVES + F.wave, NGW = F.G * NWAVES;
    const float* gp = (F.lane < 32) ? (gl + 16 * F.lane) : (gn + 16 * (F.lane - 32));
    float gvv[16];
#pragma unroll
    for (int e = 0; e < 16; ++e) gvv[e] = gp[e];
    for (int m = gw; m < MTOK; m += NGW) {
        u32x4* yr = (u32x4*)(Y + (size_t)m * DM + 16 * F.lane);
        const u32x4 a = yr[0], b = yr[1];
        float v[16];
        v[0] = bflo(a.x); v[1] = bfhi(a.x); v[2] = bflo(a.y); v[3] = bfhi(a.y); v[4] = bflo(a.z); v[5] = bfhi(a.z); v[6] = bflo(a.w); v[7] = bfhi(a.w);
        v[8] = bflo(b.x); v[9] = bfhi(b.x); v[10] = bflo(b.y); v[11] = bfhi(b.y); v[12] = bflo(b.z); v[13] = bfhi(b.z); v[14] = bflo(b.w); v[15] = bfhi(b.w);
        float s = 0.f;
#pragma unroll
        for (int e = 0; e < 16; ++e) s += v[e] * v[e];
#pragma unroll
        for (int o = 1; o < 32; o <<= 1) s += __shfl_xor(s, o);
        const float r = 1.f / sqrtf(s * (1.f / 512.f) + RMS_EPS);
#pragma unroll
        for (int e = 0; e < 16; ++e) v[e] = v[e] * r * gvv[e];
        u32x4 oa, ob; oa.x = pk2(v[0], v[1]); oa.y = pk2(v[2], v[3]); oa.z = pk2(v[4], v[5]); oa.w = pk2(v[6], v[7]);
        ob.x = pk2(v[8], v[9]); ob.y = pk2(v[10], v[11]); ob.z = pk2(v[12], v[13]); ob.w = pk2(v[14], v[15]);
        yr[0] = oa; yr[1] = ob;
    }
}

__device__ __forceinline__ void p_kcvc(Frame& F) {
    const int gw = F.bid * NWAVES + F.wave, NGW = F.G * NWAVES;
    const bf16_t* HID = (const bf16_t*)(F.ws + WS_HID); bf16_t* KC = (bf16_t*)(F.ws + WS_KC); bf16_t* VCT = (bf16_t*)(F.ws + WS_VCT);
    for (int it = gw; it < 2 * 4096; it += NGW) {
        const int which = it >> 12, row = it & 4095, d = F.lane;
        const float* w2 = INP(which == 0 ? 15 : 18);
        const u32x4* hr = (const u32x4*)(HID + ((size_t)which * 4096 + row) * 256);
        float s = 0.f;
        for (int j8 = 0; j8 < 32; ++j8) {
            const u32x4 h = hr[j8]; const float* wp = w2 + (size_t)(8 * j8) * 64 + d;
            s += bflo(h.x) * wp[0] + bfhi(h.x) * wp[64] + bflo(h.y) * wp[128] + bfhi(h.y) * wp[192] + bflo(h.z) * wp[256] + bfhi(h.z) * wp[320] + bflo(h.w) * wp[384] + bfhi(h.w) * wp[448];
        }
        const unsigned hb = pk2(s, 0.f) & 0xffffu;
        if (which == 0) KC[(size_t)row * 64 + rope_d(d)] = (bf16_t)hb;
        else { const int bg = row >> 7, n = row & 127; VCT[((size_t)bg * 64 + d) * 128 + n] = (bf16_t)hb; }
    }
}

constexpr int LR2_XC = 0, LR2_XCW = 9216, LR2_SUM = 8 * 9216;
__device__ __forceinline__ void lru_unit(Frame& F, int u) {
    const int b = u >> 4, h = (u >> 1) & 7, jh = u & 1;
    const int lane = F.lane, w = F.wave, quad = lane >> 4, l16 = lane & 15, ca0 = 8 * (lane & 7), tg = lane >> 3;
    const bf16_t* PROJ = (const bf16_t*)(F.ws + WS_ACT); bf16_t* Y = (bf16_t*)(F.ws + WS_Y);
    LAS unsigned char* xc = F.lds + LR2_XC + w * LR2_XCW;
    LAS float* SUM = (LAS float*)(F.lds + LR2_SUM);
    bf16x8 wf[2][2][2];
#pragma unroll
    for (int gsel = 0; gsel < 2; ++gsel)
#pragma unroll
        for (int nt = 0; nt < 2; ++nt)
#pragma unroll
            for (int sk = 0; sk < 2; ++sk) {
                const float* wsrc = INP(gsel == 0 ? 8 : 10) + ((size_t)(h * 64 + sk * 32 + quad * 8)) * 64 + 32 * jh + nt * 16 + l16;
                u32x4 pw; pw.x = pk2(wsrc[0], wsrc[64]); pw.y = pk2(wsrc[128], wsrc[192]); pw.z = pk2(wsrc[256], wsrc[320]); pw.w = pk2(wsrc[384], wsrc[448]);
                wf[gsel][nt][sk] = __builtin_bit_cast(bf16x8, pw);
            }
    float ba[2], bx[2], c8[2];
#pragma unroll
    for (int nt = 0; nt < 2; ++nt) { const int c = 64 * h + 32 * jh + nt * 16 + l16; ba[nt] = INP(9)[c]; bx[nt] = INP(11)[c]; c8[nt] = 8.0f * log1pf(expf(-INP(12)[c])); }
    float cw[4][8], cb[8];
#pragma unroll
    for (int e = 0; e < 8; ++e) { cb[e] = INP(7)[64 * h + ca0 + e];
#pragma unroll
        for (int jt = 0; jt < 4; ++jt) cw[jt][e] = INP(6)[jt * 512 + 64 * h + ca0 + e]; }
    float hin[2] = {0.f, 0.f};
#pragma unroll 1
    for (int pass = 0; pass < 2; ++pass) {
        float hc[2] = {hin[0], hin[1]}, pc[2] = {1.f, 1.f};
#pragma unroll 1
        for (int sub = 0; sub < 4; ++sub) {
            const int t0 = 256 * w + 64 * sub;
            {
                u32x4 raw[11];
#pragma unroll
                for (int k = 0; k < 11; ++k) { const int ts = t0 + 8 * tg - 3 + k; raw[k] = (ts >= 0) ? *(const u32x4*)(PROJ + ((size_t)(b * 2048 + ts)) * NPROJ + 64 * h + ca0) : (u32x4){0u, 0u, 0u, 0u}; }
#pragma unroll
                for (int i = 0; i < 8; ++i) {
                    float a[8];
#pragma unroll
                    for (int e = 0; e < 8; ++e) a[e] = cb[e];
#pragma unroll
                    for (int jt = 0; jt < 4; ++jt) { const u32x4 rw = raw[i + jt];
                        a[0] += cw[jt][0] * bflo(rw.x); a[1] += cw[jt][1] * bfhi(rw.x); a[2] += cw[jt][2] * bflo(rw.y); a[3] += cw[jt][3] * bfhi(rw.y);
                        a[4] += cw[jt][4] * bflo(rw.z); a[5] += cw[jt][5] * bfhi(rw.z); a[6] += cw[jt][6] * bflo(rw.w); a[7] += cw[jt][7] * bfhi(rw.w); }
                    u32x4 pw; pw.x = pk2(a[0], a[1]); pw.y = pk2(a[2], a[3]); pw.z = pk2(a[4], a[5]); pw.w = pk2(a[6], a[7]);
                    *(LAS u32x4*)(xc + (8 * tg + i) * 144 + ca0 * 2) = pw;
                }
            }
#pragma unroll 1
            for (int mt = 0; mt < 4; ++mt) {
                const bf16x8 af0 = *(const LAS bf16x8*)(xc + (16 * mt + l16) * 144 + (quad * 8) * 2), af1 = *(const LAS bf16x8*)(xc + (16 * mt + l16) * 144 + (32 + quad * 8) * 2);
                const int trow = t0 + 16 * mt + quad * 4;
                float gt[2][4];
                if (pass == 1) {
#pragma unroll
                    for (int nt = 0; nt < 2; ++nt)
#pragma unroll
                        for (int j = 0; j < 4; ++j) gt[nt][j] = bf2f(PROJ[((size_t)(b * 2048 + trow + j)) * NPROJ + 512 + 64 * h + 32 * jh + nt * 16 + l16]);
                }
                f32x4 acc[2][2];
#pragma unroll
                for (int gsel = 0; gsel < 2; ++gsel)
#pragma unroll
                    for (int nt = 0; nt < 2; ++nt) { f32x4 c = {0.f, 0.f, 0.f, 0.f}; c = __builtin_amdgcn_mfma_f32_16x16x32_bf16(af0, wf[gsel][nt][0], c, 0, 0, 0); c = __builtin_amdgcn_mfma_f32_16x16x32_bf16(af1, wf[gsel][nt][1], c, 0, 0, 0); acc[gsel][nt] = c; }
#pragma unroll
                for (int nt = 0; nt < 2; ++nt) {
                    float av[4], uv[4];
#pragma unroll
                    for (int j = 0; j < 4; ++j) {
                        const float xcv = bf2f(*(const LAS bf16_t*)(xc + (16 * mt + quad * 4 + j) * 144 + (32 * jh + nt * 16 + l16) * 2));
                        const float r = fsigmoid(acc[0][nt][j] + ba[nt]), ig = fsigmoid(acc[1][nt][j] + bx[nt]);
                        const float la = -c8[nt] * r, x2 = 2.0f * la;
                        av[j] = __builtin_amdgcn_exp2f(la * L2E);
                        const float em = (x2 > -0.3f) ? x2 * (1.0f + x2 * (0.5f + x2 * (0.16666667f + x2 * (0.041666668f + x2 * (0.0083333338f + x2 * 0.0013888889f)))))
                                                      : (__builtin_amdgcn_exp2f(x2 * L2E) - 1.0f);
                        const float mult = (trow + j == 0) ? 1.0f : __builtin_amdgcn_sqrtf(-em);
                        uv[j] = mult * ig * xcv;
                    }
                    float P = av[0], H = uv[0];
#pragma unroll
                    for (int j = 1; j < 4; ++j) { H = av[j] * H + uv[j]; P *= av[j]; }
                    float Pp = __shfl_up(P, 16), Hp = __shfl_up(H, 16);
                    if (quad >= 1) { H = P * Hp + H; P = Pp * P; }
                    Pp = __shfl_up(P, 32); Hp = __shfl_up(H, 32);
                    if (quad >= 2) { H = P * Hp + H; P = Pp * P; }
                    const float Pt = __shfl(P, 48 + l16), Ht = __shfl(H, 48 + l16);
                    if (pass == 1) {
                        float Pe = __shfl_up(P, 16), He = __shfl_up(H, 16);
                        if (quad == 0) { Pe = 1.0f; He = 0.0f; }
                        float hq = Pe * hc[nt] + He;
#pragma unroll
                        for (int j = 0; j < 4; ++j) {
                            hq = av[j] * hq + uv[j];
                            const float x = gt[nt][j], z = 0.7978845608028654f * (x + 0.044715f * x * x * x);
                            const float th = 1.0f - 2.0f * __builtin_amdgcn_rcpf(1.0f + __builtin_amdgcn_exp2f(2.0f * z * L2E));
                            const float yv = hq * (0.5f * x * (1.0f + th));
                            Y[((size_t)(b * 2048 + trow + j)) * DM + 64 * h + 32 * jh + nt * 16 + l16] = (bf16_t)(pk2(yv, 0.f) & 0xffffu);
                        }
                    }
                    hc[nt] = Pt * hc[nt] + Ht; pc[nt] *= Pt;
                }
            }
        }
        if (pass == 0) {
            if (quad == 0) {
#pragma unroll
                for (int nt = 0; nt < 2; ++nt) { SUM[(w * 32 + nt * 16 + l16) * 2] = pc[nt]; SUM[(w * 32 + nt * 16 + l16) * 2 + 1] = hc[nt]; }
            }
            __syncthreads();
            for (int w2 = 0; w2 < w; ++w2) {
#pragma unroll
                for (int nt = 0; nt < 2; ++nt) hin[nt] = SUM[(w2 * 32 + nt * 16 + l16) * 2] * hin[nt] + SUM[(w2 * 32 + nt * 16 + l16) * 2 + 1];
            }
        }
    }
    __syncthreads();
}

constexpr int AT_KC = 0, AT_VC = 18432, AT_K = 35328, AT_V = 44544, AT_IMPP = 53248, AT_IMP = 87040, AT_SEL = 95488;
__device__ __forceinline__ int crow(int r, int hi) { return (r & 3) + 8 * (r >> 2) + 4 * hi; }
#define MFMA32(a, b, c) __builtin_amdgcn_mfma_f32_32x32x16_bf16((a), (b), (c), 0, 0, 0)
__device__ __forceinline__ f32x16 qk_tile(const LAS unsigned char* Kl, int krow0, const bf16x8 (&qf)[4], int i, int hi) {
    f32x16 p;
#pragma unroll
    for (int r = 0; r < 16; ++r) p[r] = 0.f;
    const LAS unsigned char* kp = Kl + (krow0 + i) * 144 + hi * 16;
#pragma unroll
    for (int d0 = 0; d0 < 4; ++d0) { const bf16x8 a = *(const LAS bf16x8*)(kp + d0 * 32); p = MFMA32(a, qf[d0], p); }
    return p;
}
__device__ __forceinline__ bf16x8 pack8(const f32x16& p, int s) {
    u32x4 w; w.x = pk2(p[8 * s], p[8 * s + 1]); w.y = pk2(p[8 * s + 2], p[8 * s + 3]); w.z = pk2(p[8 * s + 4], p[8 * s + 5]); w.w = pk2(p[8 * s + 6], p[8 * s + 7]);
    return __builtin_bit_cast(bf16x8, w);
}
__device__ __forceinline__ void pv_step(f32x16 (&o)[2], const LAS unsigned char* Vl, int VS, int kbase, bf16x8 pb, int i, int hi) {
#pragma unroll
    for (int d0t = 0; d0t < 2; ++d0t) {
        const LAS unsigned char* vp = Vl + (32 * d0t + i) * VS + (kbase + 4 * hi) * 2;
        const s16x4 lo = *(const LAS s16x4*)vp, hi4 = *(const LAS s16x4*)(vp + 16);
        const bf16x8 a = __builtin_shufflevector(lo, hi4, 0, 1, 2, 3, 4, 5, 6, 7);
        o[d0t] = MFMA32(a, pb, o[d0t]);
    }
}
template <int MODE>
__device__ __forceinline__ void attn_branch(const bf16_t* Kg, const bf16_t* VTg, int kt_lo, int kt_hi, unsigned selw, unsigned unionmask, int tq,
                                            const bf16x8 (&qf)[4], LAS unsigned char* lds, int tid, int i, int hi, float gate, f32x16 (&tot)[2]) {
    f32x16 o[2];
#pragma unroll
    for (int r = 0; r < 16; ++r) { o[0][r] = 0.f; o[1][r] = 0.f; }
    float m = -INFINITY, l = 0.f;
    for (int kt = kt_lo; kt <= kt_hi; ++kt) {
        if (MODE == 1 && !((unionmask >> kt) & 1u)) continue;
        {
            const int row = tid >> 3, ch = tid & 7;
            const u32x4 kv = *(const u32x4*)(Kg + (size_t)(kt * 64 + row) * NPROJ + ch * 8);
            const u32x4 vv = *(const u32x4*)(VTg + (size_t)row * 2048 + kt * 64 + ch * 8);
            *(LAS u32x4*)(lds + AT_K + row * 144 + ch * 16) = kv;
            LAS u32x2* vd = (LAS u32x2*)(lds + AT_V + row * 136 + ch * 16); vd[0] = (u32x2){vv.x, vv.y}; vd[1] = (u32x2){vv.z, vv.w};
        }
        __syncthreads();
        f32x16 p0 = qk_tile(lds + AT_K, 0, qf, i, hi), p1 = qk_tile(lds + AT_K, 32, qf, i, hi);
        const bool selbit = (MODE == 1) ? (((selw >> kt) & 1u) != 0u) : true;
        float mx = -INFINITY;
        const int rel = tq - kt * 64 - 4 * hi;
#pragma unroll
        for (int r = 0; r < 16; ++r) {
            const int cr0 = (r & 3) + 8 * (r >> 2), cr1 = cr0 + 32;
            const bool v0 = selbit && cr0 <= rel && (MODE == 1 || cr0 >= rel - 511);
            const bool v1 = selbit && cr1 <= rel && (MODE == 1 || cr1 >= rel - 511);
            p0[r] = v0 ? p0[r] : -INFINITY; p1[r] = v1 ? p1[r] : -INFINITY;
            mx = fmaxf(mx, fmaxf(p0[r], p1[r]));
        }
        mx = fmaxf(mx, __shfl_xor(mx, 32));
        const float mnew = fmaxf(m, mx), msafe = (mnew == -INFINITY) ? 0.f : mnew;
        const float alpha = __builtin_amdgcn_exp2f((m - msafe) * L2E);
        float ls = 0.f;
#pragma unroll
        for (int r = 0; r < 16; ++r) { p0[r] = __builtin_amdgcn_exp2f((p0[r] - msafe) * L2E); p1[r] = __builtin_amdgcn_exp2f((p1[r] - msafe) * L2E); ls += p0[r] + p1[r]; }
        l = l * alpha + ls; m = mnew;
#pragma unroll
        for (int r = 0; r < 16; ++r) { o[0][r] *= alpha; o[1][r] *= alpha; }
        pv_step(o, lds + AT_V, 136, 0, pack8(p0, 0), i, hi);
        pv_step(o, lds + AT_V, 136, 16, pack8(p0, 1), i, hi);
        pv_step(o, lds + AT_V, 136, 32, pack8(p1, 0), i, hi);
        pv_step(o, lds + AT_V, 136, 48, pack8(p1, 1), i, hi);
        __syncthreads();
    }
    l += __shfl_xor(l, 32);
    const float sc = gate / l;
#pragma unroll
    for (int r = 0; r < 16; ++r) { tot[0][r] += o[0][r] * sc; tot[1][r] += o[1][r] * sc; }
}

__device__ __forceinline__ void attn_unit(Frame& F, int b, int g, int qt) {
    const int tid = F.tid, lane = F.lane, w = F.wave, i = lane & 31, hi = lane >> 5, r = w >> 1;
    const int bg = b * 2 + g, t0 = qt * 64, tl = 32 * (w & 1) + i, tq = t0 + tl;
    const size_t row = (size_t)b * 2048 + tq;
    LAS unsigned char* lds = F.lds;
    const bf16_t* PROJ = (const bf16_t*)(F.ws + WS_ACT); bf16_t* Y = (bf16_t*)(F.ws + WS_Y);
    const bf16_t* KC = (const bf16_t*)(F.ws + WS_KC); const bf16_t* VCT = (const bf16_t*)(F.ws + WS_VCT); const bf16_t* VT = (const bf16_t*)(F.ws + WS_VT);
    bf16x8 qf[4];
    { const bf16_t* qp = PROJ + row * NPROJ + 1024 + 64 * (4 * g + r) + 8 * hi;
#pragma unroll
      for (int d0 = 0; d0 < 4; ++d0) qf[d0] = *(const bf16x8*)(qp + 16 * d0); }
    float g0, g1, g2;
    { const bf16_t* gp = PROJ + row * NPROJ + 2304 + (4 * g + r) * 3; g0 = fsigmoid(bf2f(gp[0])); g1 = fsigmoid(bf2f(gp[1])); g2 = fsigmoid(bf2f(gp[2])); }
#pragma unroll
    for (int c2 = 0; c2 < 2; ++c2) {
        const int idx = tid + NTHREADS * c2;
        { const int rk = idx >> 3, ch = idx & 7; const u32x4 v = *(const u32x4*)(KC + ((size_t)bg * 128 + rk) * 64 + ch * 8); *(LAS u32x4*)(lds + AT_KC + rk * 144 + ch * 16) = v; }
        { const int rd = idx >> 4, ch = idx & 15; const u32x4 v = *(const u32x4*)(VCT + ((size_t)bg * 64 + rd) * 128 + ch * 8);
          LAS u32x2* vd = (LAS u32x2*)(lds + AT_VC + rd * 264 + ch * 16); vd[0] = (u32x2){v.x, v.y}; vd[1] = (u32x2){v.z, v.w}; }
    }
    __syncthreads();
    f32x16 tot[2];
    {
        f32x16 p[4];
#pragma unroll
        for (int kt = 0; kt < 4; ++kt) p[kt] = qk_tile(lds + AT_KC, 32 * kt, qf, i, hi);
        const int nv = tq >= 31 ? (((tq - 31) >> 4) + 1) : 0;
        const int nvl = nv - 4 * hi;
        float mx = -INFINITY;
#pragma unroll
        for (int kt = 0; kt < 4; ++kt)
#pragma unroll
            for (int rr = 0; rr < 16; ++rr) { const int nc = 32 * kt + (rr & 3) + 8 * (rr >> 2); p[kt][rr] = (nc < nvl) ? p[kt][rr] : -INFINITY; mx = fmaxf(mx, p[kt][rr]); }
        mx = fmaxf(mx, __shfl_xor(mx, 32));
        const float msafe = (mx == -INFINITY) ? 0.f : mx;
        float ls = 0.f;
#pragma unroll
        for (int kt = 0; kt < 4; ++kt)
#pragma unroll
            for (int rr = 0; rr < 16; ++rr) { p[kt][rr] = __builtin_amdgcn_exp2f((p[kt][rr] - msafe) * L2E); ls += p[kt][rr]; }
        ls += __shfl_xor(ls, 32);
        const float inv = ls > 0.f ? 1.0f / ls : 0.f;
#pragma unroll
        for (int kt = 0; kt < 4; ++kt)
#pragma unroll
            for (int rr = 0; rr < 16; ++rr) p[kt][rr] *= inv;
        float Qs[16], rl[16];
#pragma unroll
        for (int q4 = 0; q4 < 16; ++q4) {
            const int kt = q4 >> 2, g4 = q4 & 3;
            Qs[q4] = (p[kt][4 * g4] + p[kt][4 * g4 + 1]) + (p[kt][4 * g4 + 2] + p[kt][4 * g4 + 3]);
            rl[q4] = __shfl_xor(p[kt][4 * g4 + 3], 32);
        }
        LAS float* impp = (LAS float*)(lds + AT_IMPP) + (r * 64 + tl) * 33;
#pragma unroll
        for (int q4 = 0; q4 < 16; ++q4) {
            const float ex = hi ? rl[q4] : (q4 > 0 ? rl[q4 > 0 ? q4 - 1 : 0] : 0.f);
            impp[8 * (q4 >> 2) + 2 * (q4 & 3) + hi] = Qs[q4] + ex;
        }
        f32x16 o[2];
#pragma unroll
        for (int rr = 0; rr < 16; ++rr) { o[0][rr] = 0.f; o[1][rr] = 0.f; }
#pragma unroll
        for (int kt = 0; kt < 4; ++kt)
#pragma unroll
            for (int s = 0; s < 2; ++s) pv_step(o, lds + AT_VC, 264, 32 * kt + 16 * s, pack8(p[kt], s), i, hi);
#pragma unroll
        for (int rr = 0; rr < 16; ++rr) { tot[0][rr] = o[0][rr] * g0; tot[1][rr] = o[1][rr] * g0; }
    }
    __syncthreads();
    {
        LAS float* IMPP = (LAS float*)(lds + AT_IMPP); LAS float* IMP = (LAS float*)(lds + AT_IMP); LAS unsigned* SEL = (LAS unsigned*)(lds + AT_SEL);
#pragma unroll
        for (int it = 0; it < 4; ++it) {
            const int idx = tid + NTHREADS * it, tt = idx >> 5, j = idx & 31;
            IMP[tt * 33 + j] = ((IMPP[(0 * 64 + tt) * 33 + j] + IMPP[(1 * 64 + tt) * 33 + j]) + IMPP[(2 * 64 + tt) * 33 + j]) + IMPP[(3 * 64 + tt) * 33 + j];
        }
        __syncthreads();
#pragma unroll 1
        for (int it = 0; it < 4; ++it) {
            const int idx = tid + NTHREADS * it, tt = idx >> 5, j = idx & 31;
            const float v = IMP[tt * 33 + j];
            int cnt = 0;
#pragma unroll 2
            for (int j2 = 1; j2 <= qt - 2; ++j2) { const float v2 = IMP[tt * 33 + j2]; cnt += ((v2 > v) || (v2 == v && j2 < j)) ? 1 : 0; }
            const bool forced = (j == 0) || (j == qt) || (j == qt - 1);
            const bool sel = (j <= qt) && (forced || (j >= 1 && j <= qt - 2 && cnt < 13));
            const unsigned long long bal = __ballot(sel);
            if ((lane & 31) == 0) SEL[tt] = (lane < 32) ? (unsigned)bal : (unsigned)(bal >> 32);
        }
        __syncthreads();
    }
    unsigned selw, unionmask;
    { LAS unsigned* SEL = (LAS unsigned*)(lds + AT_SEL); selw = SEL[tl]; unsigned uu = SEL[lane];
#pragma unroll
      for (int o = 1; o < 64; o <<= 1) uu |= __shfl_xor(uu, o);
      unionmask = uu; }
    unionmask = __builtin_amdgcn_readfirstlane(unionmask);
    attn_branch<0>(PROJ + (size_t)b * 2048 * NPROJ + 2048 + 64 * g, VT + ((size_t)(32 + bg) * 64) * 2048, qt - 8 > 0 ? qt - 8 : 0, qt, 0u, 0u, tq, qf, lds, tid, i, hi, g2, tot);
    attn_branch<1>(PROJ + (size_t)b * 2048 * NPROJ + 1792 + 64 * g, VT + ((size_t)bg * 64) * 2048, 0, qt, selw, unionmask, tq, qf, lds, tid, i, hi, g1, tot);
    bf16_t* yp = Y + row * DM + 512 + 64 * (4 * g + r);
#pragma unroll
    for (int d0t = 0; d0t < 2; ++d0t)
#pragma unroll
        for (int g4 = 0; g4 < 4; ++g4) {
            const int d = 32 * d0t + 8 * g4 + 4 * hi;
            *(u32x2*)(yp + d) = (u32x2){pk2(tot[d0t][4 * g4], tot[d0t][4 * g4 + 1]), pk2(tot[d0t][4 * g4 + 2], tot[d0t][4 * g4 + 3])};
        }
}


#define XB_TMO      128
#define XB_XCNT(j)  (256  + 64 * (j))
#define XB_XSUB(j)  (1280 + 64 * (j))
#define XB_XGEN(j)  (2304 + 64 * (j))
#define XB_TOP      3328
#define XB_TOPGEN   3392
#define XCD_BAR_WORDS 3456
#define XB_SPIN_CAP (1u << 20)
__device__ __forceinline__ unsigned xb_ld(unsigned* p)              { return __hip_atomic_load(p, __ATOMIC_RELAXED, __HIP_MEMORY_SCOPE_AGENT); }
__device__ __forceinline__ unsigned xb_add(unsigned* p, unsigned v) { return __hip_atomic_fetch_add(p, v, __ATOMIC_RELAXED, __HIP_MEMORY_SCOPE_AGENT); }
__device__ __forceinline__ unsigned xb_xcc_id() { return (unsigned)__builtin_amdgcn_s_getreg((3 << 11) | 20) & 0xFu; }
#define XB_SPIN(cond, bar) do { unsigned _sp = 0; while (cond) { __builtin_amdgcn_s_sleep(1); \
    if ((++_sp & 255u) == 0u) { if (xb_ld(&(bar)[XB_TMO])) break; if (_sp > XB_SPIN_CAP) { atomicAdd(&(bar)[XB_TMO], 1u); break; } } } } while (0)
struct XcdBarrier { unsigned* bar; unsigned x; volatile LAS unsigned* st; };
__device__ __forceinline__ XcdBarrier xcd_barrier_post(unsigned* bar, volatile LAS unsigned* st) {
    XcdBarrier b; b.bar = bar; b.x = xb_xcc_id(); b.st = st;
    if (threadIdx.x == 0) (void)xb_add(&bar[XB_XCNT(b.x)], 1u);
    return b;
}
__device__ __forceinline__ void xcd_barrier_complete(unsigned* bar, unsigned x, unsigned& nloc, unsigned& nx) {
    const unsigned G = gridDim.x * gridDim.y * gridDim.z;
    unsigned sum, cnt, mine, sp = 0u;
    for (;;) {
        sum = 0u; cnt = 0u; mine = 0u;
#pragma unroll
        for (unsigned j = 0; j < 16; ++j) { const unsigned c = xb_ld(&bar[XB_XCNT(j)]); sum += c; cnt += (c > 0u) ? 1u : 0u; mine = (j == x) ? c : mine; }
        if (sum == G) break;
        __builtin_amdgcn_s_sleep(1);
        if ((++sp & 255u) == 0u) { if (xb_ld(&bar[XB_TMO])) break; if (sp > XB_SPIN_CAP) { atomicAdd(&bar[XB_TMO], 1u); break; } }
    }
    nloc = mine > 0u ? mine : 1u; nx = cnt > 0u ? cnt : 1u;
}
__device__ __forceinline__ void xcd_barrier(const XcdBarrier& b) {
    asm volatile("s_waitcnt vmcnt(0)" ::: "memory");
    __syncthreads();
    if (threadIdx.x == 0) {
        unsigned* bar = b.bar;
        __builtin_amdgcn_s_waitcnt(0);
        unsigned nloc = b.st[0], nx = b.st[1];
        if (nloc == 0u) { xcd_barrier_complete(bar, b.x, nloc, nx); b.st[0] = nloc; b.st[1] = nx; }
        const unsigned old = xb_add(&bar[XB_XSUB(b.x)], 1u);
        const unsigned gen = old / nloc;
        if (old + 1u == (gen + 1u) * nloc) {
            __builtin_amdgcn_fence(__ATOMIC_RELEASE, "agent");
            asm volatile("s_waitcnt vmcnt(0)" ::: "memory");
            const unsigned og = xb_add(&bar[XB_TOP], 1u);
            const unsigned tg = og / nx;
            if (og + 1u == (tg + 1u) * nx) xb_add(&bar[XB_TOPGEN], 1u);
            else XB_SPIN(xb_ld(&bar[XB_TOPGEN]) == tg, bar);
            __builtin_amdgcn_fence(__ATOMIC_ACQUIRE, "agent");
            xb_add(&bar[XB_XGEN(b.x)], 1u);
            asm volatile("s_waitcnt vmcnt(0)" ::: "memory");
        } else {
            XB_SPIN(xb_ld(&bar[XB_XGEN(b.x)]) == gen, bar);
            __builtin_amdgcn_fence(__ATOMIC_ACQUIRE, "agent");
            asm volatile("s_waitcnt vmcnt(0)" ::: "memory");
        }
    }
    __syncthreads();
}

__global__ void __launch_bounds__(NTHREADS, 2) hymba_fwd(Args args) {
    extern __shared__ __attribute__((aligned(16))) unsigned char lds_raw[];
    cg::grid_group grid = cg::this_grid();
    Frame F;
    F.lds = (LAS unsigned char*)lds_raw;
    F.G = gridDim.x;
    if (threadIdx.x < 64) ((LAS unsigned*)(F.lds + 131072))[threadIdx.x] = 0u;
    __syncthreads();
    const XcdBarrier xbar = xcd_barrier_post((unsigned*)(args.ws + WS_CTL), (volatile LAS unsigned*)(F.lds + 131072));
    if (args.ph_hi > 1000) grid.sync();

    const int lo = args.ph_lo, hi = args.ph_hi;
#define RELAUNDER() do { int tv = threadIdx.x; asm volatile("" : "+v"(tv)); F.tid = tv; F.lane = tv & 63; F.wave = __builtin_amdgcn_readfirstlane(tv >> 6); \
        int bv = blockIdx.x; asm volatile("" : "+s"(bv)); F.bid = bv; \
        const __attribute__((address_space(4))) unsigned long long* kv = (const __attribute__((address_space(4))) unsigned long long*)__builtin_amdgcn_kernarg_segment_ptr(); asm volatile("" : "+s"(kv)); F.kp = kv; \
        F.ws = (unsigned char*)kv[29]; F.out = (float*)kv[28]; } while (0)
#ifndef REPMASK
#define REPMASK 0
#endif
#define PH(k) if (lo <= (k) && (k) < hi) for (int rep_ = 0; rep_ < 1 + ((REPMASK >> (k)) & 1); ++rep_)
#define SEAM(k) do { if ((k) + 1 < hi || rep_ < ((REPMASK >> (k)) & 1)) xcd_barrier(xbar); } while (0)
#define WSB(off) ((bf16_t*)(F.ws + (off)))

    PH(0) { RELAUNDER();
#ifndef NO_P0
        p_prologue(F);
#endif
        SEAM(0); }
    PH(1) { RELAUNDER();
        pg8::Gemm g{WSB(WS_AB), WSB(WS_W1A), MTOK, NFF2, DM, DM}; pg8::StaticOrder S; S.init(MTOK, NFF2, F.G, F.bid); pg8::EpiSwiGLU E{WSB(WS_ACT)};
#ifndef NO_P1
        pg8::gemm_phase<pg8::EpiSwiGLU, DM, DM>(F.lds, g, S, E, F.tid);
#endif
        SEAM(1); }
    PH(2) { RELAUNDER();
        pg8::Gemm g{WSB(WS_ACT), WSB(WS_W1B), MTOK, DM, DFF, DFF}; pg8::StaticOrder S; S.init(MTOK, DM, F.G, F.bid); pg8::EpiResid E{WSB(WS_AB), WSB(WS_Y), ALPHA, 0.5f};
#ifndef NO_P2
        pg8::gemm_phase<pg8::EpiResid, DFF, DFF>(F.lds, g, S, E, F.tid);
#endif
        SEAM(2); }
    PH(3) { RELAUNDER(); p_layernorm<false>(F, WSB(WS_Y), INP(3), INP(4), WSB(WS_AB), nullptr); SEAM(3); }
    PH(4) { RELAUNDER();
        pg8::Gemm g{WSB(WS_AB), WSB(WS_WMI), MTOK, NPROJ, DM, DM}; pg8::StaticOrder S; S.init(MTOK, NPROJ, F.G, F.bid);
        pg8::EpiProj E{WSB(WS_ACT), WSB(WS_KCV), WSB(WS_VT), (const float*)(F.ws + WS_ROPE)};
#ifndef NO_P4
        pg8::gemm_phase<pg8::EpiProj, DM, DM>(F.lds, g, S, E, F.tid);
#endif
        SEAM(4); }
    PH(5) { RELAUNDER();
        const int ncmp = (F.G > 64) ? 32 : 0;
        if (F.bid < 32) {
            const int which = F.bid >> 4;
            pg8::Gemm g{WSB(WS_KCV) + (size_t)which * 32 * 2048 * 64, WSB(WS_WC1) + (size_t)which * 256 * 2048, 4096, 256, 2048, 1024};
            pg8::StaticOrder S; S.init(4096, 256, F.G > 16 ? F.G : 16, F.bid & 15);
            pg8::EpiCmp E{WSB(WS_HID) + (size_t)which * 4096 * 256, (const float*)(F.ws + WS_CBIAS) + which * 256};
#ifndef NO_P5A
            pg8::gemm_phase<pg8::EpiCmp, 2048, 1024>(F.lds, g, S, E, F.tid);
#endif
        }
        if (F.bid >= ncmp) for (int u = F.bid - ncmp; u < 256; u += F.G - ncmp) {
#ifndef NO_P5B
            lru_unit(F, u);
#endif
        }
        SEAM(5); }
    PH(6) { RELAUNDER(); p_kcvc(F); SEAM(6); }
    PH(7) { RELAUNDER();
        for (int L = F.bid; L < 1024; L += F.G) {
            const int rd = L >> 8, c = L & 255, bg = c & 31, a = c >> 5;
            const int qt = rd == 0 ? 31 - a : (rd == 1 ? 16 + a : (rd == 2 ? 15 - a : a));
#ifndef NO_P7
            attn_unit(F, bg >> 1, bg & 1, qt);
#endif
        }
        SEAM(7); }
    PH(8) { RELAUNDER(); p_rmsnorm(F, WSB(WS_Y), INP(19), INP(20)); SEAM(8); }
    PH(9) { RELAUNDER();
        pg8::Gemm g{WSB(WS_Y), WSB(WS_WMO), MTOK, DM, DM, DM}; pg8::StaticOrder S; S.init(MTOK, DM, F.G, F.bid); pg8::EpiResid E{WSB(WS_AB), WSB(WS_ACT), ALPHA, 1.0f};
#ifndef NO_P9
        pg8::gemm_phase<pg8::EpiResid, DM, DM>(F.lds, g, S, E, F.tid);
#endif
        SEAM(9); }
    PH(10) { RELAUNDER(); p_layernorm<false>(F, WSB(WS_ACT), INP(22), INP(23), WSB(WS_AB), nullptr); SEAM(10); }
    PH(11) { RELAUNDER();
        pg8::Gemm g{WSB(WS_AB), WSB(WS_W2A), MTOK, NFF2, DM, DM}; pg8::StaticOrder S; S.init(MTOK, NFF2, F.G, F.bid); pg8::EpiSwiGLU E{WSB(WS_ACT)};
#ifndef NO_P1
        pg8::gemm_phase<pg8::EpiSwiGLU, DM, DM>(F.lds, g, S, E, F.tid);
#endif
        SEAM(11); }
    PH(12) { RELAUNDER();
        pg8::Gemm g{WSB(WS_ACT), WSB(WS_W2B), MTOK, DM, DFF, DFF}; pg8::StaticOrder S; S.init(MTOK, DM, F.G, F.bid); pg8::EpiResid E{WSB(WS_AB), WSB(WS_Y), ALPHA, 0.5f};
#ifndef NO_P2
        pg8::gemm_phase<pg8::EpiResid, DFF, DFF>(F.lds, g, S, E, F.tid);
#endif
        SEAM(12); }
    PH(13) { RELAUNDER(); p_layernorm<true>(F, WSB(WS_Y), INP(26), INP(27), nullptr, F.out); }
}

extern "C" void kernel_launch(void* const* d_in, const int* in_sizes, int n_in, void* d_out, int out_size, void* d_ws, size_t ws_size, hipStream_t stream) {
    static int grid = 0;
    if (grid == 0) {
        if (n_in != 28 || out_size != MTOK * DM || ws_size < WS_END) { fprintf(stderr, "kernel_launch: unexpected shapes (n_in %d out %d ws %zu)\n", n_in, out_size, ws_size); grid = -1; return; }
        int dev = 0, cus = 0, per_cu = 0;
        (void)hipGetDevice(&dev); (void)hipDeviceGetAttribute(&cus, hipDeviceAttributeMultiprocessorCount, dev);
        if (hipFuncSetAttribute((const void*)hymba_fwd, hipFuncAttributeMaxDynamicSharedMemorySize, LDS_BYTES) != hipSuccess) { fprintf(stderr, "kernel_launch: hipFuncSetAttribute failed\n"); grid = -1; return; }
        if (hipOccupancyMaxActiveBlocksPerMultiprocessor(&per_cu, (const void*)hymba_fwd, NTHREADS, LDS_BYTES) != hipSuccess || per_cu < 1) { fprintf(stderr, "kernel_launch: occupancy query failed (%d)\n", per_cu); (void)hipGetLastError(); per_cu = 1; }
        if (per_cu > 1) per_cu = 1;
        grid = cus * per_cu;
        if (grid <= 0) { grid = -1; return; }
    }
    if (grid < 0) return;
    if (hipMemsetAsync((char*)d_ws + WS_CTL, 0, CTL_BYTES, stream) != hipSuccess) { fprintf(stderr, "kernel_launch: memset failed\n"); return; }
    Args a{};
    for (int i = 0; i < 28; ++i) a.in[i] = (const float*)d_in[i];
    a.out = (float*)d_out; a.ws = (unsigned char*)d_ws; a.ph_lo = 0; a.ph_hi = NPHASE;
    void* kargs[] = {&a};
    hipError_t e = hipLaunchCooperativeKernel((const void*)hymba_fwd, dim3(grid), dim3(NTHREADS), kargs, LDS_BYTES, stream);
    if (e != hipSuccess) fprintf(stderr, "kernel_launch: cooperative launch failed: %s (grid %d)\n", hipGetErrorString(e), grid);
}
```

```cpp
#include <hip/hip_runtime.h>
#include <hip/hip_cooperative_groups.h>
#include <cstdio>
#include <cstdint>
namespace cg = cooperative_groups;

#define LAS __attribute__((address_space(3)))
typedef unsigned short bf16_t;
typedef short bf16x8 __attribute__((ext_vector_type(8)));
typedef short s16x4 __attribute__((ext_vector_type(4)));
typedef float f32x4 __attribute__((ext_vector_type(4)));
typedef float f32x16 __attribute__((ext_vector_type(16)));
typedef unsigned u32x4 __attribute__((ext_vector_type(4)));
typedef unsigned u32x2 __attribute__((ext_vector_type(2)));
typedef float f32x2_t __attribute__((ext_vector_type(2)));
typedef __bf16 bf16x2_t __attribute__((ext_vector_type(2)));

constexpr int DM = 1024, NBATCH = 16, SEQ = 2048, MTOK = NBATCH * SEQ;
constexpr int DFF = 2816, NFF2 = 5632, INCOLS = 2328, NPROJ = 2560;
constexpr float ALPHA = 1.189207115002721f;
constexpr float LN_EPS = 1e-5f, RMS_EPS = 1e-6f;
constexpr float L2E = 1.4426950408889634f;

constexpr size_t MiB = 1u << 20;
constexpr size_t WS_W1A = 2 * MiB, WS_W1B = 14 * MiB, WS_WMI = 20 * MiB, WS_WMO = 26 * MiB, WS_W2A = 28 * MiB, WS_W2B = 40 * MiB;
constexpr size_t WS_WC1 = 46 * MiB;
constexpr size_t WS_ROPE = 48 * MiB;
constexpr size_t WS_CBIAS = 48 * MiB + 512 * 1024;
constexpr size_t WS_KC = 49 * MiB;
constexpr size_t WS_VCT = 49 * MiB + 512 * 1024;
constexpr size_t WS_HID = 50 * MiB;
constexpr size_t WS_KCV = 54 * MiB;
constexpr size_t WS_VT = 72 * MiB;
constexpr size_t WS_AB = 96 * MiB;
constexpr size_t WS_Y = 160 * MiB;
constexpr size_t WS_ACT = 224 * MiB;
constexpr size_t WS_END = 400 * MiB;

__device__ __forceinline__ unsigned pk2(float lo, float hi) { f32x2_t v = {lo, hi}; bf16x2_t b = __builtin_convertvector(v, bf16x2_t); return __builtin_bit_cast(unsigned, b); }
__device__ __forceinline__ float bflo(unsigned w) { return __uint_as_float(w << 16); }
__device__ __forceinline__ float bfhi(unsigned w) { return __uint_as_float(w & 0xffff0000u); }
__device__ __forceinline__ float bf2f(bf16_t h) { return __uint_as_float((unsigned)h << 16); }
__device__ __forceinline__ float fsigmoid(float x) { return __builtin_amdgcn_rcpf(1.0f + __builtin_amdgcn_exp2f(-x * L2E)); }
#define LDS_WAIT() asm volatile("s_waitcnt lgkmcnt(0)" ::: "memory")

namespace pg8 {
constexpr int BM = 256, BK = 64, HALF = 128, HTB = HALF * BK * 2, STAGE_BYTES = 8 * HTB, NXCD = 8, WGM = 8;
__host__ __device__ __forceinline__ int lds_byte(int r, int c) { const int st = (r >> 4) * 2 + (c >> 5), rr = r & 15, cc = c & 31, ob = rr * 64 + cc * 2; return st * 1024 + (ob ^ (((ob >> 9) & 1) << 5)); }
__host__ __device__ __forceinline__ void stage_rc(int b, int& R, int& C) { const int st = b / 1024, sb = b % 1024, swz = sb ^ (((sb >> 9) & 1) << 5); R = (st >> 1) * 16 + swz / 64; C = (st & 1) * 32 + (swz % 64) / 2; }
__host__ __device__ __forceinline__ int perm32(int rho) { const int n = rho >> 4, i = rho & 15; return 8 * (i >> 2) + 4 * n + (i & 3); }
struct Unit { int pm, pn; };
struct Gemm { const bf16_t* A; const bf16_t* Bt; int M, N, K, lda; };
struct StaticOrder {
    int nM, nN, nwg, G, c;
    __device__ void init(int M, int N, int G_, int c_) { nM = M / BM; nN = N / BM; nwg = nM * nN; G = G_; c = c_; }
    __device__ bool next(int i, Unit& u) const {
        const long L = (long)i * G + c; if (L >= nwg) return false;
        int wgid = (int)L; { const int q = nwg / NXCD, r = nwg % NXCD, xcd = wgid % NXCD, off = wgid / NXCD; wgid = (xcd < r ? xcd * (q + 1) : r * (q + 1) + (xcd - r) * q) + off; }
        const int nig = WGM * nN, gid = wgid / nig, fm = gid * WGM, gsz = (nM - fm) < WGM ? (nM - fm) : WGM;
        u.pm = fm + ((wgid % nig) % gsz); u.pn = (wgid % nig) / gsz; return true;
    }
};

template <class Epi, int K, int lda>
__device__ __forceinline__ void gemm_phase(LAS unsigned char* lds, const Gemm g, const StaticOrder& S, const Epi& E, const int tid) {
    const int wid = __builtin_amdgcn_readfirstlane(tid >> 6), lane = tid & 63, wr = wid >> 2, wc = wid & 3, fr = lane & 15, fq = lane >> 4;
    constexpr int nt = K / BK;
    unsigned voffA[2], voffB[2];
#pragma unroll
    for (int i = 0; i < 2; ++i) { int R, C; stage_rc(tid * 16 + i * 8192, R, C); const int Rb = Epi::PERM ? ((R & ~31) + perm32(R & 31)) : R;
        voffA[i] = (unsigned)(R * lda + C) * 2u; voffB[i] = (unsigned)(Rb * K + C) * 2u; }
    const size_t kstep = (size_t)(BK * 2);
    const size_t hstepA = (size_t)HALF * lda * 2, hstepB = (size_t)HALF * K * 2;
    const size_t tstepA = 2 * hstepA, tstepB = 2 * hstepB;
    const unsigned ldsw = (unsigned)wid * 1024u;
    const int aoff = lds_byte(wr * 64 + fr, fq * 8), boff = lds_byte(wc * 32 + fr, fq * 8);
#define PG8_SA(b, h) (((b) * 2 + (h)) * HTB)
#define PG8_SB(b, h) ((4 + (b) * 2 + (h)) * HTB)
#define PG8_STAGE(bufoff, gbase, voff) do { _Pragma("unroll") for (int _i = 0; _i < 2; ++_i) \
        __builtin_amdgcn_global_load_lds((const unsigned*)((const char*)(gbase) + (voff)[_i]), (LAS unsigned*)(lds + (bufoff) + ldsw + _i * 8192), 16, 0, 0); } while (0)
#define PG8_LDA(dst, b, h) do { _Pragma("unroll") for (int m = 0; m < 4; ++m) _Pragma("unroll") for (int k = 0; k < 2; ++k) dst[m][k] = *(const LAS bf16x8*)(lds + PG8_SA(b, h) + aoff + m * 2048 + k * 1024); } while (0)
#define PG8_LDB(dst, b, h) do { _Pragma("unroll") for (int n = 0; n < 2; ++n) _Pragma("unroll") for (int k = 0; k < 2; ++k) dst[n][k] = *(const LAS bf16x8*)(lds + PG8_SB(b, h) + boff + n * 2048 + k * 1024); } while (0)
#define PG8_MMA(ai, bj, At, Bt) do { __builtin_amdgcn_s_setprio(1); _Pragma("unroll") for (int m = 0; m < 4; ++m) _Pragma("unroll") for (int n = 0; n < 2; ++n) _Pragma("unroll") for (int k = 0; k < 2; ++k) \
        acc[ai][bj][m][n] = __builtin_amdgcn_mfma_f32_16x16x32_bf16(Bt[n][k], At[m][k], acc[ai][bj][m][n], 0, 0, 0); __builtin_amdgcn_s_setprio(0); } while (0)
#define PG8_WAIT_V(n) asm volatile("s_waitcnt vmcnt(" #n ")" ::: "memory")
#define PG8_WAIT_L(n) asm volatile("s_waitcnt lgkmcnt(" #n ")" ::: "memory")
#define PG8_BAR __builtin_amdgcn_s_barrier()
#define PG8_SCHED __builtin_amdgcn_sched_barrier(0)
    Unit cur, nxt; int ui = 0;
    if (!S.next(0, cur)) return;
    f32x4 acc[2][2][4][2];
#pragma unroll
    for (int a = 0; a < 2; ++a)
#pragma unroll
        for (int b = 0; b < 2; ++b)
#pragma unroll
            for (int m = 0; m < 4; ++m)
#pragma unroll
                for (int n = 0; n < 2; ++n) acc[a][b][m][n] = (f32x4){0.f, 0.f, 0.f, 0.f};
    bf16x8 At[4][2], B0[2][2], B1[2][2];
    const char* cA = (const char*)g.A + (size_t)cur.pm * tstepA; const char* cB = (const char*)g.Bt + (size_t)cur.pn * tstepB;
    PG8_STAGE(PG8_SB(0, 0), cB, voffB); PG8_STAGE(PG8_SB(0, 1), cB + hstepB, voffB); PG8_STAGE(PG8_SA(0, 0), cA, voffA); PG8_STAGE(PG8_SA(0, 1), cA + hstepA, voffA);
    if (wr == 1) PG8_BAR;
    PG8_WAIT_V(2); PG8_BAR;
    PG8_STAGE(PG8_SB(1, 0), cB + kstep, voffB); PG8_STAGE(PG8_SA(1, 0), cA + kstep, voffA); PG8_STAGE(PG8_SB(1, 1), cB + hstepB + kstep, voffB);
    PG8_WAIT_V(6); PG8_BAR;
    for (;;) {
        const bool has_next = S.next(ui + 1, nxt);
        const char* nA = has_next ? (const char*)g.A + (size_t)nxt.pm * tstepA : cA; const char* nB = has_next ? (const char*)g.Bt + (size_t)nxt.pn * tstepB : cB;
        for (int t = 0; t < nt; t += 2) {
            const bool last = (t == nt - 2);
            const char* a1 = cA + (size_t)(t + 1) * kstep;
            const char* a2 = last ? nA : cA + (size_t)(t + 2) * kstep; const char* b2 = last ? nB : cB + (size_t)(t + 2) * kstep;
            const char* a3 = a2 + kstep; const char* b3 = b2 + kstep;
            PG8_LDB(B0, 0, 0); PG8_LDB(B1, 0, 1); PG8_SCHED; PG8_LDA(At, 0, 0); PG8_STAGE(PG8_SA(1, 1), a1 + hstepA, voffA);
            PG8_WAIT_V(8); PG8_WAIT_L(0); PG8_BAR; PG8_MMA(0, 0, At, B0); PG8_MMA(0, 1, At, B1); PG8_BAR; PG8_SCHED;
            PG8_LDA(At, 0, 1); PG8_STAGE(PG8_SB(0, 0), b2, voffB); PG8_STAGE(PG8_SB(0, 1), b2 + hstepB, voffB); PG8_STAGE(PG8_SA(0, 0), a2, voffA);
            PG8_WAIT_V(8); PG8_WAIT_L(0); PG8_BAR; PG8_MMA(1, 0, At, B0); PG8_MMA(1, 1, At, B1); PG8_BAR; PG8_SCHED;
            PG8_LDB(B0, 1, 0); PG8_LDB(B1, 1, 1); PG8_SCHED; PG8_LDA(At, 1, 0); PG8_STAGE(PG8_SA(0, 1), a2 + hstepA, voffA);
            PG8_WAIT_V(8); PG8_WAIT_L(0); PG8_BAR; PG8_MMA(0, 0, At, B0); PG8_MMA(0, 1, At, B1); PG8_BAR; PG8_SCHED;
            PG8_LDA(At, 1, 1); PG8_STAGE(PG8_SB(1, 0), b3, voffB); PG8_STAGE(PG8_SB(1, 1), b3 + hstepB, voffB); PG8_STAGE(PG8_SA(1, 0), a3, voffA);
            PG8_WAIT_V(8); PG8_WAIT_L(0); PG8_BAR; PG8_MMA(1, 0, At, B0); PG8_MMA(1, 1, At, B1); PG8_BAR; PG8_SCHED;
        }
        if (wr == 0) PG8_BAR;
        E(acc, cur, wr, wc, fr, fq);
        if (!has_next) break;
#pragma unroll
        for (int a = 0; a < 2; ++a)
#pragma unroll
            for (int b = 0; b < 2; ++b)
#pragma unroll
                for (int m = 0; m < 4; ++m)
#pragma unroll
                    for (int n = 0; n < 2; ++n) acc[a][b][m][n] = (f32x4){0.f, 0.f, 0.f, 0.f};
        cur = nxt; cA = nA; cB = nB; ++ui;
        if (wr == 1) PG8_BAR;
    }
    PG8_WAIT_V(0);
    PG8_BAR;
#undef PG8_SA
#undef PG8_SB
#undef PG8_STAGE
#undef PG8_LDA
#undef PG8_LDB
#undef PG8_MMA
#undef PG8_WAIT_V
#undef PG8_WAIT_L
#undef PG8_BAR
#undef PG8_SCHED
}

struct EpiSwiGLU {
    static constexpr bool PERM = true;
    bf16_t* O;
    __device__ __forceinline__ void operator()(const f32x4 (&acc)[2][2][4][2], const Unit& u, int wr, int wc, int fr, int fq) const {
        const int col = u.pn * 128 + wc * 32 + 8 * fq;
#pragma unroll
        for (int ai = 0; ai < 2; ++ai)
#pragma unroll
            for (int m = 0; m < 4; ++m) {
                const int row = u.pm * BM + ai * HALF + wr * 64 + m * 16 + fr;
                float o[8];
#pragma unroll
                for (int n = 0; n < 2; ++n)
#pragma unroll
                    for (int e = 0; e < 4; ++e) { const float gv = acc[ai][0][m][n][e], uv = acc[ai][1][m][n][e]; o[4 * n + e] = gv * fsigmoid(gv) * uv; }
                u32x4 w; w.x = pk2(o[0], o[1]); w.y = pk2(o[2], o[3]); w.z = pk2(o[4], o[5]); w.w = pk2(o[6], o[7]);
                *(u32x4*)(O + (size_t)row * DFF + col) = w;
            }
    }
};
struct EpiResid {
    static constexpr bool PERM = true;
    const bf16_t* res; bf16_t* out; float alpha, scale;
    __device__ __forceinline__ void operator()(const f32x4 (&acc)[2][2][4][2], const Unit& u, int wr, int wc, int fr, int fq) const {
        const int col0 = u.pn * BM + wc * 32 + 8 * fq;
#pragma unroll
        for (int ai = 0; ai < 2; ++ai)
#pragma unroll
            for (int m = 0; m < 4; ++m) {
                const size_t off = (size_t)(u.pm * BM + ai * HALF + wr * 64 + m * 16 + fr) * DM + col0;
#pragma unroll
                for (int bj = 0; bj < 2; ++bj) {
                    const u32x4 rv = *(const u32x4*)(res + off + bj * HALF);
                    const f32x4 a0 = acc[ai][bj][m][0], a1 = acc[ai][bj][m][1];
                    u32x4 w;
                    w.x = pk2(alpha * bflo(rv.x) + scale * a0[0], alpha * bfhi(rv.x) + scale * a0[1]); w.y = pk2(alpha * bflo(rv.y) + scale * a0[2], alpha * bfhi(rv.y) + scale * a0[3]);
                    w.z = pk2(alpha * bflo(rv.z) + scale * a1[0], alpha * bfhi(rv.z) + scale * a1[1]); w.w = pk2(alpha * bflo(rv.w) + scale * a1[2], alpha * bfhi(rv.w) + scale * a1[3]);
                    *(u32x4*)(out + off + bj * HALF) = w;
                }
            }
    }
};
struct EpiProj {
    static constexpr bool PERM = true;
    bf16_t* PROJ; bf16_t* KCV; bf16_t* VT; const float* ROPE;
    __device__ __forceinline__ void operator()(const f32x4 (&acc)[2][2][4][2], const Unit& u, int wr, int wc, int fr, int fq) const {
        const int pn = u.pn, hc = 32 * wc + 8 * fq;
#pragma unroll
        for (int ai = 0; ai < 2; ++ai)
#pragma unroll
            for (int m = 0; m < 4; ++m) {
                const int row = u.pm * BM + ai * HALF + wr * 64 + m * 16 + fr, b = row >> 11, t = row & 2047;
#pragma unroll
                for (int bj = 0; bj < 2; ++bj) {
                    f32x4 v0 = acc[ai][bj][m][0], v1 = acc[ai][bj][m][1];
                    const bool isq = (pn == 4 || pn == 5);
                    const bool rope = isq || (pn >= 6 && pn <= 8 && bj == 0);
                    if (rope) {
                        const int i0 = (hc & 63) >> 1;
                        const f32x4* rp = (const f32x4*)(ROPE + ((size_t)t * 32 + i0) * 2);
                        const f32x4 c0 = rp[0], c1 = rp[1];
                        float a, bb;
                        a = v0[0] * c0[0] - v0[1] * c0[1]; bb = v0[1] * c0[0] + v0[0] * c0[1]; v0[0] = a; v0[1] = bb;
                        a = v0[2] * c0[2] - v0[3] * c0[3]; bb = v0[3] * c0[2] + v0[2] * c0[3]; v0[2] = a; v0[3] = bb;
                        a = v1[0] * c1[0] - v1[1] * c1[1]; bb = v1[1] * c1[0] + v1[0] * c1[1]; v1[0] = a; v1[1] = bb;
                        a = v1[2] * c1[2] - v1[3] * c1[3]; bb = v1[3] * c1[2] + v1[2] * c1[3]; v1[2] = a; v1[3] = bb;
                        if (isq) { v0 = v0 * 0.125f; v1 = v1 * 0.125f; }
                    }
                    u32x4 w; w.x = pk2(v0[0], v0[1]); w.y = pk2(v0[2], v0[3]); w.z = pk2(v1[0], v1[1]); w.w = pk2(v1[2], v1[3]);
                    if (pn == 6) {
                        const int gg = hc >> 6, d = hc & 63;
                        *(u32x4*)(KCV + (((size_t)(bj * 32 + b * 2 + gg)) * 2048 + t) * 64 + d) = w;
                    } else if ((pn == 7 || pn == 8) && bj == 1) {
                        const int gg = hc >> 6, d = hc & 63;
                        bf16_t* vp = VT + (((size_t)((pn - 7) * 32 + b * 2 + gg)) * 64 + d) * 2048 + t;
                        vp[0 * 2048] = (bf16_t)(w.x & 0xffffu); vp[1 * 2048] = (bf16_t)(w.x >> 16); vp[2 * 2048] = (bf16_t)(w.y & 0xffffu); vp[3 * 2048] = (bf16_t)(w.y >> 16);
                        vp[4 * 2048] = (bf16_t)(w.z & 0xffffu); vp[5 * 2048] = (bf16_t)(w.z >> 16); vp[6 * 2048] = (bf16_t)(w.w & 0xffffu); vp[7 * 2048] = (bf16_t)(w.w >> 16);
                    } else {
                        *(u32x4*)(PROJ + (size_t)row * NPROJ + 256 * pn + 128 * bj + hc) = w;
                    }
                    asm volatile("" ::: "memory");
                }
            }
    }
};
struct EpiCmp {
    static constexpr bool PERM = true;
    bf16_t* O; const float* bias;
    __device__ __forceinline__ void operator()(const f32x4 (&acc)[2][2][4][2], const Unit& u, int wr, int wc, int fr, int fq) const {
#pragma unroll
        for (int ai = 0; ai < 2; ++ai)
#pragma unroll
            for (int m = 0; m < 4; ++m) {
                const int row = u.pm * BM + ai * HALF + wr * 64 + m * 16 + fr;
#pragma unroll
                for (int bj = 0; bj < 2; ++bj) {
                    const int col = 128 * bj + 32 * wc + 8 * fq;
                    const f32x4 b0 = *(const f32x4*)(bias + col), b1 = *(const f32x4*)(bias + col + 4);
                    f32x4 v0 = acc[ai][bj][m][0] + b0, v1 = acc[ai][bj][m][1] + b1;
#pragma unroll
                    for (int e = 0; e < 4; ++e) { v0[e] = v0[e] * fsigmoid(v0[e]); v1[e] = v1[e] * fsigmoid(v1[e]); }
                    u32x4 w; w.x = pk2(v0[0], v0[1]); w.y = pk2(v0[2], v0[3]); w.z = pk2(v1[0], v1[1]); w.w = pk2(v1[2], v1[3]);
                    *(u32x4*)(O + (size_t)row * 256 + col) = w;
                }
                asm volatile("" ::: "memory");
            }
    }
};
}

constexpr int NWAVES = 8, NTHREADS = 512;
constexpr int LDS_BYTES = 131072 + 256;
constexpr size_t WS_CTL = 0, CTL_BYTES = 16384;
constexpr int NPHASE = 14;

struct Args { const float* in[28]; float* out; unsigned char* ws; int ph_lo, ph_hi; };

#define INP(k) ((const float*)F.kp[(k)])
struct Frame {
    LAS unsigned char* lds;
    int tid, lane, wave, G, bid;
    const __attribute__((address_space(4))) unsigned long long* kp;
    float* out; unsigned char* ws;
};

__device__ __forceinline__ float wave_sum(float v) {
#pragma unroll
    for (int o = 1; o < 64; o <<= 1) v += __shfl_xor(v, o);
    return v;
}
__device__ __forceinline__ int rope_d(int d) { return d < 32 ? 2 * d : 2 * (d - 32) + 1; }
__device__ __forceinline__ int map_swiglu(int n) { const int h = n >= DFF ? 1 : 0; const int c = n - h * DFF; return 256 * (c >> 7) + 128 * h + (c & 127); }
__device__ __forceinline__ int map_proj(int n) { const bool roped = (n >= 1024 && n < 1664) || (n >= 1792 && n < 1920) || (n >= 2048 && n < 2176); return roped ? ((n & ~63) + rope_d(n & 63)) : n; }

template <int MAP, bool KPERM>
__device__ __forceinline__ void tr_item(const float* W, int K, int N, bf16_t* WT, LAS float* scr, int item, int lane) {
    const int nblk = (N + 31) / 32, kb = item / nblk, nb = item % nblk, k0 = 64 * kb, n0 = 32 * nb;
    const int n4 = (lane & 7) * 4; const bool ok = (n0 + n4) < N;
    f32x4 ld[8];
#pragma unroll
    for (int i = 0; i < 8; ++i) { const int kk = 8 * i + (lane >> 3); ld[i] = ok ? *(const f32x4*)(W + (size_t)(k0 + kk) * N + n0 + n4) : (f32x4){0.f, 0.f, 0.f, 0.f}; }
#pragma unroll
    for (int i = 0; i < 8; ++i) { const int kk = 8 * i + (lane >> 3); LAS float* d = scr + kk * 33 + n4; d[0] = ld[i][0]; d[1] = ld[i][1]; d[2] = ld[i][2]; d[3] = ld[i][3]; }
    LDS_WAIT(); asm volatile("" ::: "memory");
    const int c = lane & 7;
#pragma unroll
    for (int j = 0; j < 4; ++j) {
        const int n = (lane >> 3) + 8 * j;
        if (n0 + n < N) {
            const LAS float* s = scr + n;
            float e[8];
#pragma unroll
            for (int q = 0; q < 8; ++q) { const int kk = KPERM ? ((q & 1) * 32 + 4 * c + (q >> 1)) : (8 * c + q); e[q] = s[kk * 33]; }
            const int dn = MAP == 1 ? map_swiglu(n0 + n) : (MAP == 2 ? map_proj(n0 + n) : (n0 + n));
            u32x4 o; o.x = pk2(e[0], e[1]); o.y = pk2(e[2], e[3]); o.z = pk2(e[4], e[5]); o.w = pk2(e[6], e[7]);
            *(u32x4*)(WT + (size_t)dn * K + k0 + 8 * c) = o;
        }
    }
    LDS_WAIT(); asm volatile("" ::: "memory");
}

__device__ __forceinline__ void p_prologue(Frame& F) {
    LAS float* scr = (LAS float*)(F.lds + F.wave * 16384);
    const int gw = F.bid * NWAVES + F.wave, NGW = F.G * NWAVES;
    bf16_t* W1A = (bf16_t*)(F.ws + WS_W1A); bf16_t* W1B = (bf16_t*)(F.ws + WS_W1B); bf16_t* WMI = (bf16_t*)(F.ws + WS_WMI); bf16_t* WMO = (bf16_t*)(F.ws + WS_WMO);
    bf16_t* W2A = (bf16_t*)(F.ws + WS_W2A); bf16_t* W2B = (bf16_t*)(F.ws + WS_W2B); bf16_t* WC1 = (bf16_t*)(F.ws + WS_WC1);
    constexpr int I_A = (DM / 64) * (NFF2 / 32), I_B = (DFF / 64) * (DM / 32), I_MI = (DM / 64) * ((INCOLS + 31) / 32), I_MO = (DM / 64) * (DM / 32), I_C = (2048 / 64) * (256 / 32);
    constexpr int NITEMS = 2 * I_A + 2 * I_B + I_MI + I_MO + 2 * I_C;
    for (int it = gw; it < NITEMS; it += NGW) {
        int r = it;
        if (r < I_A) { tr_item<1, false>(INP(1), DM, NFF2, W1A, scr, r, F.lane); continue; } r -= I_A;
        if (r < I_A) { tr_item<1, false>(INP(24), DM, NFF2, W2A, scr, r, F.lane); continue; } r -= I_A;
        if (r < I_B) { tr_item<0, false>(INP(2), DFF, DM, W1B, scr, r, F.lane); continue; } r -= I_B;
        if (r < I_B) { tr_item<0, false>(INP(25), DFF, DM, W2B, scr, r, F.lane); continue; } r -= I_B;
        if (r < I_MI) { tr_item<2, false>(INP(5), DM, INCOLS, WMI, scr, r, F.lane); continue; } r -= I_MI;
        if (r < I_MO) { tr_item<0, false>(INP(21), DM, DM, WMO, scr, r, F.lane); continue; } r -= I_MO;
        if (r < I_C) { tr_item<0, true>(INP(14), 2048, 256, WC1, scr, r, F.lane); continue; } r -= I_C;
        tr_item<0, false>(INP(17), 2048, 256, WC1 + (size_t)256 * 2048, scr, r, F.lane);
    }
    const int gt = F.bid * NTHREADS + F.tid, NGT = F.G * NTHREADS;
    { u32x4* z = (u32x4*)(WMI + (size_t)INCOLS * DM); const int nz = (NPROJ - INCOLS) * DM / 8;
      for (int i = gt; i < nz; i += NGT) z[i] = (u32x4){0u, 0u, 0u, 0u}; }
    { float* R = (float*)(F.ws + WS_ROPE);
      for (int i = gt; i < 2048 * 32; i += NGT) {
          const int t = i >> 5, k = i & 31;
          const float inv = __builtin_amdgcn_exp2f(-(float)k * 0.41524101186092029f);
          const float ang = (float)t * inv;
          const float kk = rintf(ang * 0.15915494309189535f);
          float rr = fmaf(-kk, 6.28318548202514648f, ang); rr = fmaf(-kk, -1.74845553e-7f, rr);
          const float fr = rr * 0.15915494309189535f;
          R[2 * i] = __builtin_amdgcn_cosf(fr); R[2 * i + 1] = __builtin_amdgcn_sinf(fr);
      } }
    { const float* x = INP(0); bf16_t* XB = (bf16_t*)(F.ws + WS_AB);
      for (int m = 2 * gw; m < MTOK; m += 2 * NGW) {
          const f32x4* xr = (const f32x4*)(x + (size_t)m * DM) + F.lane; u32x2* o = (u32x2*)(XB + (size_t)m * DM) + F.lane;
          f32x4 v[8];
#pragma unroll
          for (int j = 0; j < 8; ++j) v[j] = xr[64 * j];
#pragma unroll
          for (int j = 0; j < 8; ++j) o[64 * j] = (u32x2){pk2(v[j][0], v[j][1]), pk2(v[j][2], v[j][3])};
      } }
    if (F.bid < 64) {
        __syncthreads();
        const int wsel = F.bid >> 5, nb0 = (F.bid & 31) * 8;
        const float* pe = INP(wsel == 0 ? 13 : 16); const float* w1 = INP(wsel == 0 ? 14 : 17);
        float acc8[8];
#pragma unroll
        for (int e = 0; e < 8; ++e) acc8[e] = 0.f;
#pragma unroll
        for (int r4 = 0; r4 < 4; ++r4) {
            const int kk = F.tid * 4 + r4; const float pv = pe[kk];
            const f32x4 a = *(const f32x4*)(w1 + (size_t)kk * 256 + nb0), b = *(const f32x4*)(w1 + (size_t)kk * 256 + nb0 + 4);
            acc8[0] += pv * a[0]; acc8[1] += pv * a[1]; acc8[2] += pv * a[2]; acc8[3] += pv * a[3]; acc8[4] += pv * b[0]; acc8[5] += pv * b[1]; acc8[6] += pv * b[2]; acc8[7] += pv * b[3];
        }
        LAS float* red = (LAS float*)F.lds;
#pragma unroll
        for (int e = 0; e < 8; ++e) { const float sv = wave_sum(acc8[e]); if (F.lane == 0) red[F.wave * 8 + e] = sv; }
        __syncthreads();
        if (F.tid < 8) { float t = 0.f;
#pragma unroll
            for (int wv = 0; wv < 8; ++wv) t += red[wv * 8 + F.tid];
            ((float*)(F.ws + WS_CBIAS))[wsel * 256 + nb0 + F.tid] = t; }
        __syncthreads();
    }
}

template <bool OUT_F32>
__device__ __forceinline__ void p_layernorm(Frame& F, const bf16_t* Z, const float* g, const float* bta, bf16_t* OB, float* OF) {
    const int gw = F.bid * NWAVES + F.wave, NGW = F.G * NWAVES;
    float gv[16], bv[16];
#pragma unroll
    for (int e = 0; e < 16; ++e) { gv[e] = g[16 * F.lane + e]; bv[e] = bta[16 * F.lane + e]; }
    for (int m = 2 * gw; m < MTOK; m += 2 * NGW) {
        u32x4 raw[2][2];
#pragma unroll
        for (int rr = 0; rr < 2; ++rr) { const u32x4* zr = (const u32x4*)(Z + (size_t)(m + rr) * DM + 16 * F.lane); raw[rr][0] = zr[0]; raw[rr][1] = zr[1]; }
#pragma unroll
        for (int rr = 0; rr < 2; ++rr) {
            float v[16];
            const u32x4 a = raw[rr][0], b = raw[rr][1];
            v[0] = bflo(a.x); v[1] = bfhi(a.x); v[2] = bflo(a.y); v[3] = bfhi(a.y); v[4] = bflo(a.z); v[5] = bfhi(a.z); v[6] = bflo(a.w); v[7] = bfhi(a.w);
            v[8] = bflo(b.x); v[9] = bfhi(b.x); v[10] = bflo(b.y); v[11] = bfhi(b.y); v[12] = bflo(b.z); v[13] = bfhi(b.z); v[14] = bflo(b.w); v[15] = bfhi(b.w);
            float s = 0.f;
#pragma unroll
            for (int e = 0; e < 16; ++e) s += v[e];
            const float mean = wave_sum(s) * (1.f / DM); float s2 = 0.f;
#pragma unroll
            for (int e = 0; e < 16; ++e) { v[e] -= mean; s2 += v[e] * v[e]; }
            const float rstd = 1.f / sqrtf(wave_sum(s2) * (1.f / DM) + LN_EPS);
#pragma unroll
            for (int e = 0; e < 16; ++e) v[e] = v[e] * rstd * gv[e] + bv[e];
            if (OUT_F32) {
                f32x4* o = (f32x4*)(OF + (size_t)(m + rr) * DM + 16 * F.lane);
                o[0] = (f32x4){v[0], v[1], v[2], v[3]}; o[1] = (f32x4){v[4], v[5], v[6], v[7]}; o[2] = (f32x4){v[8], v[9], v[10], v[11]}; o[3] = (f32x4){v[12], v[13], v[14], v[15]};
            } else {
                u32x4* o = (u32x4*)(OB + (size_t)(m + rr) * DM + 16 * F.lane);
                u32x4 oa, ob; oa.x = pk2(v[0], v[1]); oa.y = pk2(v[2], v[3]); oa.z = pk2(v[4], v[5]); oa.w = pk2(v[6], v[7]);
                ob.x = pk2(v[8], v[9]); ob.y = pk2(v[10], v[11]); ob.z = pk2(v[12], v[13]); ob.w = pk2(v[14], v[15]);
                o[0] = oa; o[1] = ob;
            }
        }
    }
}

__device__ __forceinline__ void p_rmsnorm(Frame& F, bf16_t* Y, const float* gl, const float* gn) {
    const int gw = F.bid * NWAVES + F.wave, NGW = F.G * NWAVES;
    const float* gp = (F.lane < 32) ? (gl + 16 * F.lane) : (gn + 16 * (F.lane - 32));
    float gvv[16];
#pragma unroll
    for (int e = 0; e < 16; ++e) gvv[e] = gp[e];
    for (int m = gw; m < MTOK; m += NGW) {
        u32x4* yr = (u32x4*)(Y + (size_t)m * DM + 16 * F.lane);
        const u32x4 a = yr[0], b = yr[1];
        float v[16];
        v[0] = bflo(a.x); v[1] = bfhi(a.x); v[2] = bflo(a.y); v[3] = bfhi(a.y); v[4] = bflo(a.z); v[5] = bfhi(a.z); v[6] = bflo(a.w); v[7] = bfhi(a.w);
        v[8] = bflo(b.x); v[9] = bfhi(b.x); v[10] = bflo(b.y); v[11] = bfhi(b.y); v[12] = bflo(b.z); v[13] = bfhi(b.z); v[14] = bflo(b.w); v[15] = bfhi(b.w);
        float s = 0.f;
#pragma unroll
        for (int e = 0; e < 16; ++e) s += v[e] * v[e];
#pragma unroll
        for (int o = 1; o < 32; o <<= 1) s += __shfl_xor(s, o);
        const float r = 1.f / sqrtf(s * (1.f / 512.f) + RMS_EPS);
#pragma unroll
        for (int e = 0; e < 16; ++e) v[e] = v[e] * r * gvv[e];
        u32x4 oa, ob; oa.x = pk2(v[0], v[1]); oa.y = pk2(v[2], v[3]); oa.z = pk2(v[4], v[5]); oa.w = pk2(v[6], v[7]);
        ob.x = pk2(v[8], v[9]); ob.y = pk2(v[10], v[11]); ob.z = pk2(v[12], v[13]); ob.w = pk2(v[14], v[15]);
        yr[0] = oa; yr[1] = ob;
    }
}

__device__ __forceinline__ void cmp_second(Frame& F, int which, int pm) {
    const int lane = F.lane, quad = lane >> 4, l16 = lane & 15;
    const float* w2 = INP(which == 0 ? 15 : 18);
    LAS bf16_t* WT = (LAS bf16_t*)F.lds;
    for (int idx = F.tid; idx < 256 * 64; idx += NTHREADS) { const int k = idx >> 6, d = idx & 63; WT[d * 264 + k] = (bf16_t)(pk2(w2[idx], 0.f) & 0xffffu); }
    __builtin_amdgcn_fence(__ATOMIC_RELEASE, "agent");
    __syncthreads();
    __builtin_amdgcn_fence(__ATOMIC_ACQUIRE, "agent");
    const bf16_t* HID = (const bf16_t*)(F.ws + WS_HID) + ((size_t)which * 4096 + 256 * pm) * 256;
    bf16_t* KC = (bf16_t*)(F.ws + WS_KC); bf16_t* VCT = (bf16_t*)(F.ws + WS_VCT);
#pragma unroll 1
    for (int mi = 0; mi < 2; ++mi) {
        const int r0 = (2 * F.wave + mi) * 16;
        bf16x8 af[8];
#pragma unroll
        for (int ks = 0; ks < 8; ++ks) af[ks] = *(const bf16x8*)(HID + (size_t)(r0 + l16) * 256 + ks * 32 + quad * 8);
#pragma unroll
        for (int nt = 0; nt < 4; ++nt) {
            f32x4 c = {0.f, 0.f, 0.f, 0.f};
#pragma unroll
            for (int ks = 0; ks < 8; ++ks) { const bf16x8 bfr = *(const LAS bf16x8*)(WT + (nt * 16 + l16) * 264 + ks * 32 + quad * 8); c = __builtin_amdgcn_mfma_f32_16x16x32_bf16(af[ks], bfr, c, 0, 0, 0); }
#pragma unroll
            for (int j = 0; j < 4; ++j) {
                const int row = 256 * pm + r0 + quad * 4 + j, d = nt * 16 + l16;
                const bf16_t hb = (bf16_t)(pk2(c[j], 0.f) & 0xffffu);
                if (which == 0) KC[(size_t)row * 64 + rope_d(d)] = hb;
                else VCT[((size_t)(row >> 7) * 64 + d) * 128 + (row & 127)] = hb;
            }
        }
    }
    __syncthreads();
}

constexpr int LR2_XC = 0, LR2_XCW = 9216, LR2_SUM = 8 * 9216;
__device__ __forceinline__ void lru_unit(Frame& F, int u) {
    const int b = u >> 4, h = (u >> 1) & 7, jh = u & 1;
    const int lane = F.lane, w = F.wave, quad = lane >> 4, l16 = lane & 15, ca0 = 8 * (lane & 7), tg = lane >> 3;
    const bf16_t* PROJ = (const bf16_t*)(F.ws + WS_ACT); bf16_t* Y = (bf16_t*)(F.ws + WS_Y);
    LAS unsigned char* xc = F.lds + LR2_XC + w * LR2_XCW;
    LAS float* SUM = (LAS float*)(F.lds + LR2_SUM);
    bf16x8 wf[2][2][2];
#pragma unroll
    for (int gsel = 0; gsel < 2; ++gsel)
#pragma unroll
        for (int nt = 0; nt < 2; ++nt)
#pragma unroll
            for (int sk = 0; sk < 2; ++sk) {
                const float* wsrc = INP(gsel == 0 ? 8 : 10) + ((size_t)(h * 64 + sk * 32 + quad * 8)) * 64 + 32 * jh + nt * 16 + l16;
                u32x4 pw; pw.x = pk2(wsrc[0], wsrc[64]); pw.y = pk2(wsrc[128], wsrc[192]); pw.z = pk2(wsrc[256], wsrc[320]); pw.w = pk2(wsrc[384], wsrc[448]);
                wf[gsel][nt][sk] = __builtin_bit_cast(bf16x8, pw);
            }
    float ba[2], bx[2], c8[2];
#pragma unroll
    for (int nt = 0; nt < 2; ++nt) { const int c = 64 * h + 32 * jh + nt * 16 + l16; ba[nt] = INP(9)[c]; bx[nt] = INP(11)[c]; c8[nt] = 8.0f * log1pf(expf(-INP(12)[c])); }
    float cw[4][8], cb[8];
#pragma unroll
    for (int e = 0; e < 8; ++e) { cb[e] = INP(7)[64 * h + ca0 + e];
#pragma unroll
        for (int jt = 0; jt < 4; ++jt) cw[jt][e] = INP(6)[jt * 512 + 64 * h + ca0 + e]; }
    float hin[2] = {0.f, 0.f};
#pragma unroll 1
    for (int pass = 0; pass < 2; ++pass) {
        float hc[2] = {hin[0], hin[1]}, pc[2] = {1.f, 1.f};
#pragma unroll 1
        for (int sub = 0; sub < 4; ++sub) {
            const int t0 = 256 * w + 64 * sub;
            {
                u32x4 raw[11];
#pragma unroll
                for (int k = 0; k < 11; ++k) { const int ts = t0 + 8 * tg - 3 + k; raw[k] = (ts >= 0) ? *(const u32x4*)(PROJ + ((size_t)(b * 2048 + ts)) * NPROJ + 64 * h + ca0) : (u32x4){0u, 0u, 0u, 0u}; }
#pragma unroll
                for (int i = 0; i < 8; ++i) {
                    float a[8];
#pragma unroll
                    for (int e = 0; e < 8; ++e) a[e] = cb[e];
#pragma unroll
                    for (int jt = 0; jt < 4; ++jt) { const u32x4 rw = raw[i + jt];
                        a[0] += cw[jt][0] * bflo(rw.x); a[1] += cw[jt][1] * bfhi(rw.x); a[2] += cw[jt][2] * bflo(rw.y); a[3] += cw[jt][3] * bfhi(rw.y);
                        a[4] += cw[jt][4] * bflo(rw.z); a[5] += cw[jt][5] * bfhi(rw.z); a[6] += cw[jt][6] * bflo(rw.w); a[7] += cw[jt][7] * bfhi(rw.w); }
                    u32x4 pw; pw.x = pk2(a[0], a[1]); pw.y = pk2(a[2], a[3]); pw.z = pk2(a[4], a[5]); pw.w = pk2(a[6], a[7]);
                    *(LAS u32x4*)(xc + (8 * tg + i) * 144 + ca0 * 2) = pw;
                }
            }
#pragma unroll 1
            for (int mt = 0; mt < 4; ++mt) {
                const bf16x8 af0 = *(const LAS bf16x8*)(xc + (16 * mt + l16) * 144 + (quad * 8) * 2), af1 = *(const LAS bf16x8*)(xc + (16 * mt + l16) * 144 + (32 + quad * 8) * 2);
                const int trow = t0 + 16 * mt + quad * 4;
                float gt[2][4];
                if (pass == 1) {
#pragma unroll
                    for (int nt = 0; nt < 2; ++nt)
#pragma unroll
                        for (int j = 0; j < 4; ++j) gt[nt][j] = bf2f(PROJ[((size_t)(b * 2048 + trow + j)) * NPROJ + 512 + 64 * h + 32 * jh + nt * 16 + l16]);
                }
                f32x4 acc[2][2];
#pragma unroll
                for (int gsel = 0; gsel < 2; ++gsel)
#pragma unroll
                    for (int nt = 0; nt < 2; ++nt) { f32x4 c = {0.f, 0.f, 0.f, 0.f}; c = __builtin_amdgcn_mfma_f32_16x16x32_bf16(af0, wf[gsel][nt][0], c, 0, 0, 0); c = __builtin_amdgcn_mfma_f32_16x16x32_bf16(af1, wf[gsel][nt][1], c, 0, 0, 0); acc[gsel][nt] = c; }
#pragma unroll
                for (int nt = 0; nt < 2; ++nt) {
                    float av[4], uv[4];
#pragma unroll
                    for (int j = 0; j < 4; ++j) {
                        const float xcv = bf2f(*(const LAS bf16_t*)(xc + (16 * mt + quad * 4 + j) * 144 + (32 * jh + nt * 16 + l16) * 2));
                        const float r = fsigmoid(acc[0][nt][j] + ba[nt]), ig = fsigmoid(acc[1][nt][j] + bx[nt]);
                        const float la = -c8[nt] * r, x2 = 2.0f * la;
                        av[j] = __builtin_amdgcn_exp2f(la * L2E);
                        const float em = (x2 > -0.3f) ? x2 * (1.0f + x2 * (0.5f + x2 * (0.16666667f + x2 * (0.041666668f + x2 * (0.0083333338f + x2 * 0.0013888889f)))))
                                                      : (__builtin_amdgcn_exp2f(x2 * L2E) - 1.0f);
                        const float mult = (trow + j == 0) ? 1.0f : __builtin_amdgcn_sqrtf(-em);
                        uv[j] = mult * ig * xcv;
                    }
                    float P = av[0], H = uv[0];
#pragma unroll
                    for (int j = 1; j < 4; ++j) { H = av[j] * H + uv[j]; P *= av[j]; }
                    float Pp = __shfl_up(P, 16), Hp = __shfl_up(H, 16);
                    if (quad >= 1) { H = P * Hp + H; P = Pp * P; }
                    Pp = __shfl_up(P, 32); Hp = __shfl_up(H, 32);
                    if (quad >= 2) { H = P * Hp + H; P = Pp * P; }
                    const float Pt = __shfl(P, 48 + l16), Ht = __shfl(H, 48 + l16);
                    if (pass == 1) {
                        float Pe = __shfl_up(P, 16), He = __shfl_up(H, 16);
                        if (quad == 0) { Pe = 1.0f; He = 0.0f; }
                        float hq = Pe * hc[nt] + He;
#pragma unroll
                        for (int j = 0; j < 4; ++j) {
                            hq = av[j] * hq + uv[j];
                            const float x = gt[nt][j], z = 0.7978845608028654f * (x + 0.044715f * x * x * x);
                            const float th = 1.0f - 2.0f * __builtin_amdgcn_rcpf(1.0f + __builtin_amdgcn_exp2f(2.0f * z * L2E));
                            const float yv = hq * (0.5f * x * (1.0f + th));
                            Y[((size_t)(b * 2048 + trow + j)) * DM + 64 * h + 32 * jh + nt * 16 + l16] = (bf16_t)(pk2(yv, 0.f) & 0xffffu);
                        }
                    }
                    hc[nt] = Pt * hc[nt] + Ht; pc[nt] *= Pt;
                }
            }
        }
        if (pass == 0) {
            if (quad == 0) {
#pragma unroll
                for (int nt = 0; nt < 2; ++nt) { SUM[(w * 32 + nt * 16 + l16) * 2] = pc[nt]; SUM[(w * 32 + nt * 16 + l16) * 2 + 1] = hc[nt]; }
            }
            __syncthreads();
            for (int w2 = 0; w2 < w; ++w2) {
#pragma unroll
                for (int nt = 0; nt < 2; ++nt) hin[nt] = SUM[(w2 * 32 + nt * 16 + l16) * 2] * hin[nt] + SUM[(w2 * 32 + nt * 16 + l16) * 2 + 1];
            }
        }
    }
    __syncthreads();
}

constexpr int AT_KC = 0, AT_VC = 18432, AT_K = 35328, AT_V = 44544, AT_IMPP = 53248, AT_IMP = 87040, AT_SEL = 95488;
__device__ __forceinline__ int crow(int r, int hi) { return (r & 3) + 8 * (r >> 2) + 4 * hi; }
#define MFMA32(a, b, c) __builtin_amdgcn_mfma_f32_32x32x16_bf16((a), (b), (c), 0, 0, 0)
__device__ __forceinline__ f32x16 qk_tile(const LAS unsigned char* Kl, int krow0, const bf16x8 (&qf)[4], int i, int hi) {
    f32x16 p;
#pragma unroll
    for (int r = 0; r < 16; ++r) p[r] = 0.f;
    const LAS unsigned char* kp = Kl + (krow0 + i) * 144 + hi * 16;
#pragma unroll
    for (int d0 = 0; d0 < 4; ++d0) { const bf16x8 a = *(const LAS bf16x8*)(kp + d0 * 32); p = MFMA32(a, qf[d0], p); }
    return p;
}
__device__ __forceinline__ bf16x8 pack8(const f32x16& p, int s) {
    u32x4 w; w.x = pk2(p[8 * s], p[8 * s + 1]); w.y = pk2(p[8 * s + 2], p[8 * s + 3]); w.z = pk2(p[8 * s + 4], p[8 * s + 5]); w.w = pk2(p[8 * s + 6], p[8 * s + 7]);
    return __builtin_bit_cast(bf16x8, w);
}
__device__ __forceinline__ void pv_step(f32x16 (&o)[2], const LAS unsigned char* Vl, int VS, int kbase, bf16x8 pb, int i, int hi) {
#pragma unroll
    for (int d0t = 0; d0t < 2; ++d0t) {
        const LAS unsigned char* vp = Vl + (32 * d0t + i) * VS + (kbase + 4 * hi) * 2;
        const s16x4 lo = *(const LAS s16x4*)vp, hi4 = *(const LAS s16x4*)(vp + 16);
        const bf16x8 a = __builtin_shufflevector(lo, hi4, 0, 1, 2, 3, 4, 5, 6, 7);
        o[d0t] = MFMA32(a, pb, o[d0t]);
    }
}
template <int MODE>
__device__ __forceinline__ void attn_branch(const bf16_t* Kg, const bf16_t* VTg, int kt_lo, int kt_hi, unsigned selw, unsigned unionmask, int tq,
                                            const bf16x8 (&qf)[4], LAS unsigned char* lds, int tid, int i, int hi, float gate, f32x16 (&tot)[2]) {
    f32x16 o[2];
#pragma unroll
    for (int r = 0; r < 16; ++r) { o[0][r] = 0.f; o[1][r] = 0.f; }
    float m = -INFINITY, l = 0.f;
    const int ldrow = tid >> 3, ldch = tid & 7;
    const bf16_t* kgp = Kg + (size_t)ldrow * NPROJ + ldch * 8;
    const bf16_t* vgp = VTg + (size_t)ldrow * 2048 + ldch * 8;
    unsigned todo = (MODE == 1) ? (unionmask & (kt_hi >= 31 ? 0xffffffffu : ((2u << kt_hi) - 1u))) : (((kt_hi >= 31) ? 0xffffffffu : ((2u << kt_hi) - 1u)) & ~((1u << kt_lo) - 1u));
    u32x4 kv = {0u, 0u, 0u, 0u}, vv = {0u, 0u, 0u, 0u};
    if (todo) { const int k0 = __builtin_ctz(todo); kv = *(const u32x4*)(kgp + (size_t)k0 * 64 * NPROJ); vv = *(const u32x4*)(vgp + k0 * 64); }
    while (todo) {
        const int kt = __builtin_ctz(todo); todo &= todo - 1u;
        {
            *(LAS u32x4*)(lds + AT_K + ldrow * 144 + ldch * 16) = kv;
            LAS u32x2* vd = (LAS u32x2*)(lds + AT_V + ldrow * 136 + ldch * 16); vd[0] = (u32x2){vv.x, vv.y}; vd[1] = (u32x2){vv.z, vv.w};
        }
        __syncthreads();
        if (todo) { const int kn = __builtin_ctz(todo); kv = *(const u32x4*)(kgp + (size_t)kn * 64 * NPROJ); vv = *(const u32x4*)(vgp + kn * 64); }
        f32x16 p0 = qk_tile(lds + AT_K, 0, qf, i, hi), p1 = qk_tile(lds + AT_K, 32, qf, i, hi);
        const bool selbit = (MODE == 1) ? (((selw >> kt) & 1u) != 0u) : true;
        float mx = -INFINITY;
        const int rel = tq - kt * 64 - 4 * hi;
#pragma unroll
        for (int r = 0; r < 16; ++r) {
            const int cr0 = (r & 3) + 8 * (r >> 2), cr1 = cr0 + 32;
            const bool v0 = selbit && cr0 <= rel && (MODE == 1 || cr0 >= rel - 511);
            const bool v1 = selbit && cr1 <= rel && (MODE == 1 || cr1 >= rel - 511);
            p0[r] = v0 ? p0[r] : -INFINITY; p1[r] = v1 ? p1[r] : -INFINITY;
            mx = fmaxf(mx, fmaxf(p0[r], p1[r]));
        }
        mx = fmaxf(mx, __shfl_xor(mx, 32));
        const float mnew = fmaxf(m, mx), msafe = (mnew == -INFINITY) ? 0.f : mnew;
        const float alpha = __builtin_amdgcn_exp2f((m - msafe) * L2E);
        float ls = 0.f;
#pragma unroll
        for (int r = 0; r < 16; ++r) { p0[r] = __builtin_amdgcn_exp2f((p0[r] - msafe) * L2E); p1[r] = __builtin_amdgcn_exp2f((p1[r] - msafe) * L2E); ls += p0[r] + p1[r]; }
        l = l * alpha + ls; m = mnew;
#pragma unroll
        for (int r = 0; r < 16; ++r) { o[0][r] *= alpha; o[1][r] *= alpha; }
        pv_step(o, lds + AT_V, 136, 0, pack8(p0, 0), i, hi);
        pv_step(o, lds + AT_V, 136, 16, pack8(p0, 1), i, hi);
        pv_step(o, lds + AT_V, 136, 32, pack8(p1, 0), i, hi);
        pv_step(o, lds + AT_V, 136, 48, pack8(p1, 1), i, hi);
        __syncthreads();
    }
    l += __shfl_xor(l, 32);
    const float sc = gate / l;
#pragma unroll
    for (int r = 0; r < 16; ++r) { tot[0][r] += o[0][r] * sc; tot[1][r] += o[1][r] * sc; }
}

__device__ __forceinline__ void attn_unit(Frame& F, int b, int g, int qt) {
    const int tid = F.tid, lane = F.lane, w = F.wave, i = lane & 31, hi = lane >> 5, r = w >> 1;
    const int bg = b * 2 + g, t0 = qt * 64, tl = 32 * (w & 1) + i, tq = t0 + tl;
    const size_t row = (size_t)b * 2048 + tq;
    LAS unsigned char* lds = F.lds;
    const bf16_t* PROJ = (const bf16_t*)(F.ws + WS_ACT); bf16_t* Y = (bf16_t*)(F.ws + WS_Y);
    const bf16_t* KC = (const bf16_t*)(F.ws + WS_KC); const bf16_t* VCT = (const bf16_t*)(F.ws + WS_VCT); const bf16_t* VT = (const bf16_t*)(F.ws + WS_VT);
    bf16x8 qf[4];
    { const bf16_t* qp = PROJ + row * NPROJ + 1024 + 64 * (4 * g + r) + 8 * hi;
#pragma unroll
      for (int d0 = 0; d0 < 4; ++d0) qf[d0] = *(const bf16x8*)(qp + 16 * d0); }
    float g0, g1, g2;
    { const bf16_t* gp = PROJ + row * NPROJ + 2304 + (4 * g + r) * 3; g0 = fsigmoid(bf2f(gp[0])); g1 = fsigmoid(bf2f(gp[1])); g2 = fsigmoid(bf2f(gp[2])); }
#pragma unroll
    for (int c2 = 0; c2 < 2; ++c2) {
        const int idx = tid + NTHREADS * c2;
        { const int rk = idx >> 3, ch = idx & 7; const u32x4 v = *(const u32x4*)(KC + ((size_t)bg * 128 + rk) * 64 + ch * 8); *(LAS u32x4*)(lds + AT_KC + rk * 144 + ch * 16) = v; }
        { const int rd = idx >> 4, ch = idx & 15; const u32x4 v = *(const u32x4*)(VCT + ((size_t)bg * 64 + rd) * 128 + ch * 8);
          LAS u32x2* vd = (LAS u32x2*)(lds + AT_VC + rd * 264 + ch * 16); vd[0] = (u32x2){v.x, v.y}; vd[1] = (u32x2){v.z, v.w}; }
    }
    __syncthreads();
    f32x16 tot[2];
    {
        f32x16 p[4];
#pragma unroll
        for (int kt = 0; kt < 4; ++kt) p[kt] = qk_tile(lds + AT_KC, 32 * kt, qf, i, hi);
        const int nv = tq >= 31 ? (((tq - 31) >> 4) + 1) : 0;
        const int nvl = nv - 4 * hi;
        float mx = -INFINITY;
#pragma unroll
        for (int kt = 0; kt < 4; ++kt)
#pragma unroll
            for (int rr = 0; rr < 16; ++rr) { const int nc = 32 * kt + (rr & 3) + 8 * (rr >> 2); p[kt][rr] = (nc < nvl) ? p[kt][rr] : -INFINITY; mx = fmaxf(mx, p[kt][rr]); }
        mx = fmaxf(mx, __shfl_xor(mx, 32));
        const float msafe = (mx == -INFINITY) ? 0.f : mx;
        float ls = 0.f;
#pragma unroll
        for (int kt = 0; kt < 4; ++kt)
#pragma unroll
            for (int rr = 0; rr < 16; ++rr) { p[kt][rr] = __builtin_amdgcn_exp2f((p[kt][rr] - msafe) * L2E); ls += p[kt][rr]; }
        ls += __shfl_xor(ls, 32);
        const float inv = ls > 0.f ? 1.0f / ls : 0.f;
#pragma unroll
        for (int kt = 0; kt < 4; ++kt)
#pragma unroll
            for (int rr = 0; rr < 16; ++rr) p[kt][rr] *= inv;
        float Qs[16], rl[16];
#pragma unroll
        for (int q4 = 0; q4 < 16; ++q4) {
            const int kt = q4 >> 2, g4 = q4 & 3;
            Qs[q4] = (p[kt][4 * g4] + p[kt][4 * g4 + 1]) + (p[kt][4 * g4 + 2] + p[kt][4 * g4 + 3]);
            rl[q4] = __shfl_xor(p[kt][4 * g4 + 3], 32);
        }
        LAS float* impp = (LAS float*)(lds + AT_IMPP) + (r * 64 + tl) * 33;
#pragma unroll
        for (int q4 = 0; q4 < 16; ++q4) {
            const float ex = hi ? rl[q4] : (q4 > 0 ? rl[q4 > 0 ? q4 - 1 : 0] : 0.f);
            impp[8 * (q4 >> 2) + 2 * (q4 & 3) + hi] = Qs[q4] + ex;
        }
        f32x16 o[2];
#pragma unroll
        for (int rr = 0; rr < 16; ++rr) { o[0][rr] = 0.f; o[1][rr] = 0.f; }
#pragma unroll
        for (int kt = 0; kt < 4; ++kt)
#pragma unroll
            for (int s = 0; s < 2; ++s) pv_step(o, lds + AT_VC, 264, 32 * kt + 16 * s, pack8(p[kt], s), i, hi);
#pragma unroll
        for (int rr = 0; rr < 16; ++rr) { tot[0][rr] = o[0][rr] * g0; tot[1][rr] = o[1][rr] * g0; }
    }
    __syncthreads();
    {
        LAS float* IMPP = (LAS float*)(lds + AT_IMPP); LAS float* IMP = (LAS float*)(lds + AT_IMP); LAS unsigned* SEL = (LAS unsigned*)(lds + AT_SEL);
#pragma unroll
        for (int it = 0; it < 4; ++it) {
            const int idx = tid + NTHREADS * it, tt = idx >> 5, j = idx & 31;
            IMP[tt * 33 + j] = ((IMPP[(0 * 64 + tt) * 33 + j] + IMPP[(1 * 64 + tt) * 33 + j]) + IMPP[(2 * 64 + tt) * 33 + j]) + IMPP[(3 * 64 + tt) * 33 + j];
        }
        __syncthreads();
#pragma unroll 1
        for (int it = 0; it < 4; ++it) {
            const int idx = tid + NTHREADS * it, tt = idx >> 5, j = idx & 31;
            const float v = IMP[tt * 33 + j];
            int cnt = 0;
#pragma unroll 2
            for (int j2 = 1; j2 <= qt - 2; ++j2) { const float v2 = IMP[tt * 33 + j2]; cnt += ((v2 > v) || (v2 == v && j2 < j)) ? 1 : 0; }
            const bool forced = (j == 0) || (j == qt) || (j == qt - 1);
            const bool sel = (j <= qt) && (forced || (j >= 1 && j <= qt - 2 && cnt < 13));
            const unsigned long long bal = __ballot(sel);
            if ((lane & 31) == 0) SEL[tt] = (lane < 32) ? (unsigned)bal : (unsigned)(bal >> 32);
        }
        __syncthreads();
    }
    unsigned selw, unionmask;
    { LAS unsigned* SEL = (LAS unsigned*)(lds + AT_SEL); selw = SEL[tl]; unsigned uu = SEL[lane];
#pragma unroll
      for (int o = 1; o < 64; o <<= 1) uu |= __shfl_xor(uu, o);
      unionmask = uu; }
    unionmask = __builtin_amdgcn_readfirstlane(unionmask);
    attn_branch<0>(PROJ + (size_t)b * 2048 * NPROJ + 2048 + 64 * g, VT + ((size_t)(32 + bg) * 64) * 2048, qt - 8 > 0 ? qt - 8 : 0, qt, 0u, 0u, tq, qf, lds, tid, i, hi, g2, tot);
    attn_branch<1>(PROJ + (size_t)b * 2048 * NPROJ + 1792 + 64 * g, VT + ((size_t)bg * 64) * 2048, 0, qt, selw, unionmask, tq, qf, lds, tid, i, hi, g1, tot);
    bf16_t* yp = Y + row * DM + 512 + 64 * (4 * g + r);
#pragma unroll
    for (int d0t = 0; d0t < 2; ++d0t)
#pragma unroll
        for (int g4 = 0; g4 < 4; ++g4) {
            const int d = 32 * d0t + 8 * g4 + 4 * hi;
            *(u32x2*)(yp + d) = (u32x2){pk2(tot[d0t][4 * g4], tot[d0t][4 * g4 + 1]), pk2(tot[d0t][4 * g4 + 2], tot[d0t][4 * g4 + 3])};
        }
}


#define XB_TMO      128
#define XB_XCNT(j)  (256  + 64 * (j))
#define XB_XSUB(j)  (1280 + 64 * (j))
#define XB_XGEN(j)  (2304 + 64 * (j))
#define XB_TOP      3328
#define XB_TOPGEN   3392
#define XCD_BAR_WORDS 3456
#define XB_SPIN_CAP (1u << 20)
__device__ __forceinline__ unsigned xb_ld(unsigned* p)              { return __hip_atomic_load(p, __ATOMIC_RELAXED, __HIP_MEMORY_SCOPE_AGENT); }
__device__ __forceinline__ unsigned xb_add(unsigned* p, unsigned v) { return __hip_atomic_fetch_add(p, v, __ATOMIC_RELAXED, __HIP_MEMORY_SCOPE_AGENT); }
__device__ __forceinline__ unsigned xb_xcc_id() { return (unsigned)__builtin_amdgcn_s_getreg((3 << 11) | 20) & 0xFu; }
#define XB_SPIN(cond, bar) do { unsigned _sp = 0; while (cond) { __builtin_amdgcn_s_sleep(1); \
    if ((++_sp & 255u) == 0u) { if (xb_ld(&(bar)[XB_TMO])) break; if (_sp > XB_SPIN_CAP) { atomicAdd(&(bar)[XB_TMO], 1u); break; } } } } while (0)
struct XcdBarrier { unsigned* bar; unsigned x; volatile LAS unsigned* st; };
__device__ __forceinline__ XcdBarrier xcd_barrier_post(unsigned* bar, volatile LAS unsigned* st) {
    XcdBarrier b; b.bar = bar; b.x = xb_xcc_id(); b.st = st;
    if (threadIdx.x == 0) (void)xb_add(&bar[XB_XCNT(b.x)], 1u);
    return b;
}
__device__ __forceinline__ void xcd_barrier_complete(unsigned* bar, unsigned x, unsigned& nloc, unsigned& nx) {
    const unsigned G = gridDim.x * gridDim.y * gridDim.z;
    unsigned sum, cnt, mine, sp = 0u;
    for (;;) {
        sum = 0u; cnt = 0u; mine = 0u;
#pragma unroll
        for (unsigned j = 0; j < 16; ++j) { const unsigned c = xb_ld(&bar[XB_XCNT(j)]); sum += c; cnt += (c > 0u) ? 1u : 0u; mine = (j == x) ? c : mine; }
        if (sum == G) break;
        __builtin_amdgcn_s_sleep(1);
        if ((++sp & 255u) == 0u) { if (xb_ld(&bar[XB_TMO])) break; if (sp > XB_SPIN_CAP) { atomicAdd(&bar[XB_TMO], 1u); break; } }
    }
    nloc = mine > 0u ? mine : 1u; nx = cnt > 0u ? cnt : 1u;
}
__device__ __forceinline__ void xcd_barrier(const XcdBarrier& b) {
    asm volatile("s_waitcnt vmcnt(0)" ::: "memory");
    __syncthreads();
    if (threadIdx.x == 0) {
        unsigned* bar = b.bar;
        __builtin_amdgcn_s_waitcnt(0);
        unsigned nloc = b.st[0], nx = b.st[1];
        if (nloc == 0u) { xcd_barrier_complete(bar, b.x, nloc, nx); b.st[0] = nloc; b.st[1] = nx; }
        const unsigned old = xb_add(&bar[XB_XSUB(b.x)], 1u);
        const unsigned gen = old / nloc;
        if (old + 1u == (gen + 1u) * nloc) {
            __builtin_amdgcn_fence(__ATOMIC_RELEASE, "agent");
            asm volatile("s_waitcnt vmcnt(0)" ::: "memory");
            const unsigned og = xb_add(&bar[XB_TOP], 1u);
            const unsigned tg = og / nx;
            if (og + 1u == (tg + 1u) * nx) xb_add(&bar[XB_TOPGEN], 1u);
            else XB_SPIN(xb_ld(&bar[XB_TOPGEN]) == tg, bar);
            __builtin_amdgcn_fence(__ATOMIC_ACQUIRE, "agent");
            xb_add(&bar[XB_XGEN(b.x)], 1u);
            asm volatile("s_waitcnt vmcnt(0)" ::: "memory");
        } else {
            XB_SPIN(xb_ld(&bar[XB_XGEN(b.x)]) == gen, bar);
            __builtin_amdgcn_fence(__ATOMIC_ACQUIRE, "agent");
            asm volatile("s_waitcnt vmcnt(0)" ::: "memory");
        }
    }
    __syncthreads();
}

__global__ void __launch_bounds__(NTHREADS, 2) hymba_fwd(Args args) {
    extern __shared__ __attribute__((aligned(16))) unsigned char lds_raw[];
    cg::grid_group grid = cg::this_grid();
    Frame F;
    F.lds = (LAS unsigned char*)lds_raw;
    F.G = gridDim.x;
    if (threadIdx.x < 64) ((LAS unsigned*)(F.lds + 131072))[threadIdx.x] = 0u;
    __syncthreads();
    const XcdBarrier xbar = xcd_barrier_post((unsigned*)(args.ws + WS_CTL), (volatile LAS unsigned*)(F.lds + 131072));
    if (args.ph_hi > 1000) grid.sync();

    const int lo = args.ph_lo, hi = args.ph_hi;
#define RELAUNDER() do { int tv = threadIdx.x; asm volatile("" : "+v"(tv)); F.tid = tv; F.lane = tv & 63; F.wave = __builtin_amdgcn_readfirstlane(tv >> 6); \
        int bv = blockIdx.x; asm volatile("" : "+s"(bv)); F.bid = bv; \
        const __attribute__((address_space(4))) unsigned long long* kv = (const __attribute__((address_space(4))) unsigned long long*)__builtin_amdgcn_kernarg_segment_ptr(); asm volatile("" : "+s"(kv)); F.kp = kv; \
        F.ws = (unsigned char*)kv[29]; F.out = (float*)kv[28]; } while (0)
#ifndef REPMASK
#define REPMASK 0
#endif
#define PH(k) if (lo <= (k) && (k) < hi) for (int rep_ = 0; rep_ < 1 + ((REPMASK >> (k)) & 1); ++rep_)
#define SEAM(k) do { if ((k) + 1 < hi || rep_ < ((REPMASK >> (k)) & 1)) xcd_barrier(xbar); } while (0)
#define WSB(off) ((bf16_t*)(F.ws + (off)))

    PH(0) { RELAUNDER();
#ifndef NO_P0
        p_prologue(F);
#endif
        SEAM(0); }
    PH(1) { RELAUNDER();
        pg8::Gemm g{WSB(WS_AB), WSB(WS_W1A), MTOK, NFF2, DM, DM}; pg8::StaticOrder S; S.init(MTOK, NFF2, F.G, F.bid); pg8::EpiSwiGLU E{WSB(WS_ACT)};
#ifndef NO_P1
        pg8::gemm_phase<pg8::EpiSwiGLU, DM, DM>(F.lds, g, S, E, F.tid);
#endif
        SEAM(1); }
    PH(2) { RELAUNDER();
        pg8::Gemm g{WSB(WS_ACT), WSB(WS_W1B), MTOK, DM, DFF, DFF}; pg8::StaticOrder S; S.init(MTOK, DM, F.G, F.bid); pg8::EpiResid E{WSB(WS_AB), WSB(WS_Y), ALPHA, 0.5f};
#ifndef NO_P2
        pg8::gemm_phase<pg8::EpiResid, DFF, DFF>(F.lds, g, S, E, F.tid);
#endif
        SEAM(2); }
    PH(3) { RELAUNDER(); p_layernorm<false>(F, WSB(WS_Y), INP(3), INP(4), WSB(WS_AB), nullptr); SEAM(3); }
    PH(4) { RELAUNDER();
        pg8::Gemm g{WSB(WS_AB), WSB(WS_WMI), MTOK, NPROJ, DM, DM}; pg8::StaticOrder S; S.init(MTOK, NPROJ, F.G, F.bid);
        pg8::EpiProj E{WSB(WS_ACT), WSB(WS_KCV), WSB(WS_VT), (const float*)(F.ws + WS_ROPE)};
#ifndef NO_P4
        pg8::gemm_phase<pg8::EpiProj, DM, DM>(F.lds, g, S, E, F.tid);
#endif
        SEAM(4); }
    PH(5) { RELAUNDER();
        const int ncmp = (F.G > 64) ? 32 : 0;
        if (F.bid < 32) {
            const int which = F.bid >> 4;
            pg8::Gemm g{WSB(WS_KCV) + (size_t)which * 32 * 2048 * 64, WSB(WS_WC1) + (size_t)which * 256 * 2048, 4096, 256, 2048, 1024};
            pg8::StaticOrder S; S.init(4096, 256, F.G > 16 ? F.G : 16, F.bid & 15);
            pg8::EpiCmp E{WSB(WS_HID) + (size_t)which * 4096 * 256, (const float*)(F.ws + WS_CBIAS) + which * 256};
#ifndef NO_P5A
            pg8::gemm_phase<pg8::EpiCmp, 2048, 1024>(F.lds, g, S, E, F.tid);
#endif
            pg8::Unit cu; if (S.next(0, cu)) cmp_second(F, which, cu.pm);
        }
        if (F.bid >= ncmp) for (int u = F.bid - ncmp; u < 256; u += F.G - ncmp) {
#ifndef NO_P5B
            lru_unit(F, u);
#endif
        }
        SEAM(6); }
    PH(7) { RELAUNDER();
        for (int L = F.bid; L < 1024; L += F.G) {
            const int rd = L >> 8, c = L & 255, bg = c & 31, a = c >> 5;
            const int qt = rd == 0 ? 31 - a : (rd == 1 ? 16 + a : (rd == 2 ? 15 - a : a));
#ifndef NO_P7
            attn_unit(F, bg >> 1, bg & 1, qt);
#endif
        }
        SEAM(7); }
    PH(8) { RELAUNDER(); p_rmsnorm(F, WSB(WS_Y), INP(19), INP(20)); SEAM(8); }
    PH(9) { RELAUNDER();
        pg8::Gemm g{WSB(WS_Y), WSB(WS_WMO), MTOK, DM, DM, DM}; pg8::StaticOrder S; S.init(MTOK, DM, F.G, F.bid); pg8::EpiResid E{WSB(WS_AB), WSB(WS_ACT), ALPHA, 1.0f};
#ifndef NO_P9
        pg8::gemm_phase<pg8::EpiResid, DM, DM>(F.lds, g, S, E, F.tid);
#endif
        SEAM(9); }
    PH(10) { RELAUNDER(); p_layernorm<false>(F, WSB(WS_ACT), INP(22), INP(23), WSB(WS_AB), nullptr); SEAM(10); }
    PH(11) { RELAUNDER();
        pg8::Gemm g{WSB(WS_AB), WSB(WS_W2A), MTOK, NFF2, DM, DM}; pg8::StaticOrder S; S.init(MTOK, NFF2, F.G, F.bid); pg8::EpiSwiGLU E{WSB(WS_ACT)};
#ifndef NO_P1
        pg8::gemm_phase<pg8::EpiSwiGLU, DM, DM>(F.lds, g, S, E, F.tid);
#endif
        SEAM(11); }
    PH(12) { RELAUNDER();
        pg8::Gemm g{WSB(WS_ACT), WSB(WS_W2B), MTOK, DM, DFF, DFF}; pg8::StaticOrder S; S.init(MTOK, DM, F.G, F.bid); pg8::EpiResid E{WSB(WS_AB), WSB(WS_Y), ALPHA, 0.5f};
#ifndef NO_P2
        pg8::gemm_phase<pg8::EpiResid, DFF, DFF>(F.lds, g, S, E, F.tid);
#endif
        SEAM(12); }
    PH(13) { RELAUNDER(); p_layernorm<true>(F, WSB(WS_Y), INP(26), INP(27), nullptr, F.out); }
}

extern "C" void kernel_launch(void* const* d_in, const int* in_sizes, int n_in, void* d_out, int out_size, void* d_ws, size_t ws_size, hipStream_t stream) {
    static int grid = 0;
    if (grid == 0) {
        if (n_in != 28 || out_size != MTOK * DM || ws_size < WS_END) { fprintf(stderr, "kernel_launch: unexpected shapes (n_in %d out %d ws %zu)\n", n_in, out_size, ws_size); grid = -1; return; }
        int dev = 0, cus = 0, per_cu = 0;
        (void)hipGetDevice(&dev); (void)hipDeviceGetAttribute(&cus, hipDeviceAttributeMultiprocessorCount, dev);
        if (hipFuncSetAttribute((const void*)hymba_fwd, hipFuncAttributeMaxDynamicSharedMemorySize, LDS_BYTES) != hipSuccess) { fprintf(stderr, "kernel_launch: hipFuncSetAttribute failed\n"); grid = -1; return; }
        if (hipOccupancyMaxActiveBlocksPerMultiprocessor(&per_cu, (const void*)hymba_fwd, NTHREADS, LDS_BYTES) != hipSuccess || per_cu < 1) { fprintf(stderr, "kernel_launch: occupancy query failed (%d)\n", per_cu); (void)hipGetLastError(); per_cu = 1; }
        if (per_cu > 1) per_cu = 1;
        grid = cus * per_cu;
        if (grid <= 0) { grid = -1; return; }
    }
    if (grid < 0) return;
    if (hipMemsetAsync((char*)d_ws + WS_CTL, 0, CTL_BYTES, stream) != hipSuccess) { fprintf(stderr, "kernel_launch: memset failed\n"); return; }
    Args a{};
    for (int i = 0; i < 28; ++i) a.in[i] = (const float*)d_in[i];
    a.out = (float*)d_out; a.ws = (unsigned char*)d_ws; a.ph_lo = 0; a.ph_hi = NPHASE;
    void* kargs[] = {&a};
    hipError_t e = hipLaunchCooperativeKernel((const void*)hymba_fwd, dim3(grid), dim3(NTHREADS), kargs, LDS_BYTES, stream);
    if (e != hipSuccess) fprintf(stderr, "kernel_launch: cooperative launch failed: %s (grid %d)\n", hipGetErrorString(e), grid);
}
```

```cpp
#include <hip/hip_runtime.h>
#include <hip/hip_cooperative_groups.h>
#include <cstdio>
#include <cstdint>
namespace cg = cooperative_groups;

#define LAS __attribute__((address_space(3)))
typedef unsigned short bf16_t;
typedef short bf16x8 __attribute__((ext_vector_type(8)));
typedef short s16x4 __attribute__((ext_vector_type(4)));
typedef float f32x4 __attribute__((ext_vector_type(4)));
typedef float f32x16 __attribute__((ext_vector_type(16)));
typedef unsigned u32x4 __attribute__((ext_vector_type(4)));
typedef unsigned u32x2 __attribute__((ext_vector_type(2)));
typedef float f32x2_t __attribute__((ext_vector_type(2)));
typedef __bf16 bf16x2_t __attribute__((ext_vector_type(2)));

constexpr int DM = 1024, NBATCH = 16, SEQ = 2048, MTOK = NBATCH * SEQ;
constexpr int DFF = 2816, NFF2 = 5632, INCOLS = 2328, NPROJ = 2560;
constexpr float ALPHA = 1.189207115002721f;
constexpr float LN_EPS = 1e-5f, RMS_EPS = 1e-6f;
constexpr float L2E = 1.4426950408889634f;

constexpr size_t MiB = 1u << 20;
constexpr size_t WS_W1A = 2 * MiB, WS_W1B = 14 * MiB, WS_WMI = 20 * MiB, WS_WMO = 26 * MiB, WS_W2A = 28 * MiB, WS_W2B = 40 * MiB;
constexpr size_t WS_WC1 = 46 * MiB;
constexpr size_t WS_ROPE = 48 * MiB;
constexpr size_t WS_CBIAS = 48 * MiB + 512 * 1024;
constexpr size_t WS_KC = 49 * MiB;
constexpr size_t WS_VCT = 49 * MiB + 512 * 1024;
constexpr size_t WS_HID = 50 * MiB;
constexpr size_t WS_KCV = 54 * MiB;
constexpr size_t WS_VT = 72 * MiB;
constexpr size_t WS_AB = 96 * MiB;
constexpr size_t WS_Y = 160 * MiB;
constexpr size_t WS_ACT = 224 * MiB;
constexpr size_t WS_END = 400 * MiB;

__device__ __forceinline__ unsigned pk2(float lo, float hi) { f32x2_t v = {lo, hi}; bf16x2_t b = __builtin_convertvector(v, bf16x2_t); return __builtin_bit_cast(unsigned, b); }
__device__ __forceinline__ float bflo(unsigned w) { return __uint_as_float(w << 16); }
__device__ __forceinline__ float bfhi(unsigned w) { return __uint_as_float(w & 0xffff0000u); }
__device__ __forceinline__ float bf2f(bf16_t h) { return __uint_as_float((unsigned)h << 16); }
__device__ __forceinline__ float fsigmoid(float x) { return __builtin_amdgcn_rcpf(1.0f + __builtin_amdgcn_exp2f(-x * L2E)); }
#define LDS_WAIT() asm volatile("s_waitcnt lgkmcnt(0)" ::: "memory")

namespace pg8 {
constexpr int BM = 256, BK = 64, HALF = 128, HTB = HALF * BK * 2, STAGE_BYTES = 8 * HTB, NXCD = 8, WGM = 8;
__host__ __device__ __forceinline__ int lds_byte(int r, int c) { const int st = (r >> 4) * 2 + (c >> 5), rr = r & 15, cc = c & 31, ob = rr * 64 + cc * 2; return st * 1024 + (ob ^ (((ob >> 9) & 1) << 5)); }
__host__ __device__ __forceinline__ void stage_rc(int b, int& R, int& C) { const int st = b / 1024, sb = b % 1024, swz = sb ^ (((sb >> 9) & 1) << 5); R = (st >> 1) * 16 + swz / 64; C = (st & 1) * 32 + (swz % 64) / 2; }
__host__ __device__ __forceinline__ int perm32(int rho) { const int n = rho >> 4, i = rho & 15; return 8 * (i >> 2) + 4 * n + (i & 3); }
struct Unit { int pm, pn; };
struct Gemm { const bf16_t* A; const bf16_t* Bt; int M, N, K, lda; };
struct StaticOrder {
    int nM, nN, nwg, G, c;
    __device__ void init(int M, int N, int G_, int c_) { nM = M / BM; nN = N / BM; nwg = nM * nN; G = G_; c = c_; }
    __device__ bool next(int i, Unit& u) const {
        const long L = (long)i * G + c; if (L >= nwg) return false;
        int wgid = (int)L; { const int q = nwg / NXCD, r = nwg % NXCD, xcd = wgid % NXCD, off = wgid / NXCD; wgid = (xcd < r ? xcd * (q + 1) : r * (q + 1) + (xcd - r) * q) + off; }
        const int nig = WGM * nN, gid = wgid / nig, fm = gid * WGM, gsz = (nM - fm) < WGM ? (nM - fm) : WGM;
        u.pm = fm + ((wgid % nig) % gsz); u.pn = (wgid % nig) / gsz; return true;
    }
};

template <class Epi, int K, int lda>
__device__ __forceinline__ void gemm_phase(LAS unsigned char* lds, const Gemm g, const StaticOrder& S, const Epi& E, const int tid) {
    const int wid = __builtin_amdgcn_readfirstlane(tid >> 6), lane = tid & 63, wr = wid >> 2, wc = wid & 3, fr = lane & 15, fq = lane >> 4;
    constexpr int nt = K / BK;
    unsigned voffA[2], voffB[2];
#pragma unroll
    for (int i = 0; i < 2; ++i) { int R, C; stage_rc(tid * 16 + i * 8192, R, C); const int Rb = Epi::PERM ? ((R & ~31) + perm32(R & 31)) : R;
        voffA[i] = (unsigned)(R * lda + C) * 2u; voffB[i] = (unsigned)(Rb * K + C) * 2u; }
    const size_t kstep = (size_t)(BK * 2);
    const size_t hstepA = (size_t)HALF * lda * 2, hstepB = (size_t)HALF * K * 2;
    const size_t tstepA = 2 * hstepA, tstepB = 2 * hstepB;
    const unsigned ldsw = (unsigned)wid * 1024u;
    const int aoff = lds_byte(wr * 64 + fr, fq * 8), boff = lds_byte(wc * 32 + fr, fq * 8);
#define PG8_SA(b, h) (((b) * 2 + (h)) * HTB)
#define PG8_SB(b, h) ((4 + (b) * 2 + (h)) * HTB)
#define PG8_STAGE(bufoff, gbase, voff) do { _Pragma("unroll") for (int _i = 0; _i < 2; ++_i) \
        __builtin_amdgcn_global_load_lds((const unsigned*)((const char*)(gbase) + (voff)[_i]), (LAS unsigned*)(lds + (bufoff) + ldsw + _i * 8192), 16, 0, 0); } while (0)
#define PG8_LDA(dst, b, h) do { _Pragma("unroll") for (int m = 0; m < 4; ++m) _Pragma("unroll") for (int k = 0; k < 2; ++k) dst[m][k] = *(const LAS bf16x8*)(lds + PG8_SA(b, h) + aoff + m * 2048 + k * 1024); } while (0)
#define PG8_LDB(dst, b, h) do { _Pragma("unroll") for (int n = 0; n < 2; ++n) _Pragma("unroll") for (int k = 0; k < 2; ++k) dst[n][k] = *(const LAS bf16x8*)(lds + PG8_SB(b, h) + boff + n * 2048 + k * 1024); } while (0)
#define PG8_MMA(ai, bj, At, Bt) do { __builtin_amdgcn_s_setprio(1); _Pragma("unroll") for (int m = 0; m < 4; ++m) _Pragma("unroll") for (int n = 0; n < 2; ++n) _Pragma("unroll") for (int k = 0; k < 2; ++k) \
        acc[ai][bj][m][n] = __builtin_amdgcn_mfma_f32_16x16x32_bf16(Bt[n][k], At[m][k], acc[ai][bj][m][n], 0, 0, 0); __builtin_amdgcn_s_setprio(0); } while (0)
#define PG8_WAIT_V(n) asm volatile("s_waitcnt vmcnt(" #n ")" ::: "memory")
#define PG8_WAIT_L(n) asm volatile("s_waitcnt lgkmcnt(" #n ")" ::: "memory")
#define PG8_BAR __builtin_amdgcn_s_barrier()
#define PG8_SCHED __builtin_amdgcn_sched_barrier(0)
    Unit cur, nxt; int ui = 0;
    if (!S.next(0, cur)) return;
    f32x4 acc[2][2][4][2];
#pragma unroll
    for (int a = 0; a < 2; ++a)
#pragma unroll
        for (int b = 0; b < 2; ++b)
#pragma unroll
            for (int m = 0; m < 4; ++m)
#pragma unroll
                for (int n = 0; n < 2; ++n) acc[a][b][m][n] = (f32x4){0.f, 0.f, 0.f, 0.f};
    bf16x8 At[4][2], B0[2][2], B1[2][2];
    const char* cA = (const char*)g.A + (size_t)cur.pm * tstepA; const char* cB = (const char*)g.Bt + (size_t)cur.pn * tstepB;
    PG8_STAGE(PG8_SB(0, 0), cB, voffB); PG8_STAGE(PG8_SB(0, 1), cB + hstepB, voffB); PG8_STAGE(PG8_SA(0, 0), cA, voffA); PG8_STAGE(PG8_SA(0, 1), cA + hstepA, voffA);
    if (wr == 1) PG8_BAR;
    PG8_WAIT_V(2); PG8_BAR;
    PG8_STAGE(PG8_SB(1, 0), cB + kstep, voffB); PG8_STAGE(PG8_SA(1, 0), cA + kstep, voffA); PG8_STAGE(PG8_SB(1, 1), cB + hstepB + kstep, voffB);
    PG8_WAIT_V(6); PG8_BAR;
    for (;;) {
        const bool has_next = S.next(ui + 1, nxt);
        const char* nA = has_next ? (const char*)g.A + (size_t)nxt.pm * tstepA : cA; const char* nB = has_next ? (const char*)g.Bt + (size_t)nxt.pn * tstepB : cB;
        for (int t = 0; t < nt; t += 2) {
            const bool last = (t == nt - 2);
            const char* a1 = cA + (size_t)(t + 1) * kstep;
            const char* a2 = last ? nA : cA + (size_t)(t + 2) * kstep; const char* b2 = last ? nB : cB + (size_t)(t + 2) * kstep;
            const char* a3 = a2 + kstep; const char* b3 = b2 + kstep;
            PG8_LDB(B0, 0, 0); PG8_LDB(B1, 0, 1); PG8_SCHED; PG8_LDA(At, 0, 0); PG8_STAGE(PG8_SA(1, 1), a1 + hstepA, voffA);
            PG8_WAIT_V(8); PG8_WAIT_L(0); PG8_BAR; PG8_MMA(0, 0, At, B0); PG8_MMA(0, 1, At, B1); PG8_BAR; PG8_SCHED;
            PG8_LDA(At, 0, 1); PG8_STAGE(PG8_SB(0, 0), b2, voffB); PG8_STAGE(PG8_SB(0, 1), b2 + hstepB, voffB); PG8_STAGE(PG8_SA(0, 0), a2, voffA);
            PG8_WAIT_V(8); PG8_WAIT_L(0); PG8_BAR; PG8_MMA(1, 0, At, B0); PG8_MMA(1, 1, At, B1); PG8_BAR; PG8_SCHED;
            PG8_LDB(B0, 1, 0); PG8_LDB(B1, 1, 1); PG8_SCHED; PG8_LDA(At, 1, 0); PG8_STAGE(PG8_SA(0, 1), a2 + hstepA, voffA);
            PG8_WAIT_V(8); PG8_WAIT_L(0); PG8_BAR; PG8_MMA(0, 0, At, B0); PG8_MMA(0, 1, At, B1); PG8_BAR; PG8_SCHED;
            PG8_LDA(At, 1, 1); PG8_STAGE(PG8_SB(1, 0), b3, voffB); PG8_STAGE(PG8_SB(1, 1), b3 + hstepB, voffB); PG8_STAGE(PG8_SA(1, 0), a3, voffA);
            PG8_WAIT_V(8); PG8_WAIT_L(0); PG8_BAR; PG8_MMA(1, 0, At, B0); PG8_MMA(1, 1, At, B1); PG8_BAR; PG8_SCHED;
        }
        if (wr == 0) PG8_BAR;
        E(acc, cur, wr, wc, fr, fq);
        if (!has_next) break;
#pragma unroll
        for (int a = 0; a < 2; ++a)
#pragma unroll
            for (int b = 0; b < 2; ++b)
#pragma unroll
                for (int m = 0; m < 4; ++m)
#pragma unroll
                    for (int n = 0; n < 2; ++n) acc[a][b][m][n] = (f32x4){0.f, 0.f, 0.f, 0.f};
        cur = nxt; cA = nA; cB = nB; ++ui;
        if (wr == 1) PG8_BAR;
    }
    PG8_WAIT_V(0);
    PG8_BAR;
#undef PG8_SA
#undef PG8_SB
#undef PG8_STAGE
#undef PG8_LDA
#undef PG8_LDB
#undef PG8_MMA
#undef PG8_WAIT_V
#undef PG8_WAIT_L
#undef PG8_BAR
#undef PG8_SCHED
}

struct EpiSwiGLU {
    static constexpr bool PERM = true;
    bf16_t* O;
    __device__ __forceinline__ void operator()(const f32x4 (&acc)[2][2][4][2], const Unit& u, int wr, int wc, int fr, int fq) const {
        const int col = u.pn * 128 + wc * 32 + 8 * fq;
#pragma unroll
        for (int ai = 0; ai < 2; ++ai)
#pragma unroll
            for (int m = 0; m < 4; ++m) {
                const int row = u.pm * BM + ai * HALF + wr * 64 + m * 16 + fr;
                float o[8];
#pragma unroll
                for (int n = 0; n < 2; ++n)
#pragma unroll
                    for (int e = 0; e < 4; ++e) { const float gv = acc[ai][0][m][n][e], uv = acc[ai][1][m][n][e]; o[4 * n + e] = gv * fsigmoid(gv) * uv; }
                u32x4 w; w.x = pk2(o[0], o[1]); w.y = pk2(o[2], o[3]); w.z = pk2(o[4], o[5]); w.w = pk2(o[6], o[7]);
                *(u32x4*)(O + (size_t)row * DFF + col) = w;
            }
    }
};
struct EpiResid {
    static constexpr bool PERM = true;
    const bf16_t* res; bf16_t* out; float alpha, scale;
    __device__ __forceinline__ void operator()(const f32x4 (&acc)[2][2][4][2], const Unit& u, int wr, int wc, int fr, int fq) const {
        const int col0 = u.pn * BM + wc * 32 + 8 * fq;
#pragma unroll
        for (int ai = 0; ai < 2; ++ai)
#pragma unroll
            for (int m = 0; m < 4; ++m) {
                const size_t off = (size_t)(u.pm * BM + ai * HALF + wr * 64 + m * 16 + fr) * DM + col0;
#pragma unroll
                for (int bj = 0; bj < 2; ++bj) {
                    const u32x4 rv = *(const u32x4*)(res + off + bj * HALF);
                    const f32x4 a0 = acc[ai][bj][m][0], a1 = acc[ai][bj][m][1];
                    u32x4 w;
                    w.x = pk2(alpha * bflo(rv.x) + scale * a0[0], alpha * bfhi(rv.x) + scale * a0[1]); w.y = pk2(alpha * bflo(rv.y) + scale * a0[2], alpha * bfhi(rv.y) + scale * a0[3]);
                    w.z = pk2(alpha * bflo(rv.z) + scale * a1[0], alpha * bfhi(rv.z) + scale * a1[1]); w.w = pk2(alpha * bflo(rv.w) + scale * a1[2], alpha * bfhi(rv.w) + scale * a1[3]);
                    *(u32x4*)(out + off + bj * HALF) = w;
                }
            }
    }
};
struct EpiProj {
    static constexpr bool PERM = true;
    bf16_t* PROJ; bf16_t* KCV; bf16_t* VT; const float* ROPE;
    __device__ __forceinline__ void operator()(const f32x4 (&acc)[2][2][4][2], const Unit& u, int wr, int wc, int fr, int fq) const {
        const int pn = u.pn, hc = 32 * wc + 8 * fq;
#pragma unroll
        for (int ai = 0; ai < 2; ++ai)
#pragma unroll
            for (int m = 0; m < 4; ++m) {
                const int row = u.pm * BM + ai * HALF + wr * 64 + m * 16 + fr, b = row >> 11, t = row & 2047;
#pragma unroll
                for (int bj = 0; bj < 2; ++bj) {
                    f32x4 v0 = acc[ai][bj][m][0], v1 = acc[ai][bj][m][1];
                    const bool isq = (pn == 4 || pn == 5);
                    const bool rope = isq || (pn >= 6 && pn <= 8 && bj == 0);
                    if (rope) {
                        const int i0 = (hc & 63) >> 1;
                        const f32x4* rp = (const f32x4*)(ROPE + ((size_t)t * 32 + i0) * 2);
                        const f32x4 c0 = rp[0], c1 = rp[1];
                        float a, bb;
                        a = v0[0] * c0[0] - v0[1] * c0[1]; bb = v0[1] * c0[0] + v0[0] * c0[1]; v0[0] = a; v0[1] = bb;
                        a = v0[2] * c0[2] - v0[3] * c0[3]; bb = v0[3] * c0[2] + v0[2] * c0[3]; v0[2] = a; v0[3] = bb;
                        a = v1[0] * c1[0] - v1[1] * c1[1]; bb = v1[1] * c1[0] + v1[0] * c1[1]; v1[0] = a; v1[1] = bb;
                        a = v1[2] * c1[2] - v1[3] * c1[3]; bb = v1[3] * c1[2] + v1[2] * c1[3]; v1[2] = a; v1[3] = bb;
                        if (isq) { v0 = v0 * (0.125f * L2E); v1 = v1 * (0.125f * L2E); }
                    }
                    u32x4 w; w.x = pk2(v0[0], v0[1]); w.y = pk2(v0[2], v0[3]); w.z = pk2(v1[0], v1[1]); w.w = pk2(v1[2], v1[3]);
                    if (pn == 6) {
                        const int gg = hc >> 6, d = hc & 63;
                        *(u32x4*)(KCV + (((size_t)(bj * 32 + b * 2 + gg)) * 2048 + t) * 64 + d) = w;
                    } else if ((pn == 7 || pn == 8) && bj == 1) {
                        const int gg = hc >> 6, d = hc & 63;
                        bf16_t* vp = VT + (((size_t)((pn - 7) * 32 + b * 2 + gg)) * 64 + d) * 2048 + t;
                        vp[0 * 2048] = (bf16_t)(w.x & 0xffffu); vp[1 * 2048] = (bf16_t)(w.x >> 16); vp[2 * 2048] = (bf16_t)(w.y & 0xffffu); vp[3 * 2048] = (bf16_t)(w.y >> 16);
                        vp[4 * 2048] = (bf16_t)(w.z & 0xffffu); vp[5 * 2048] = (bf16_t)(w.z >> 16); vp[6 * 2048] = (bf16_t)(w.w & 0xffffu); vp[7 * 2048] = (bf16_t)(w.w >> 16);
                    } else {
                        *(u32x4*)(PROJ + (size_t)row * NPROJ + 256 * pn + 128 * bj + hc) = w;
                    }
                    asm volatile("" ::: "memory");
                }
            }
    }
};
struct EpiCmp {
    static constexpr bool PERM = true;
    bf16_t* O; const float* bias;
    __device__ __forceinline__ void operator()(const f32x4 (&acc)[2][2][4][2], const Unit& u, int wr, int wc, int fr, int fq) const {
#pragma unroll
        for (int ai = 0; ai < 2; ++ai)
#pragma unroll
            for (int m = 0; m < 4; ++m) {
                const int row = u.pm * BM + ai * HALF + wr * 64 + m * 16 + fr;
#pragma unroll
                for (int bj = 0; bj < 2; ++bj) {
                    const int col = 128 * bj + 32 * wc + 8 * fq;
                    const f32x4 b0 = *(const f32x4*)(bias + col), b1 = *(const f32x4*)(bias + col + 4);
                    f32x4 v0 = acc[ai][bj][m][0] + b0, v1 = acc[ai][bj][m][1] + b1;
#pragma unroll
                    for (int e = 0; e < 4; ++e) { v0[e] = v0[e] * fsigmoid(v0[e]); v1[e] = v1[e] * fsigmoid(v1[e]); }
                    u32x4 w; w.x = pk2(v0[0], v0[1]); w.y = pk2(v0[2], v0[3]); w.z = pk2(v1[0], v1[1]); w.w = pk2(v1[2], v1[3]);
                    *(u32x4*)(O + (size_t)row * 256 + col) = w;
                }
                asm volatile("" ::: "memory");
            }
    }
};
}

constexpr int NWAVES = 8, NTHREADS = 512;
constexpr int LDS_BYTES = 131072 + 256;
constexpr size_t WS_CTL = 0, CTL_BYTES = 16384;
constexpr int NPHASE = 14;

struct Args { const float* in[28]; float* out; unsigned char* ws; int ph_lo, ph_hi; };

#define INP(k) ((const float*)F.kp[(k)])
struct Frame {
    LAS unsigned char* lds;
    int tid, lane, wave, G, bid;
    const __attribute__((address_space(4))) unsigned long long* kp;
    float* out; unsigned char* ws;
};

__device__ __forceinline__ float wave_sum(float v) {
#pragma unroll
    for (int o = 1; o < 64; o <<= 1) v += __shfl_xor(v, o);
    return v;
}
__device__ __forceinline__ int rope_d(int d) { return d < 32 ? 2 * d : 2 * (d - 32) + 1; }
__device__ __forceinline__ int map_swiglu(int n) { const int h = n >= DFF ? 1 : 0; const int c = n - h * DFF; return 256 * (c >> 7) + 128 * h + (c & 127); }
__device__ __forceinline__ int map_proj(int n) { const bool roped = (n >= 1024 && n < 1664) || (n >= 1792 && n < 1920) || (n >= 2048 && n < 2176); return roped ? ((n & ~63) + rope_d(n & 63)) : n; }

template <int MAP, bool KPERM>
__device__ __forceinline__ void tr_item(const float* W, int K, int N, bf16_t* WT, LAS float* scr, int item, int lane) {
    const int nblk = (N + 31) / 32, kb = item / nblk, nb = item % nblk, k0 = 64 * kb, n0 = 32 * nb;
    const int n4 = (lane & 7) * 4; const bool ok = (n0 + n4) < N;
    f32x4 ld[8];
#pragma unroll
    for (int i = 0; i < 8; ++i) { const int kk = 8 * i + (lane >> 3); ld[i] = ok ? *(const f32x4*)(W + (size_t)(k0 + kk) * N + n0 + n4) : (f32x4){0.f, 0.f, 0.f, 0.f}; }
#pragma unroll
    for (int i = 0; i < 8; ++i) { const int kk = 8 * i + (lane >> 3); LAS float* d = scr + kk * 33 + n4; d[0] = ld[i][0]; d[1] = ld[i][1]; d[2] = ld[i][2]; d[3] = ld[i][3]; }
    LDS_WAIT(); asm volatile("" ::: "memory");
    const int c = lane & 7;
#pragma unroll
    for (int j = 0; j < 4; ++j) {
        const int n = (lane >> 3) + 8 * j;
        if (n0 + n < N) {
            const LAS float* s = scr + n;
            float e[8];
#pragma unroll
            for (int q = 0; q < 8; ++q) { const int kk = KPERM ? ((q & 1) * 32 + 4 * c + (q >> 1)) : (8 * c + q); e[q] = s[kk * 33]; }
            const int dn = MAP == 1 ? map_swiglu(n0 + n) : (MAP == 2 ? map_proj(n0 + n) : (n0 + n));
            u32x4 o; o.x = pk2(e[0], e[1]); o.y = pk2(e[2], e[3]); o.z = pk2(e[4], e[5]); o.w = pk2(e[6], e[7]);
            *(u32x4*)(WT + (size_t)dn * K + k0 + 8 * c) = o;
        }
    }
    LDS_WAIT(); asm volatile("" ::: "memory");
}

__device__ __forceinline__ void p_prologue(Frame& F) {
    LAS float* scr = (LAS float*)(F.lds + F.wave * 16384);
    const int gw = F.bid * NWAVES + F.wave, NGW = F.G * NWAVES;
    bf16_t* W1A = (bf16_t*)(F.ws + WS_W1A); bf16_t* W1B = (bf16_t*)(F.ws + WS_W1B); bf16_t* WMI = (bf16_t*)(F.ws + WS_WMI); bf16_t* WMO = (bf16_t*)(F.ws + WS_WMO);
    bf16_t* W2A = (bf16_t*)(F.ws + WS_W2A); bf16_t* W2B = (bf16_t*)(F.ws + WS_W2B); bf16_t* WC1 = (bf16_t*)(F.ws + WS_WC1);
    constexpr int I_A = (DM / 64) * (NFF2 / 32), I_B = (DFF / 64) * (DM / 32), I_MI = (DM / 64) * ((INCOLS + 31) / 32), I_MO = (DM / 64) * (DM / 32), I_C = (2048 / 64) * (256 / 32);
    constexpr int NITEMS = 2 * I_A + 2 * I_B + I_MI + I_MO + 2 * I_C;
    for (int it = gw; it < NITEMS; it += NGW) {
        int r = it;
        if (r < I_A) { tr_item<1, false>(INP(1), DM, NFF2, W1A, scr, r, F.lane); continue; } r -= I_A;
        if (r < I_A) { tr_item<1, false>(INP(24), DM, NFF2, W2A, scr, r, F.lane); continue; } r -= I_A;
        if (r < I_B) { tr_item<0, false>(INP(2), DFF, DM, W1B, scr, r, F.lane); continue; } r -= I_B;
        if (r < I_B) { tr_item<0, false>(INP(25), DFF, DM, W2B, scr, r, F.lane); continue; } r -= I_B;
        if (r < I_MI) { tr_item<2, false>(INP(5), DM, INCOLS, WMI, scr, r, F.lane); continue; } r -= I_MI;
        if (r < I_MO) { tr_item<0, false>(INP(21), DM, DM, WMO, scr, r, F.lane); continue; } r -= I_MO;
        if (r < I_C) { tr_item<0, true>(INP(14), 2048, 256, WC1, scr, r, F.lane); continue; } r -= I_C;
        tr_item<0, false>(INP(17), 2048, 256, WC1 + (size_t)256 * 2048, scr, r, F.lane);
    }
    const int gt = F.bid * NTHREADS + F.tid, NGT = F.G * NTHREADS;
    { u32x4* z = (u32x4*)(WMI + (size_t)INCOLS * DM); const int nz = (NPROJ - INCOLS) * DM / 8;
      for (int i = gt; i < nz; i += NGT) z[i] = (u32x4){0u, 0u, 0u, 0u}; }
    { float* R = (float*)(F.ws + WS_ROPE);
      for (int i = gt; i < 2048 * 32; i += NGT) {
          const int t = i >> 5, k = i & 31;
          const float inv = __builtin_amdgcn_exp2f(-(float)k * 0.41524101186092029f);
          const float ang = (float)t * inv;
          const float kk = rintf(ang * 0.15915494309189535f);
          float rr = fmaf(-kk, 6.28318548202514648f, ang); rr = fmaf(-kk, -1.74845553e-7f, rr);
          const float fr = rr * 0.15915494309189535f;
          R[2 * i] = __builtin_amdgcn_cosf(fr); R[2 * i + 1] = __builtin_amdgcn_sinf(fr);
      } }
    { const float* x = INP(0); bf16_t* XB = (bf16_t*)(F.ws + WS_AB);
      for (int m = 2 * gw; m < MTOK; m += 2 * NGW) {
          const f32x4* xr = (const f32x4*)(x + (size_t)m * DM) + F.lane; u32x2* o = (u32x2*)(XB + (size_t)m * DM) + F.lane;
          f32x4 v[8];
#pragma unroll
          for (int j = 0; j < 8; ++j) v[j] = xr[64 * j];
#pragma unroll
          for (int j = 0; j < 8; ++j) o[64 * j] = (u32x2){pk2(v[j][0], v[j][1]), pk2(v[j][2], v[j][3])};
      } }
    if (F.bid < 64) {
        __syncthreads();
        const int wsel = F.bid >> 5, nb0 = (F.bid & 31) * 8;
        const float* pe = INP(wsel == 0 ? 13 : 16); const float* w1 = INP(wsel == 0 ? 14 : 17);
        float acc8[8];
#pragma unroll
        for (int e = 0; e < 8; ++e) acc8[e] = 0.f;
#pragma unroll
        for (int r4 = 0; r4 < 4; ++r4) {
            const int kk = F.tid * 4 + r4; const float pv = pe[kk];
            const f32x4 a = *(const f32x4*)(w1 + (size_t)kk * 256 + nb0), b = *(const f32x4*)(w1 + (size_t)kk * 256 + nb0 + 4);
            acc8[0] += pv * a[0]; acc8[1] += pv * a[1]; acc8[2] += pv * a[2]; acc8[3] += pv * a[3]; acc8[4] += pv * b[0]; acc8[5] += pv * b[1]; acc8[6] += pv * b[2]; acc8[7] += pv * b[3];
        }
        LAS float* red = (LAS float*)F.lds;
#pragma unroll
        for (int e = 0; e < 8; ++e) { const float sv = wave_sum(acc8[e]); if (F.lane == 0) red[F.wave * 8 + e] = sv; }
        __syncthreads();
        if (F.tid < 8) { float t = 0.f;
#pragma unroll
            for (int wv = 0; wv < 8; ++wv) t += red[wv * 8 + F.tid];
            ((float*)(F.ws + WS_CBIAS))[wsel * 256 + nb0 + F.tid] = t; }
        __syncthreads();
    }
}

template <bool OUT_F32>
__device__ __forceinline__ void p_layernorm(Frame& F, const bf16_t* Z, const float* g, const float* bta, bf16_t* OB, float* OF) {
    const int gw = F.bid * NWAVES + F.wave, NGW = F.G * NWAVES;
    float gv[16], bv[16];
#pragma unroll
    for (int e = 0; e < 16; ++e) { gv[e] = g[16 * F.lane + e]; bv[e] = bta[16 * F.lane + e]; }
    for (int m = 2 * gw; m < MTOK; m += 2 * NGW) {
        u32x4 raw[2][2];
#pragma unroll
        for (int rr = 0; rr < 2; ++rr) { const u32x4* zr = (const u32x4*)(Z + (size_t)(m + rr) * DM + 16 * F.lane); raw[rr][0] = zr[0]; raw[rr][1] = zr[1]; }
#pragma unroll
        for (int rr = 0; rr < 2; ++rr) {
            float v[16];
            const u32x4 a = raw[rr][0], b = raw[rr][1];
            v[0] = bflo(a.x); v[1] = bfhi(a.x); v[2] = bflo(a.y); v[3] = bfhi(a.y); v[4] = bflo(a.z); v[5] = bfhi(a.z); v[6] = bflo(a.w); v[7] = bfhi(a.w);
            v[8] = bflo(b.x); v[9] = bfhi(b.x); v[10] = bflo(b.y); v[11] = bfhi(b.y); v[12] = bflo(b.z); v[13] = bfhi(b.z); v[14] = bflo(b.w); v[15] = bfhi(b.w);
            float s = 0.f;
#pragma unroll
            for (int e = 0; e < 16; ++e) s += v[e];
            const float mean = wave_sum(s) * (1.f / DM); float s2 = 0.f;
#pragma unroll
            for (int e = 0; e < 16; ++e) { v[e] -= mean; s2 += v[e] * v[e]; }
            const float rstd = 1.f / sqrtf(wave_sum(s2) * (1.f / DM) + LN_EPS);
#pragma unroll
            for (int e = 0; e < 16; ++e) v[e] = v[e] * rstd * gv[e] + bv[e];
            if (OUT_F32) {
                f32x4* o = (f32x4*)(OF + (size_t)(m + rr) * DM + 16 * F.lane);
                o[0] = (f32x4){v[0], v[1], v[2], v[3]}; o[1] = (f32x4){v[4], v[5], v[6], v[7]}; o[2] = (f32x4){v[8], v[9], v[10], v[11]}; o[3] = (f32x4){v[12], v[13], v[14], v[15]};
            } else {
                u32x4* o = (u32x4*)(OB + (size_t)(m + rr) * DM + 16 * F.lane);
                u32x4 oa, ob; oa.x = pk2(v[0], v[1]); oa.y = pk2(v[2], v[3]); oa.z = pk2(v[4], v[5]); oa.w = pk2(v[6], v[7]);
                ob.x = pk2(v[8], v[9]); ob.y = pk2(v[10], v[11]); ob.z = pk2(v[12], v[13]); ob.w = pk2(v[14], v[15]);
                o[0] = oa; o[1] = ob;
            }
        }
    }
}

__device__ __forceinline__ void p_rmsnorm(Frame& F, bf16_t* Y, const float* gl, const float* gn) {
    const int gw = F.bid * NWAVES + F.wave, NGW = F.G * NWAVES;
    const float* gp = (F.lane < 32) ? (gl + 16 * F.lane) : (gn + 16 * (F.lane - 32));
    float gvv[16];
#pragma unroll
    for (int e = 0; e < 16; ++e) gvv[e] = gp[e];
    for (int m = gw; m < MTOK; m += NGW) {
        u32x4* yr = (u32x4*)(Y + (size_t)m * DM + 16 * F.lane);
        const u32x4 a = yr[0], b = yr[1];
        float v[16];
        v[0] = bflo(a.x); v[1] = bfhi(a.x); v[2] = bflo(a.y); v[3] = bfhi(a.y); v[4] = bflo(a.z); v[5] = bfhi(a.z); v[6] = bflo(a.w); v[7] = bfhi(a.w);
        v[8] = bflo(b.x); v[9] = bfhi(b.x); v[10] = bflo(b.y); v[11] = bfhi(b.y); v[12] = bflo(b.z); v[13] = bfhi(b.z); v[14] = bflo(b.w); v[15] = bfhi(b.w);
        float s = 0.f;
#pragma unroll
        for (int e = 0; e < 16; ++e) s += v[e] * v[e];
#pragma unroll
        for (int o = 1; o < 32; o <<= 1) s += __shfl_xor(s, o);
        const float r = 1.f / sqrtf(s * (1.f / 512.f) + RMS_EPS);
#pragma unroll
        for (int e = 0; e < 16; ++e) v[e] = v[e] * r * gvv[e];
        u32x4 oa, ob; oa.x = pk2(v[0], v[1]); oa.y = pk2(v[2], v[3]); oa.z = pk2(v[4], v[5]); oa.w = pk2(v[6], v[7]);
        ob.x = pk2(v[8], v[9]); ob.y = pk2(v[10], v[11]); ob.z = pk2(v[12], v[13]); ob.w = pk2(v[14], v[15]);
        yr[0] = oa; yr[1] = ob;
    }
}

__device__ __forceinline__ void cmp_second(Frame& F, int which, int pm) {
    const int lane = F.lane, quad = lane >> 4, l16 = lane & 15;
    const float* w2 = INP(which == 0 ? 15 : 18);
    LAS bf16_t* WT = (LAS bf16_t*)F.lds;
    for (int idx = F.tid; idx < 256 * 64; idx += NTHREADS) { const int k = idx >> 6, d = idx & 63; WT[d * 264 + k] = (bf16_t)(pk2(w2[idx], 0.f) & 0xffffu); }
    __builtin_amdgcn_fence(__ATOMIC_RELEASE, "agent");
    __syncthreads();
    __builtin_amdgcn_fence(__ATOMIC_ACQUIRE, "agent");
    const bf16_t* HID = (const bf16_t*)(F.ws + WS_HID) + ((size_t)which * 4096 + 256 * pm) * 256;
    bf16_t* KC = (bf16_t*)(F.ws + WS_KC); bf16_t* VCT = (bf16_t*)(F.ws + WS_VCT);
#pragma unroll 1
    for (int mi = 0; mi < 2; ++mi) {
        const int r0 = (2 * F.wave + mi) * 16;
        bf16x8 af[8];
#pragma unroll
        for (int ks = 0; ks < 8; ++ks) af[ks] = *(const bf16x8*)(HID + (size_t)(r0 + l16) * 256 + ks * 32 + quad * 8);
#pragma unroll
        for (int nt = 0; nt < 4; ++nt) {
            f32x4 c = {0.f, 0.f, 0.f, 0.f};
#pragma unroll
            for (int ks = 0; ks < 8; ++ks) { const bf16x8 bfr = *(const LAS bf16x8*)(WT + (nt * 16 + l16) * 264 + ks * 32 + quad * 8); c = __builtin_amdgcn_mfma_f32_16x16x32_bf16(af[ks], bfr, c, 0, 0, 0); }
#pragma unroll
            for (int j = 0; j < 4; ++j) {
                const int row = 256 * pm + r0 + quad * 4 + j, d = nt * 16 + l16;
                const bf16_t hb = (bf16_t)(pk2(c[j], 0.f) & 0xffffu);
                if (which == 0) KC[(size_t)row * 64 + rope_d(d)] = hb;
                else VCT[((size_t)(row >> 7) * 64 + d) * 128 + (row & 127)] = hb;
            }
        }
    }
    __syncthreads();
}

constexpr int LR2_XC = 0, LR2_XCW = 9216, LR2_SUM = 8 * 9216;
__device__ __forceinline__ void lru_unit(Frame& F, int u) {
    const int b = u >> 4, h = (u >> 1) & 7, jh = u & 1;
    const int lane = F.lane, w = F.wave, quad = lane >> 4, l16 = lane & 15, ca0 = 8 * (lane & 7), tg = lane >> 3;
    const bf16_t* PROJ = (const bf16_t*)(F.ws + WS_ACT); bf16_t* Y = (bf16_t*)(F.ws + WS_Y);
    LAS unsigned char* xc = F.lds + LR2_XC + w * LR2_XCW;
    LAS float* SUM = (LAS float*)(F.lds + LR2_SUM);
    bf16x8 wf[2][2][2];
#pragma unroll
    for (int gsel = 0; gsel < 2; ++gsel)
#pragma unroll
        for (int nt = 0; nt < 2; ++nt)
#pragma unroll
            for (int sk = 0; sk < 2; ++sk) {
                const float* wsrc = INP(gsel == 0 ? 8 : 10) + ((size_t)(h * 64 + sk * 32 + quad * 8)) * 64 + 32 * jh + nt * 16 + l16;
                u32x4 pw; pw.x = pk2(wsrc[0], wsrc[64]); pw.y = pk2(wsrc[128], wsrc[192]); pw.z = pk2(wsrc[256], wsrc[320]); pw.w = pk2(wsrc[384], wsrc[448]);
                wf[gsel][nt][sk] = __builtin_bit_cast(bf16x8, pw);
            }
    float ba[2], bx[2], c8[2];
#pragma unroll
    for (int nt = 0; nt < 2; ++nt) { const int c = 64 * h + 32 * jh + nt * 16 + l16; ba[nt] = INP(9)[c]; bx[nt] = INP(11)[c]; c8[nt] = 8.0f * log1pf(expf(-INP(12)[c])); }
    float cw[4][8], cb[8];
#pragma unroll
    for (int e = 0; e < 8; ++e) { cb[e] = INP(7)[64 * h + ca0 + e];
#pragma unroll
        for (int jt = 0; jt < 4; ++jt) cw[jt][e] = INP(6)[jt * 512 + 64 * h + ca0 + e]; }
    float hin[2] = {0.f, 0.f};
#pragma unroll 1
    for (int pass = 0; pass < 2; ++pass) {
        float hc[2] = {hin[0], hin[1]}, pc[2] = {1.f, 1.f};
#pragma unroll 1
        for (int sub = 0; sub < 4; ++sub) {
            const int t0 = 256 * w + 64 * sub;
            {
                u32x4 raw[11];
#pragma unroll
                for (int k = 0; k < 11; ++k) { const int ts = t0 + 8 * tg - 3 + k; raw[k] = (ts >= 0) ? *(const u32x4*)(PROJ + ((size_t)(b * 2048 + ts)) * NPROJ + 64 * h + ca0) : (u32x4){0u, 0u, 0u, 0u}; }
#pragma unroll
                for (int i = 0; i < 8; ++i) {
                    float a[8];
#pragma unroll
                    for (int e = 0; e < 8; ++e) a[e] = cb[e];
#pragma unroll
                    for (int jt = 0; jt < 4; ++jt) { const u32x4 rw = raw[i + jt];
                        a[0] += cw[jt][0] * bflo(rw.x); a[1] += cw[jt][1] * bfhi(rw.x); a[2] += cw[jt][2] * bflo(rw.y); a[3] += cw[jt][3] * bfhi(rw.y);
                        a[4] += cw[jt][4] * bflo(rw.z); a[5] += cw[jt][5] * bfhi(rw.z); a[6] += cw[jt][6] * bflo(rw.w); a[7] += cw[jt][7] * bfhi(rw.w); }
                    u32x4 pw; pw.x = pk2(a[0], a[1]); pw.y = pk2(a[2], a[3]); pw.z = pk2(a[4], a[5]); pw.w = pk2(a[6], a[7]);
                    *(LAS u32x4*)(xc + (8 * tg + i) * 144 + ca0 * 2) = pw;
                }
            }
#pragma unroll 1
            for (int mt = 0; mt < 4; ++mt) {
                const bf16x8 af0 = *(const LAS bf16x8*)(xc + (16 * mt + l16) * 144 + (quad * 8) * 2), af1 = *(const LAS bf16x8*)(xc + (16 * mt + l16) * 144 + (32 + quad * 8) * 2);
                const int trow = t0 + 16 * mt + quad * 4;
                float gt[2][4];
                if (pass == 1) {
#pragma unroll
                    for (int nt = 0; nt < 2; ++nt)
#pragma unroll
                        for (int j = 0; j < 4; ++j) gt[nt][j] = bf2f(PROJ[((size_t)(b * 2048 + trow + j)) * NPROJ + 512 + 64 * h + 32 * jh + nt * 16 + l16]);
                }
                f32x4 acc[2][2];
#pragma unroll
                for (int gsel = 0; gsel < 2; ++gsel)
#pragma unroll
                    for (int nt = 0; nt < 2; ++nt) { f32x4 c = {0.f, 0.f, 0.f, 0.f}; c = __builtin_amdgcn_mfma_f32_16x16x32_bf16(af0, wf[gsel][nt][0], c, 0, 0, 0); c = __builtin_amdgcn_mfma_f32_16x16x32_bf16(af1, wf[gsel][nt][1], c, 0, 0, 0); acc[gsel][nt] = c; }
#pragma unroll
                for (int nt = 0; nt < 2; ++nt) {
                    float av[4], uv[4];
#pragma unroll
                    for (int j = 0; j < 4; ++j) {
                        const float xcv = bf2f(*(const LAS bf16_t*)(xc + (16 * mt + quad * 4 + j) * 144 + (32 * jh + nt * 16 + l16) * 2));
                        const float r = fsigmoid(acc[0][nt][j] + ba[nt]), ig = fsigmoid(acc[1][nt][j] + bx[nt]);
                        const float la = -c8[nt] * r, x2 = 2.0f * la;
                        av[j] = __builtin_amdgcn_exp2f(la * L2E);
                        const float em = (x2 > -0.3f) ? x2 * (1.0f + x2 * (0.5f + x2 * (0.16666667f + x2 * (0.041666668f + x2 * (0.0083333338f + x2 * 0.0013888889f)))))
                                                      : (__builtin_amdgcn_exp2f(x2 * L2E) - 1.0f);
                        const float mult = (trow + j == 0) ? 1.0f : __builtin_amdgcn_sqrtf(-em);
                        uv[j] = mult * ig * xcv;
                    }
                    float P = av[0], H = uv[0];
#pragma unroll
                    for (int j = 1; j < 4; ++j) { H = av[j] * H + uv[j]; P *= av[j]; }
                    float Pp = __shfl_up(P, 16), Hp = __shfl_up(H, 16);
                    if (quad >= 1) { H = P * Hp + H; P = Pp * P; }
                    Pp = __shfl_up(P, 32); Hp = __shfl_up(H, 32);
                    if (quad >= 2) { H = P * Hp + H; P = Pp * P; }
                    const float Pt = __shfl(P, 48 + l16), Ht = __shfl(H, 48 + l16);
                    if (pass == 1) {
                        float Pe = __shfl_up(P, 16), He = __shfl_up(H, 16);
                        if (quad == 0) { Pe = 1.0f; He = 0.0f; }
                        float hq = Pe * hc[nt] + He;
#pragma unroll
                        for (int j = 0; j < 4; ++j) {
                            hq = av[j] * hq + uv[j];
                            const float x = gt[nt][j], z = 0.7978845608028654f * (x + 0.044715f * x * x * x);
                            const float th = 1.0f - 2.0f * __builtin_amdgcn_rcpf(1.0f + __builtin_amdgcn_exp2f(2.0f * z * L2E));
                            const float yv = hq * (0.5f * x * (1.0f + th));
                            Y[((size_t)(b * 2048 + trow + j)) * DM + 64 * h + 32 * jh + nt * 16 + l16] = (bf16_t)(pk2(yv, 0.f) & 0xffffu);
                        }
                    }
                    hc[nt] = Pt * hc[nt] + Ht; pc[nt] *= Pt;
                }
            }
        }
        if (pass == 0) {
            if (quad == 0) {
#pragma unroll
                for (int nt = 0; nt < 2; ++nt) { SUM[(w * 32 + nt * 16 + l16) * 2] = pc[nt]; SUM[(w * 32 + nt * 16 + l16) * 2 + 1] = hc[nt]; }
            }
            __syncthreads();
            for (int w2 = 0; w2 < w; ++w2) {
#pragma unroll
                for (int nt = 0; nt < 2; ++nt) hin[nt] = SUM[(w2 * 32 + nt * 16 + l16) * 2] * hin[nt] + SUM[(w2 * 32 + nt * 16 + l16) * 2 + 1];
            }
        }
    }
    __syncthreads();
}

constexpr int AT_KC = 0, AT_VC = 18432, AT_K = 35328, AT_V = 44544, AT_IMPP = 53248, AT_IMP = 87040, AT_SEL = 95488;
__device__ __forceinline__ int crow(int r, int hi) { return (r & 3) + 8 * (r >> 2) + 4 * hi; }
#define MFMA32(a, b, c) __builtin_amdgcn_mfma_f32_32x32x16_bf16((a), (b), (c), 0, 0, 0)
__device__ __forceinline__ f32x16 qk_tile(const LAS unsigned char* Kl, int krow0, const bf16x8 (&qf)[4], int i, int hi) {
    f32x16 p;
#pragma unroll
    for (int r = 0; r < 16; ++r) p[r] = 0.f;
    const LAS unsigned char* kp = Kl + (krow0 + i) * 144 + hi * 16;
#pragma unroll
    for (int d0 = 0; d0 < 4; ++d0) { const bf16x8 a = *(const LAS bf16x8*)(kp + d0 * 32); p = MFMA32(a, qf[d0], p); }
    return p;
}
__device__ __forceinline__ bf16x8 pack8(const f32x16& p, int s) {
    u32x4 w; w.x = pk2(p[8 * s], p[8 * s + 1]); w.y = pk2(p[8 * s + 2], p[8 * s + 3]); w.z = pk2(p[8 * s + 4], p[8 * s + 5]); w.w = pk2(p[8 * s + 6], p[8 * s + 7]);
    return __builtin_bit_cast(bf16x8, w);
}
__device__ __forceinline__ void pv_step(f32x16 (&o)[2], const LAS unsigned char* Vl, int VS, int kbase, bf16x8 pb, int i, int hi) {
#pragma unroll
    for (int d0t = 0; d0t < 2; ++d0t) {
        const LAS unsigned char* vp = Vl + (32 * d0t + i) * VS + (kbase + 4 * hi) * 2;
        const s16x4 lo = *(const LAS s16x4*)vp, hi4 = *(const LAS s16x4*)(vp + 16);
        const bf16x8 a = __builtin_shufflevector(lo, hi4, 0, 1, 2, 3, 4, 5, 6, 7);
        o[d0t] = MFMA32(a, pb, o[d0t]);
    }
}
template <int MODE>
__device__ __forceinline__ void attn_branch(const bf16_t* Kg, const bf16_t* VTg, int kt_lo, int kt_hi, unsigned selw, unsigned unionmask, int tq,
                                            const bf16x8 (&qf)[4], LAS unsigned char* lds, int tid, int i, int hi, float gate, f32x16 (&tot)[2]) {
    f32x16 o[2];
#pragma unroll
    for (int r = 0; r < 16; ++r) { o[0][r] = 0.f; o[1][r] = 0.f; }
    float m = -INFINITY, l = 0.f;
    const int ldrow = tid >> 3, ldch = tid & 7;
    const bf16_t* kgp = Kg + (size_t)ldrow * NPROJ + ldch * 8;
    const bf16_t* vgp = VTg + (size_t)ldrow * 2048 + ldch * 8;
    unsigned todo = (MODE == 1) ? (unionmask & (kt_hi >= 31 ? 0xffffffffu : ((2u << kt_hi) - 1u))) : (((kt_hi >= 31) ? 0xffffffffu : ((2u << kt_hi) - 1u)) & ~((1u << kt_lo) - 1u));
    u32x4 kv = {0u, 0u, 0u, 0u}, vv = {0u, 0u, 0u, 0u};
    if (todo) { const int k0 = __builtin_ctz(todo); kv = *(const u32x4*)(kgp + (size_t)k0 * 64 * NPROJ); vv = *(const u32x4*)(vgp + k0 * 64); }
    while (todo) {
        const int kt = __builtin_ctz(todo); todo &= todo - 1u;
        {
            *(LAS u32x4*)(lds + AT_K + ldrow * 144 + ldch * 16) = kv;
            LAS u32x2* vd = (LAS u32x2*)(lds + AT_V + ldrow * 136 + ldch * 16); vd[0] = (u32x2){vv.x, vv.y}; vd[1] = (u32x2){vv.z, vv.w};
        }
        __syncthreads();
        if (todo) { const int kn = __builtin_ctz(todo); kv = *(const u32x4*)(kgp + (size_t)kn * 64 * NPROJ); vv = *(const u32x4*)(vgp + kn * 64); }
        f32x16 p0 = qk_tile(lds + AT_K, 0, qf, i, hi), p1 = qk_tile(lds + AT_K, 32, qf, i, hi);
        const bool selbit = (MODE == 1) ? (((selw >> kt) & 1u) != 0u) : true;
        const bool edge = (MODE == 1) ? (kt == kt_hi) : (kt == kt_hi || kt + 8 == kt_hi);
        if (edge) {
            const int rel = tq - kt * 64 - 4 * hi;
#pragma unroll
            for (int r = 0; r < 16; ++r) {
                const int cr0 = (r & 3) + 8 * (r >> 2), cr1 = cr0 + 32;
                const bool v0 = cr0 <= rel && (MODE == 1 || cr0 >= rel - 511);
                const bool v1 = cr1 <= rel && (MODE == 1 || cr1 >= rel - 511);
                p0[r] = v0 ? p0[r] : -INFINITY; p1[r] = v1 ? p1[r] : -INFINITY;
            }
        }
        float mx = -INFINITY;
#pragma unroll
        for (int r = 0; r < 16; ++r) mx = fmaxf(mx, fmaxf(p0[r], p1[r]));
        if (MODE == 1 && !selbit) mx = -INFINITY;
        mx = fmaxf(mx, __shfl_xor(mx, 32));
        if (__any(mx > m + 8.0f)) {
            const float mnew = (mx > m + 8.0f) ? mx : m;
            const float alpha = (mnew == m) ? 1.0f : __builtin_amdgcn_exp2f(m - mnew);
#pragma unroll
            for (int r = 0; r < 16; ++r) { o[0][r] *= alpha; o[1][r] *= alpha; }
            l *= alpha; m = mnew;
        }
        const float moff = (MODE == 1 && !selbit) ? INFINITY : ((m == -INFINITY) ? 0.f : m);
        float ls = 0.f;
#pragma unroll
        for (int r = 0; r < 16; ++r) { p0[r] = __builtin_amdgcn_exp2f(p0[r] - moff); p1[r] = __builtin_amdgcn_exp2f(p1[r] - moff); ls += p0[r] + p1[r]; }
        l += ls;
        pv_step(o, lds + AT_V, 136, 0, pack8(p0, 0), i, hi);
        pv_step(o, lds + AT_V, 136, 16, pack8(p0, 1), i, hi);
        pv_step(o, lds + AT_V, 136, 32, pack8(p1, 0), i, hi);
        pv_step(o, lds + AT_V, 136, 48, pack8(p1, 1), i, hi);
        __syncthreads();
    }
    l += __shfl_xor(l, 32);
    const float sc = gate / l;
#pragma unroll
    for (int r = 0; r < 16; ++r) { tot[0][r] += o[0][r] * sc; tot[1][r] += o[1][r] * sc; }
}

__device__ __forceinline__ void attn_unit(Frame& F, int b, int g, int qt) {
    const int tid = F.tid, lane = F.lane, w = F.wave, i = lane & 31, hi = lane >> 5, r = w >> 1;
    const int bg = b * 2 + g, t0 = qt * 64, tl = 32 * (w & 1) + i, tq = t0 + tl;
    const size_t row = (size_t)b * 2048 + tq;
    LAS unsigned char* lds = F.lds;
    const bf16_t* PROJ = (const bf16_t*)(F.ws + WS_ACT); bf16_t* Y = (bf16_t*)(F.ws + WS_Y);
    const bf16_t* KC = (const bf16_t*)(F.ws + WS_KC); const bf16_t* VCT = (const bf16_t*)(F.ws + WS_VCT); const bf16_t* VT = (const bf16_t*)(F.ws + WS_VT);
    bf16x8 qf[4];
    { const bf16_t* qp = PROJ + row * NPROJ + 1024 + 64 * (4 * g + r) + 8 * hi;
#pragma unroll
      for (int d0 = 0; d0 < 4; ++d0) qf[d0] = *(const bf16x8*)(qp + 16 * d0); }
    float g0, g1, g2;
    { const bf16_t* gp = PROJ + row * NPROJ + 2304 + (4 * g + r) * 3; g0 = fsigmoid(bf2f(gp[0])); g1 = fsigmoid(bf2f(gp[1])); g2 = fsigmoid(bf2f(gp[2])); }
#pragma unroll
    for (int c2 = 0; c2 < 2; ++c2) {
        const int idx = tid + NTHREADS * c2;
        { const int rk = idx >> 3, ch = idx & 7; const u32x4 v = *(const u32x4*)(KC + ((size_t)bg * 128 + rk) * 64 + ch * 8); *(LAS u32x4*)(lds + AT_KC + rk * 144 + ch * 16) = v; }
        { const int rd = idx >> 4, ch = idx & 15; const u32x4 v = *(const u32x4*)(VCT + ((size_t)bg * 64 + rd) * 128 + ch * 8);
          LAS u32x2* vd = (LAS u32x2*)(lds + AT_VC + rd * 264 + ch * 16); vd[0] = (u32x2){v.x, v.y}; vd[1] = (u32x2){v.z, v.w}; }
    }
    __syncthreads();
    f32x16 tot[2];
    {
        f32x16 p[4];
#pragma unroll
        for (int kt = 0; kt < 4; ++kt) p[kt] = qk_tile(lds + AT_KC, 32 * kt, qf, i, hi);
        const int nv = tq >= 31 ? (((tq - 31) >> 4) + 1) : 0;
        const int nvl = nv - 4 * hi;
        float mx = -INFINITY;
#pragma unroll
        for (int kt = 0; kt < 4; ++kt)
#pragma unroll
            for (int rr = 0; rr < 16; ++rr) { const int nc = 32 * kt + (rr & 3) + 8 * (rr >> 2); p[kt][rr] = (nc < nvl) ? p[kt][rr] : -INFINITY; mx = fmaxf(mx, p[kt][rr]); }
        mx = fmaxf(mx, __shfl_xor(mx, 32));
        const float msafe = (mx == -INFINITY) ? 0.f : mx;
        float ls = 0.f;
#pragma unroll
        for (int kt = 0; kt < 4; ++kt)
#pragma unroll
            for (int rr = 0; rr < 16; ++rr) { p[kt][rr] = __builtin_amdgcn_exp2f(p[kt][rr] - msafe); ls += p[kt][rr]; }
        ls += __shfl_xor(ls, 32);
        const float inv = ls > 0.f ? 1.0f / ls : 0.f;
#pragma unroll
        for (int kt = 0; kt < 4; ++kt)
#pragma unroll
            for (int rr = 0; rr < 16; ++rr) p[kt][rr] *= inv;
        float Qs[16], rl[16];
#pragma unroll
        for (int q4 = 0; q4 < 16; ++q4) {
            const int kt = q4 >> 2, g4 = q4 & 3;
            Qs[q4] = (p[kt][4 * g4] + p[kt][4 * g4 + 1]) + (p[kt][4 * g4 + 2] + p[kt][4 * g4 + 3]);
            rl[q4] = __shfl_xor(p[kt][4 * g4 + 3], 32);
        }
        LAS float* impp = (LAS float*)(lds + AT_IMPP) + (r * 64 + tl) * 33;
#pragma unroll
        for (int q4 = 0; q4 < 16; ++q4) {
            const float ex = hi ? rl[q4] : (q4 > 0 ? rl[q4 > 0 ? q4 - 1 : 0] : 0.f);
            impp[8 * (q4 >> 2) + 2 * (q4 & 3) + hi] = Qs[q4] + ex;
        }
        f32x16 o[2];
#pragma unroll
        for (int rr = 0; rr < 16; ++rr) { o[0][rr] = 0.f; o[1][rr] = 0.f; }
#pragma unroll
        for (int kt = 0; kt < 4; ++kt)
#pragma unroll
            for (int s = 0; s < 2; ++s) pv_step(o, lds + AT_VC, 264, 32 * kt + 16 * s, pack8(p[kt], s), i, hi);
#pragma unroll
        for (int rr = 0; rr < 16; ++rr) { tot[0][rr] = o[0][rr] * g0; tot[1][rr] = o[1][rr] * g0; }
    }
    __syncthreads();
    {
        LAS float* IMPP = (LAS float*)(lds + AT_IMPP); LAS float* IMP = (LAS float*)(lds + AT_IMP); LAS unsigned* SEL = (LAS unsigned*)(lds + AT_SEL);
#pragma unroll
        for (int it = 0; it < 4; ++it) {
            const int idx = tid + NTHREADS * it, tt = idx >> 5, j = idx & 31;
            IMP[tt * 33 + j] = ((IMPP[(0 * 64 + tt) * 33 + j] + IMPP[(1 * 64 + tt) * 33 + j]) + IMPP[(2 * 64 + tt) * 33 + j]) + IMPP[(3 * 64 + tt) * 33 + j];
        }
        __syncthreads();
#pragma unroll 1
        for (int it = 0; it < 4; ++it) {
            const int idx = tid + NTHREADS * it, tt = idx >> 5, j = idx & 31;
            const float v = IMP[tt * 33 + j];
            int cnt = 0;
#pragma unroll 2
            for (int j2 = 1; j2 <= qt - 2; ++j2) { const float v2 = IMP[tt * 33 + j2]; cnt += ((v2 > v) || (v2 == v && j2 < j)) ? 1 : 0; }
            const bool forced = (j == 0) || (j == qt) || (j == qt - 1);
            const bool sel = (j <= qt) && (forced || (j >= 1 && j <= qt - 2 && cnt < 13));
            const unsigned long long bal = __ballot(sel);
            if ((lane & 31) == 0) SEL[tt] = (lane < 32) ? (unsigned)bal : (unsigned)(bal >> 32);
        }
        __syncthreads();
    }
    unsigned selw, unionmask;
    { LAS unsigned* SEL = (LAS unsigned*)(lds + AT_SEL); selw = SEL[tl]; unsigned uu = SEL[lane];
#pragma unroll
      for (int o = 1; o < 64; o <<= 1) uu |= __shfl_xor(uu, o);
      unionmask = uu; }
    unionmask = __builtin_amdgcn_readfirstlane(unionmask);
    attn_branch<0>(PROJ + (size_t)b * 2048 * NPROJ + 2048 + 64 * g, VT + ((size_t)(32 + bg) * 64) * 2048, qt - 8 > 0 ? qt - 8 : 0, qt, 0u, 0u, tq, qf, lds, tid, i, hi, g2, tot);
    attn_branch<1>(PROJ + (size_t)b * 2048 * NPROJ + 1792 + 64 * g, VT + ((size_t)bg * 64) * 2048, 0, qt, selw, unionmask, tq, qf, lds, tid, i, hi, g1, tot);
    bf16_t* yp = Y + row * DM + 512 + 64 * (4 * g + r);
#pragma unroll
    for (int d0t = 0; d0t < 2; ++d0t)
#pragma unroll
        for (int g4 = 0; g4 < 4; ++g4) {
            const int d = 32 * d0t + 8 * g4 + 4 * hi;
            *(u32x2*)(yp + d) = (u32x2){pk2(tot[d0t][4 * g4], tot[d0t][4 * g4 + 1]), pk2(tot[d0t][4 * g4 + 2], tot[d0t][4 * g4 + 3])};
        }
}


#define XB_TMO      128
#define XB_XCNT(j)  (256  + 64 * (j))
#define XB_XSUB(j)  (1280 + 64 * (j))
#define XB_XGEN(j)  (2304 + 64 * (j))
#define XB_TOP      3328
#define XB_TOPGEN   3392
#define XCD_BAR_WORDS 3456
#define XB_SPIN_CAP (1u << 20)
__device__ __forceinline__ unsigned xb_ld(unsigned* p)              { return __hip_atomic_load(p, __ATOMIC_RELAXED, __HIP_MEMORY_SCOPE_AGENT); }
__device__ __forceinline__ unsigned xb_add(unsigned* p, unsigned v) { return __hip_atomic_fetch_add(p, v, __ATOMIC_RELAXED, __HIP_MEMORY_SCOPE_AGENT); }
__device__ __forceinline__ unsigned xb_xcc_id() { return (unsigned)__builtin_amdgcn_s_getreg((3 << 11) | 20) & 0xFu; }
#define XB_SPIN(cond, bar) do { unsigned _sp = 0; while (cond) { __builtin_amdgcn_s_sleep(1); \
    if ((++_sp & 255u) == 0u) { if (xb_ld(&(bar)[XB_TMO])) break; if (_sp > XB_SPIN_CAP) { atomicAdd(&(bar)[XB_TMO], 1u); break; } } } } while (0)
struct XcdBarrier { unsigned* bar; unsigned x; volatile LAS unsigned* st; };
__device__ __forceinline__ XcdBarrier xcd_barrier_post(unsigned* bar, volatile LAS unsigned* st) {
    XcdBarrier b; b.bar = bar; b.x = xb_xcc_id(); b.st = st;
    if (threadIdx.x == 0) (void)xb_add(&bar[XB_XCNT(b.x)], 1u);
    return b;
}
__device__ __forceinline__ void xcd_barrier_complete(unsigned* bar, unsigned x, unsigned& nloc, unsigned& nx) {
    const unsigned G = gridDim.x * gridDim.y * gridDim.z;
    unsigned sum, cnt, mine, sp = 0u;
    for (;;) {
        sum = 0u; cnt = 0u; mine = 0u;
#pragma unroll
        for (unsigned j = 0; j < 16; ++j) { const unsigned c = xb_ld(&bar[XB_XCNT(j)]); sum += c; cnt += (c > 0u) ? 1u : 0u; mine = (j == x) ? c : mine; }
        if (sum == G) break;
        __builtin_amdgcn_s_sleep(1);
        if ((++sp & 255u) == 0u) { if (xb_ld(&bar[XB_TMO])) break; if (sp > XB_SPIN_CAP) { atomicAdd(&bar[XB_TMO], 1u); break; } }
    }
    nloc = mine > 0u ? mine : 1u; nx = cnt > 0u ? cnt : 1u;
}
__device__ __forceinline__ void xcd_barrier(const XcdBarrier& b) {
    asm volatile("s_waitcnt vmcnt(0)" ::: "memory");
    __syncthreads();
    if (threadIdx.x == 0) {
        unsigned* bar = b.bar;
        __builtin_amdgcn_s_waitcnt(0);
        unsigned nloc = b.st[0], nx = b.st[1];
        if (nloc == 0u) { xcd_barrier_complete(bar, b.x, nloc, nx); b.st[0] = nloc; b.st[1] = nx; }
        const unsigned old = xb_add(&bar[XB_XSUB(b.x)], 1u);
        const unsigned gen = old / nloc;
        if (old + 1u == (gen + 1u) * nloc) {
            __builtin_amdgcn_fence(__ATOMIC_RELEASE, "agent");
            asm volatile("s_waitcnt vmcnt(0)" ::: "memory");
            const unsigned og = xb_add(&bar[XB_TOP], 1u);
            const unsigned tg = og / nx;
            if (og + 1u == (tg + 1u) * nx) xb_add(&bar[XB_TOPGEN], 1u);
            else XB_SPIN(xb_ld(&bar[XB_TOPGEN]) == tg, bar);
            __builtin_amdgcn_fence(__ATOMIC_ACQUIRE, "agent");
            xb_add(&bar[XB_XGEN(b.x)], 1u);
            asm volatile("s_waitcnt vmcnt(0)" ::: "memory");
        } else {
            XB_SPIN(xb_ld(&bar[XB_XGEN(b.x)]) == gen, bar);
            __builtin_amdgcn_fence(__ATOMIC_ACQUIRE, "agent");
            asm volatile("s_waitcnt vmcnt(0)" ::: "memory");
        }
    }
    __syncthreads();
}

__global__ void __launch_bounds__(NTHREADS, 2) hymba_fwd(Args args) {
    extern __shared__ __attribute__((aligned(16))) unsigned char lds_raw[];
    cg::grid_group grid = cg::this_grid();
    Frame F;
    F.lds = (LAS unsigned char*)lds_raw;
    F.G = gridDim.x;
    if (threadIdx.x < 64) ((LAS unsigned*)(F.lds + 131072))[threadIdx.x] = 0u;
    __syncthreads();
    const XcdBarrier xbar = xcd_barrier_post((unsigned*)(args.ws + WS_CTL), (volatile LAS unsigned*)(F.lds + 131072));
    if (args.ph_hi > 1000) grid.sync();

    const int lo = args.ph_lo, hi = args.ph_hi;
#define RELAUNDER() do { int tv = threadIdx.x; asm volatile("" : "+v"(tv)); F.tid = tv; F.lane = tv & 63; F.wave = __builtin_amdgcn_readfirstlane(tv >> 6); \
        int bv = blockIdx.x; asm volatile("" : "+s"(bv)); F.bid = bv; \
        const __attribute__((address_space(4))) unsigned long long* kv = (const __attribute__((address_space(4))) unsigned long long*)__builtin_amdgcn_kernarg_segment_ptr(); asm volatile("" : "+s"(kv)); F.kp = kv; \
        F.ws = (unsigned char*)kv[29]; F.out = (float*)kv[28]; } while (0)
#ifndef REPMASK
#define REPMASK 0
#endif
#define PH(k) if (lo <= (k) && (k) < hi) for (int rep_ = 0; rep_ < 1 + ((REPMASK >> (k)) & 1); ++rep_)
#define SEAM(k) do { if ((k) + 1 < hi || rep_ < ((REPMASK >> (k)) & 1)) xcd_barrier(xbar); } while (0)
#define WSB(off) ((bf16_t*)(F.ws + (off)))

    PH(0) { RELAUNDER();
#ifndef NO_P0
        p_prologue(F);
#endif
        SEAM(0); }
    PH(1) { RELAUNDER();
        pg8::Gemm g{WSB(WS_AB), WSB(WS_W1A), MTOK, NFF2, DM, DM}; pg8::StaticOrder S; S.init(MTOK, NFF2, F.G, F.bid); pg8::EpiSwiGLU E{WSB(WS_ACT)};
#ifndef NO_P1
        pg8::gemm_phase<pg8::EpiSwiGLU, DM, DM>(F.lds, g, S, E, F.tid);
#endif
        SEAM(1); }
    PH(2) { RELAUNDER();
        pg8::Gemm g{WSB(WS_ACT), WSB(WS_W1B), MTOK, DM, DFF, DFF}; pg8::StaticOrder S; S.init(MTOK, DM, F.G, F.bid); pg8::EpiResid E{WSB(WS_AB), WSB(WS_Y), ALPHA, 0.5f};
#ifndef NO_P2
        pg8::gemm_phase<pg8::EpiResid, DFF, DFF>(F.lds, g, S, E, F.tid);
#endif
        SEAM(2); }
    PH(3) { RELAUNDER(); p_layernorm<false>(F, WSB(WS_Y), INP(3), INP(4), WSB(WS_AB), nullptr); SEAM(3); }
    PH(4) { RELAUNDER();
        pg8::Gemm g{WSB(WS_AB), WSB(WS_WMI), MTOK, NPROJ, DM, DM}; pg8::StaticOrder S; S.init(MTOK, NPROJ, F.G, F.bid);
        pg8::EpiProj E{WSB(WS_ACT), WSB(WS_KCV), WSB(WS_VT), (const float*)(F.ws + WS_ROPE)};
#ifndef NO_P4
        pg8::gemm_phase<pg8::EpiProj, DM, DM>(F.lds, g, S, E, F.tid);
#endif
        SEAM(4); }
    PH(5) { RELAUNDER();
        const int ncmp = (F.G > 64) ? 32 : 0;
        if (F.bid < 32) {
            const int which = F.bid >> 4;
            pg8::Gemm g{WSB(WS_KCV) + (size_t)which * 32 * 2048 * 64, WSB(WS_WC1) + (size_t)which * 256 * 2048, 4096, 256, 2048, 1024};
            pg8::StaticOrder S; S.init(4096, 256, F.G > 16 ? F.G : 16, F.bid & 15);
            pg8::EpiCmp E{WSB(WS_HID) + (size_t)which * 4096 * 256, (const float*)(F.ws + WS_CBIAS) + which * 256};
#ifndef NO_P5A
            pg8::gemm_phase<pg8::EpiCmp, 2048, 1024>(F.lds, g, S, E, F.tid);
#endif
            pg8::Unit cu; if (S.next(0, cu)) cmp_second(F, which, cu.pm);
        }
        if (F.bid >= ncmp) for (int u = F.bid - ncmp; u < 256; u += F.G - ncmp) {
#ifndef NO_P5B
            lru_unit(F, u);
#endif
        }
        SEAM(6); }
    PH(7) { RELAUNDER();
        for (int L = F.bid; L < 1024; L += F.G) {
            const int rd = L >> 8, c = L & 255, bg = c & 31, a = c >> 5;
            const int qt = rd == 0 ? 31 - a : (rd == 1 ? 16 + a : (rd == 2 ? 15 - a : a));
            { int tv = threadIdx.x; asm volatile("" : "+v"(tv)); F.tid = tv; F.lane = tv & 63; F.wave = __builtin_amdgcn_readfirstlane(tv >> 6); }
#ifndef NO_P7
            attn_unit(F, bg >> 1, bg & 1, qt);
#endif
        }
        SEAM(7); }
    PH(8) { RELAUNDER(); p_rmsnorm(F, WSB(WS_Y), INP(19), INP(20)); SEAM(8); }
    PH(9) { RELAUNDER();
        pg8::Gemm g{WSB(WS_Y), WSB(WS_WMO), MTOK, DM, DM, DM}; pg8::StaticOrder S; S.init(MTOK, DM, F.G, F.bid); pg8::EpiResid E{WSB(WS_AB), WSB(WS_ACT), ALPHA, 1.0f};
#ifndef NO_P9
        pg8::gemm_phase<pg8::EpiResid, DM, DM>(F.lds, g, S, E, F.tid);
#endif
        SEAM(9); }
    PH(10) { RELAUNDER(); p_layernorm<false>(F, WSB(WS_ACT), INP(22), INP(23), WSB(WS_AB), nullptr); SEAM(10); }
    PH(11) { RELAUNDER();
        pg8::Gemm g{WSB(WS_AB), WSB(WS_W2A), MTOK, NFF2, DM, DM}; pg8::StaticOrder S; S.init(MTOK, NFF2, F.G, F.bid); pg8::EpiSwiGLU E{WSB(WS_ACT)};
#ifndef NO_P1
        pg8::gemm_phase<pg8::EpiSwiGLU, DM, DM>(F.lds, g, S, E, F.tid);
#endif
        SEAM(11); }
    PH(12) { RELAUNDER();
        pg8::Gemm g{WSB(WS_ACT), WSB(WS_W2B), MTOK, DM, DFF, DFF}; pg8::StaticOrder S; S.init(MTOK, DM, F.G, F.bid); pg8::EpiResid E{WSB(WS_AB), WSB(WS_Y), ALPHA, 0.5f};
#ifndef NO_P2
        pg8::gemm_phase<pg8::EpiResid, DFF, DFF>(F.lds, g, S, E, F.tid);
#endif
        SEAM(12); }
    PH(13) { RELAUNDER(); p_layernorm<true>(F, WSB(WS_Y), INP(26), INP(27), nullptr, F.out); }
}

extern "C" void kernel_launch(void* const* d_in, const int* in_sizes, int n_in, void* d_out, int out_size, void* d_ws, size_t ws_size, hipStream_t stream) {
    static int grid = 0;
    if (grid == 0) {
        if (n_in != 28 || out_size != MTOK * DM || ws_size < WS_END) { fprintf(stderr, "kernel_launch: unexpected shapes (n_in %d out %d ws %zu)\n", n_in, out_size, ws_size); grid = -1; return; }
        int dev = 0, cus = 0, per_cu = 0;
        (void)hipGetDevice(&dev); (void)hipDeviceGetAttribute(&cus, hipDeviceAttributeMultiprocessorCount, dev);
        if (hipFuncSetAttribute((const void*)hymba_fwd, hipFuncAttributeMaxDynamicSharedMemorySize, LDS_BYTES) != hipSuccess) { fprintf(stderr, "kernel_launch: hipFuncSetAttribute failed\n"); grid = -1; return; }
        if (hipOccupancyMaxActiveBlocksPerMultiprocessor(&per_cu, (const void*)hymba_fwd, NTHREADS, LDS_BYTES) != hipSuccess || per_cu < 1) { fprintf(stderr, "kernel_launch: occupancy query failed (%d)\n", per_cu); (void)hipGetLastError(); per_cu = 1; }
        if (per_cu > 1) per_cu = 1;
        grid = cus * per_cu;
        if (grid <= 0) { grid = -1; return; }
    }
    if (grid < 0) return;
    if (hipMemsetAsync((char*)d_ws + WS_CTL, 0, CTL_BYTES, stream) != hipSuccess) { fprintf(stderr, "kernel_launch: memset failed\n"); return; }
    Args a{};
    for (int i = 0; i < 28; ++i) a.in[i] = (const float*)d_in[i];
    a.out = (float*)d_out; a.ws = (unsigned char*)d_ws; a.ph_lo = 0; a.ph_hi = NPHASE;
    void* kargs[] = {&a};
    hipError_t e = hipLaunchCooperativeKernel((const void*)hymba_fwd, dim3(grid), dim3(NTHREADS), kargs, LDS_BYTES, stream);
    if (e != hipSuccess) fprintf(stderr, "kernel_launch: cooperative launch failed: %s (grid %d)\n", hipGetErrorString(e), grid);
}
```

```cpp
#include <hip/hip_runtime.h>
#include <hip/hip_cooperative_groups.h>
#include <cstdio>
#include <cstdint>
namespace cg = cooperative_groups;

#define LAS __attribute__((address_space(3)))
typedef unsigned short bf16_t;
typedef short bf16x8 __attribute__((ext_vector_type(8)));
typedef short s16x4 __attribute__((ext_vector_type(4)));
typedef float f32x4 __attribute__((ext_vector_type(4)));
typedef float f32x16 __attribute__((ext_vector_type(16)));
typedef unsigned u32x4 __attribute__((ext_vector_type(4)));
typedef unsigned u32x2 __attribute__((ext_vector_type(2)));
typedef float f32x2_t __attribute__((ext_vector_type(2)));
typedef __bf16 bf16x2_t __attribute__((ext_vector_type(2)));

constexpr int DM = 1024, NBATCH = 16, SEQ = 2048, MTOK = NBATCH * SEQ;
constexpr int DFF = 2816, NFF2 = 5632, INCOLS = 2328, NPROJ = 2560;
constexpr float ALPHA = 1.189207115002721f;
constexpr float LN_EPS = 1e-5f, RMS_EPS = 1e-6f;
constexpr float L2E = 1.4426950408889634f;

constexpr size_t MiB = 1u << 20;
constexpr size_t WS_W1A = 2 * MiB, WS_W1B = 14 * MiB, WS_WMI = 20 * MiB, WS_WMO = 26 * MiB, WS_W2A = 28 * MiB, WS_W2B = 40 * MiB;
constexpr size_t WS_WC1 = 46 * MiB;
constexpr size_t WS_ROPE = 48 * MiB;
constexpr size_t WS_CBIAS = 48 * MiB + 512 * 1024;
constexpr size_t WS_KC = 49 * MiB;
constexpr size_t WS_VCT = 49 * MiB + 512 * 1024;
constexpr size_t WS_HID = 50 * MiB;
constexpr size_t WS_KCV = 54 * MiB;
constexpr size_t WS_VT = 72 * MiB;
constexpr size_t WS_AB = 96 * MiB;
constexpr size_t WS_Y = 160 * MiB;
constexpr size_t WS_ACT = 224 * MiB;
constexpr size_t WS_END = 400 * MiB;

__device__ __forceinline__ unsigned pk2(float lo, float hi) { f32x2_t v = {lo, hi}; bf16x2_t b = __builtin_convertvector(v, bf16x2_t); return __builtin_bit_cast(unsigned, b); }
__device__ __forceinline__ float bflo(unsigned w) { return __uint_as_float(w << 16); }
__device__ __forceinline__ float bfhi(unsigned w) { return __uint_as_float(w & 0xffff0000u); }
__device__ __forceinline__ float bf2f(bf16_t h) { return __uint_as_float((unsigned)h << 16); }
__device__ __forceinline__ float fsigmoid(float x) { return __builtin_amdgcn_rcpf(1.0f + __builtin_amdgcn_exp2f(-x * L2E)); }
#define LDS_WAIT() asm volatile("s_waitcnt lgkmcnt(0)" ::: "memory")

namespace pg8 {
constexpr int BM = 256, BK = 64, HALF = 128, HTB = HALF * BK * 2, STAGE_BYTES = 8 * HTB, NXCD = 8, WGM = 8;
__host__ __device__ __forceinline__ int lds_byte(int r, int c) { const int st = (r >> 4) * 2 + (c >> 5), rr = r & 15, cc = c & 31, ob = rr * 64 + cc * 2; return st * 1024 + (ob ^ (((ob >> 9) & 1) << 5)); }
__host__ __device__ __forceinline__ void stage_rc(int b, int& R, int& C) { const int st = b / 1024, sb = b % 1024, swz = sb ^ (((sb >> 9) & 1) << 5); R = (st >> 1) * 16 + swz / 64; C = (st & 1) * 32 + (swz % 64) / 2; }
__host__ __device__ __forceinline__ int perm32(int rho) { const int n = rho >> 4, i = rho & 15; return 8 * (i >> 2) + 4 * n + (i & 3); }
struct Unit { int pm, pn; };
struct Gemm { const bf16_t* A; const bf16_t* Bt; int M, N, K, lda; };
struct StaticOrder {
    int nM, nN, nwg, G, c;
    __device__ void init(int M, int N, int G_, int c_) { nM = M / BM; nN = N / BM; nwg = nM * nN; G = G_; c = c_; }
    __device__ bool next(int i, Unit& u) const {
        const long L = (long)i * G + c; if (L >= nwg) return false;
        int wgid = (int)L; { const int q = nwg / NXCD, r = nwg % NXCD, xcd = wgid % NXCD, off = wgid / NXCD; wgid = (xcd < r ? xcd * (q + 1) : r * (q + 1) + (xcd - r) * q) + off; }
        const int nig = WGM * nN, gid = wgid / nig, fm = gid * WGM, gsz = (nM - fm) < WGM ? (nM - fm) : WGM;
        u.pm = fm + ((wgid % nig) % gsz); u.pn = (wgid % nig) / gsz; return true;
    }
};

template <class Epi, int K, int lda>
__device__ __forceinline__ void gemm_phase(LAS unsigned char* lds, const Gemm g, const StaticOrder& S, const Epi& E, const int tid) {
    const int wid = __builtin_amdgcn_readfirstlane(tid >> 6), lane = tid & 63, wr = wid >> 2, wc = wid & 3, fr = lane & 15, fq = lane >> 4;
    constexpr int nt = K / BK;
    unsigned voffA[2], voffB[2];
#pragma unroll
    for (int i = 0; i < 2; ++i) { int R, C; stage_rc(tid * 16 + i * 8192, R, C); const int Rb = Epi::PERM ? ((R & ~31) + perm32(R & 31)) : R;
        voffA[i] = (unsigned)(R * lda + C) * 2u; voffB[i] = (unsigned)(Rb * K + C) * 2u; }
    const size_t kstep = (size_t)(BK * 2);
    const size_t hstepA = (size_t)HALF * lda * 2, hstepB = (size_t)HALF * K * 2;
    const size_t tstepA = 2 * hstepA, tstepB = 2 * hstepB;
    const unsigned ldsw = (unsigned)wid * 1024u;
    const int aoff = lds_byte(wr * 64 + fr, fq * 8), boff = lds_byte(wc * 32 + fr, fq * 8);
#define PG8_SA(b, h) (((b) * 2 + (h)) * HTB)
#define PG8_SB(b, h) ((4 + (b) * 2 + (h)) * HTB)
#define PG8_STAGE(bufoff, gbase, voff) do { _Pragma("unroll") for (int _i = 0; _i < 2; ++_i) \
        __builtin_amdgcn_global_load_lds((const unsigned*)((const char*)(gbase) + (voff)[_i]), (LAS unsigned*)(lds + (bufoff) + ldsw + _i * 8192), 16, 0, 0); } while (0)
#define PG8_LDA(dst, b, h) do { _Pragma("unroll") for (int m = 0; m < 4; ++m) _Pragma("unroll") for (int k = 0; k < 2; ++k) dst[m][k] = *(const LAS bf16x8*)(lds + PG8_SA(b, h) + aoff + m * 2048 + k * 1024); } while (0)
#define PG8_LDB(dst, b, h) do { _Pragma("unroll") for (int n = 0; n < 2; ++n) _Pragma("unroll") for (int k = 0; k < 2; ++k) dst[n][k] = *(const LAS bf16x8*)(lds + PG8_SB(b, h) + boff + n * 2048 + k * 1024); } while (0)
#define PG8_MMA(ai, bj, At, Bt) do { __builtin_amdgcn_s_setprio(1); _Pragma("unroll") for (int m = 0; m < 4; ++m) _Pragma("unroll") for (int n = 0; n < 2; ++n) _Pragma("unroll") for (int k = 0; k < 2; ++k) \
        acc[ai][bj][m][n] = __builtin_amdgcn_mfma_f32_16x16x32_bf16(Bt[n][k], At[m][k], acc[ai][bj][m][n], 0, 0, 0); __builtin_amdgcn_s_setprio(0); } while (0)
#define PG8_WAIT_V(n) asm volatile("s_waitcnt vmcnt(" #n ")" ::: "memory")
#define PG8_WAIT_L(n) asm volatile("s_waitcnt lgkmcnt(" #n ")" ::: "memory")
#define PG8_BAR __builtin_amdgcn_s_barrier()
#define PG8_SCHED __builtin_amdgcn_sched_barrier(0)
    Unit cur, nxt; int ui = 0;
    if (!S.next(0, cur)) return;
    f32x4 acc[2][2][4][2];
#pragma unroll
    for (int a = 0; a < 2; ++a)
#pragma unroll
        for (int b = 0; b < 2; ++b)
#pragma unroll
            for (int m = 0; m < 4; ++m)
#pragma unroll
                for (int n = 0; n < 2; ++n) acc[a][b][m][n] = (f32x4){0.f, 0.f, 0.f, 0.f};
    bf16x8 At[4][2], B0[2][2], B1[2][2];
    const char* cA = (const char*)g.A + (size_t)cur.pm * tstepA; const char* cB = (const char*)g.Bt + (size_t)cur.pn * tstepB;
    PG8_STAGE(PG8_SB(0, 0), cB, voffB); PG8_STAGE(PG8_SB(0, 1), cB + hstepB, voffB); PG8_STAGE(PG8_SA(0, 0), cA, voffA); PG8_STAGE(PG8_SA(0, 1), cA + hstepA, voffA);
    if (wr == 1) PG8_BAR;
    PG8_WAIT_V(2); PG8_BAR;
    PG8_STAGE(PG8_SB(1, 0), cB + kstep, voffB); PG8_STAGE(PG8_SA(1, 0), cA + kstep, voffA); PG8_STAGE(PG8_SB(1, 1), cB + hstepB + kstep, voffB);
    PG8_WAIT_V(6); PG8_BAR;
    for (;;) {
        const bool has_next = S.next(ui + 1, nxt);
        const char* nA = has_next ? (const char*)g.A + (size_t)nxt.pm * tstepA : cA; const char* nB = has_next ? (const char*)g.Bt + (size_t)nxt.pn * tstepB : cB;
        for (int t = 0; t < nt; t += 2) {
            const bool last = (t == nt - 2);
            const char* a1 = cA + (size_t)(t + 1) * kstep;
            const char* a2 = last ? nA : cA + (size_t)(t + 2) * kstep; const char* b2 = last ? nB : cB + (size_t)(t + 2) * kstep;
            const char* a3 = a2 + kstep; const char* b3 = b2 + kstep;
            PG8_LDB(B0, 0, 0); PG8_LDB(B1, 0, 1); PG8_SCHED; PG8_LDA(At, 0, 0); PG8_STAGE(PG8_SA(1, 1), a1 + hstepA, voffA);
            PG8_WAIT_V(8); PG8_WAIT_L(0); PG8_BAR; PG8_MMA(0, 0, At, B0); PG8_MMA(0, 1, At, B1); PG8_BAR; PG8_SCHED;
            PG8_LDA(At, 0, 1); PG8_STAGE(PG8_SB(0, 0), b2, voffB); PG8_STAGE(PG8_SB(0, 1), b2 + hstepB, voffB); PG8_STAGE(PG8_SA(0, 0), a2, voffA);
            PG8_WAIT_V(8); PG8_WAIT_L(0); PG8_BAR; PG8_MMA(1, 0, At, B0); PG8_MMA(1, 1, At, B1); PG8_BAR; PG8_SCHED;
            PG8_LDB(B0, 1, 0); PG8_LDB(B1, 1, 1); PG8_SCHED; PG8_LDA(At, 1, 0); PG8_STAGE(PG8_SA(0, 1), a2 + hstepA, voffA);
            PG8_WAIT_V(8); PG8_WAIT_L(0); PG8_BAR; PG8_MMA(0, 0, At, B0); PG8_MMA(0, 1, At, B1); PG8_BAR; PG8_SCHED;
            PG8_LDA(At, 1, 1); PG8_STAGE(PG8_SB(1, 0), b3, voffB); PG8_STAGE(PG8_SB(1, 1), b3 + hstepB, voffB); PG8_STAGE(PG8_SA(1, 0), a3, voffA);
            PG8_WAIT_V(8); PG8_WAIT_L(0); PG8_BAR; PG8_MMA(1, 0, At, B0); PG8_MMA(1, 1, At, B1); PG8_BAR; PG8_SCHED;
        }
        if (wr == 0) PG8_BAR;
        E(acc, cur, wr, wc, fr, fq);
        if (!has_next) break;
#pragma unroll
        for (int a = 0; a < 2; ++a)
#pragma unroll
            for (int b = 0; b < 2; ++b)
#pragma unroll
                for (int m = 0; m < 4; ++m)
#pragma unroll
                    for (int n = 0; n < 2; ++n) acc[a][b][m][n] = (f32x4){0.f, 0.f, 0.f, 0.f};
        cur = nxt; cA = nA; cB = nB; ++ui;
        if (wr == 1) PG8_BAR;
    }
    PG8_WAIT_V(0);
    PG8_BAR;
#undef PG8_SA
#undef PG8_SB
#undef PG8_STAGE
#undef PG8_LDA
#undef PG8_LDB
#undef PG8_MMA
#undef PG8_WAIT_V
#undef PG8_WAIT_L
#undef PG8_BAR
#undef PG8_SCHED
}

struct EpiSwiGLU {
    static constexpr bool PERM = true;
    bf16_t* O;
    __device__ __forceinline__ void operator()(const f32x4 (&acc)[2][2][4][2], const Unit& u, int wr, int wc, int fr, int fq) const {
        const int col = u.pn * 128 + wc * 32 + 8 * fq;
#pragma unroll
        for (int ai = 0; ai < 2; ++ai)
#pragma unroll
            for (int m = 0; m < 4; ++m) {
                const int row = u.pm * BM + ai * HALF + wr * 64 + m * 16 + fr;
                float o[8];
#pragma unroll
                for (int n = 0; n < 2; ++n)
#pragma unroll
                    for (int e = 0; e < 4; ++e) { const float gv = acc[ai][0][m][n][e], uv = acc[ai][1][m][n][e]; o[4 * n + e] = gv * fsigmoid(gv) * uv; }
                u32x4 w; w.x = pk2(o[0], o[1]); w.y = pk2(o[2], o[3]); w.z = pk2(o[4], o[5]); w.w = pk2(o[6], o[7]);
                *(u32x4*)(O + (size_t)row * DFF + col) = w;
            }
    }
};
struct EpiResid {
    static constexpr bool PERM = true;
    const bf16_t* res; bf16_t* out; float alpha, scale;
    __device__ __forceinline__ void operator()(const f32x4 (&acc)[2][2][4][2], const Unit& u, int wr, int wc, int fr, int fq) const {
        const int col0 = u.pn * BM + wc * 32 + 8 * fq;
#pragma unroll
        for (int ai = 0; ai < 2; ++ai)
#pragma unroll
            for (int m = 0; m < 4; ++m) {
                const size_t off = (size_t)(u.pm * BM + ai * HALF + wr * 64 + m * 16 + fr) * DM + col0;
#pragma unroll
                for (int bj = 0; bj < 2; ++bj) {
                    const u32x4 rv = *(const u32x4*)(res + off + bj * HALF);
                    const f32x4 a0 = acc[ai][bj][m][0], a1 = acc[ai][bj][m][1];
                    u32x4 w;
                    w.x = pk2(alpha * bflo(rv.x) + scale * a0[0], alpha * bfhi(rv.x) + scale * a0[1]); w.y = pk2(alpha * bflo(rv.y) + scale * a0[2], alpha * bfhi(rv.y) + scale * a0[3]);
                    w.z = pk2(alpha * bflo(rv.z) + scale * a1[0], alpha * bfhi(rv.z) + scale * a1[1]); w.w = pk2(alpha * bflo(rv.w) + scale * a1[2], alpha * bfhi(rv.w) + scale * a1[3]);
                    *(u32x4*)(out + off + bj * HALF) = w;
                }
            }
    }
};
struct EpiProj {
    static constexpr bool PERM = true;
    bf16_t* PROJ; bf16_t* KCV; bf16_t* VT; const float* ROPE;
    __device__ __forceinline__ void operator()(const f32x4 (&acc)[2][2][4][2], const Unit& u, int wr, int wc, int fr, int fq) const {
        const int pn = u.pn, hc = 32 * wc + 8 * fq;
#pragma unroll
        for (int ai = 0; ai < 2; ++ai)
#pragma unroll
            for (int m = 0; m < 4; ++m) {
                const int row = u.pm * BM + ai * HALF + wr * 64 + m * 16 + fr, b = row >> 11, t = row & 2047;
#pragma unroll
                for (int bj = 0; bj < 2; ++bj) {
                    f32x4 v0 = acc[ai][bj][m][0], v1 = acc[ai][bj][m][1];
                    const bool isq = (pn == 4 || pn == 5);
                    const bool rope = isq || (pn >= 6 && pn <= 8 && bj == 0);
                    if (rope) {
                        const int i0 = (hc & 63) >> 1;
                        const f32x4* rp = (const f32x4*)(ROPE + ((size_t)t * 32 + i0) * 2);
                        const f32x4 c0 = rp[0], c1 = rp[1];
                        float a, bb;
                        a = v0[0] * c0[0] - v0[1] * c0[1]; bb = v0[1] * c0[0] + v0[0] * c0[1]; v0[0] = a; v0[1] = bb;
                        a = v0[2] * c0[2] - v0[3] * c0[3]; bb = v0[3] * c0[2] + v0[2] * c0[3]; v0[2] = a; v0[3] = bb;
                        a = v1[0] * c1[0] - v1[1] * c1[1]; bb = v1[1] * c1[0] + v1[0] * c1[1]; v1[0] = a; v1[1] = bb;
                        a = v1[2] * c1[2] - v1[3] * c1[3]; bb = v1[3] * c1[2] + v1[2] * c1[3]; v1[2] = a; v1[3] = bb;
                        if (isq) { v0 = v0 * (0.125f * L2E); v1 = v1 * (0.125f * L2E); }
                    }
                    u32x4 w; w.x = pk2(v0[0], v0[1]); w.y = pk2(v0[2], v0[3]); w.z = pk2(v1[0], v1[1]); w.w = pk2(v1[2], v1[3]);
                    if (pn == 6) {
                        const int gg = hc >> 6, d = hc & 63;
                        *(u32x4*)(KCV + (((size_t)(bj * 32 + b * 2 + gg)) * 2048 + t) * 64 + d) = w;
                    } else if ((pn == 7 || pn == 8) && bj == 1) {
                        const int gg = hc >> 6, d = hc & 63;
                        bf16_t* vp = VT + (((size_t)((pn - 7) * 32 + b * 2 + gg)) * 64 + d) * 2048 + t;
                        vp[0 * 2048] = (bf16_t)(w.x & 0xffffu); vp[1 * 2048] = (bf16_t)(w.x >> 16); vp[2 * 2048] = (bf16_t)(w.y & 0xffffu); vp[3 * 2048] = (bf16_t)(w.y >> 16);
                        vp[4 * 2048] = (bf16_t)(w.z & 0xffffu); vp[5 * 2048] = (bf16_t)(w.z >> 16); vp[6 * 2048] = (bf16_t)(w.w & 0xffffu); vp[7 * 2048] = (bf16_t)(w.w >> 16);
                    } else {
                        *(u32x4*)(PROJ + (size_t)row * NPROJ + 256 * pn + 128 * bj + hc) = w;
                    }
                    asm volatile("" ::: "memory");
                }
            }
    }
};
struct EpiCmp {
    static constexpr bool PERM = true;
    bf16_t* O; const float* bias;
    __device__ __forceinline__ void operator()(const f32x4 (&acc)[2][2][4][2], const Unit& u, int wr, int wc, int fr, int fq) const {
#pragma unroll
        for (int ai = 0; ai < 2; ++ai)
#pragma unroll
            for (int m = 0; m < 4; ++m) {
                const int row = u.pm * BM + ai * HALF + wr * 64 + m * 16 + fr;
#pragma unroll
                for (int bj = 0; bj < 2; ++bj) {
                    const int col = 128 * bj + 32 * wc + 8 * fq;
                    const f32x4 b0 = *(const f32x4*)(bias + col), b1 = *(const f32x4*)(bias + col + 4);
                    f32x4 v0 = acc[ai][bj][m][0] + b0, v1 = acc[ai][bj][m][1] + b1;
#pragma unroll
                    for (int e = 0; e < 4; ++e) { v0[e] = v0[e] * fsigmoid(v0[e]); v1[e] = v1[e] * fsigmoid(v1[e]); }
                    u32x4 w; w.x = pk2(v0[0], v0[1]); w.y = pk2(v0[2], v0[3]); w.z = pk2(v1[0], v1[1]); w.w = pk2(v1[2], v1[3]);
                    *(u32x4*)(O + (size_t)row * 256 + col) = w;
                }
                asm volatile("" ::: "memory");
            }
    }
};
}

constexpr int NWAVES = 8, NTHREADS = 512;
constexpr int LDS_BYTES = 131072 + 256;
constexpr size_t WS_CTL = 0, CTL_BYTES = 16384;
constexpr int NPHASE = 14;

struct Args { const float* in[28]; float* out; unsigned char* ws; int ph_lo, ph_hi; };

#define INP(k) ((const float*)F.kp[(k)])
struct Frame {
    LAS unsigned char* lds;
    int tid, lane, wave, G, bid;
    const __attribute__((address_space(4))) unsigned long long* kp;
    float* out; unsigned char* ws;
};

__device__ __forceinline__ float wave_sum(float v) {
#pragma unroll
    for (int o = 1; o < 64; o <<= 1) v += __shfl_xor(v, o);
    return v;
}
__device__ __forceinline__ int rope_d(int d) { return d < 32 ? 2 * d : 2 * (d - 32) + 1; }
__device__ __forceinline__ int map_swiglu(int n) { const int h = n >= DFF ? 1 : 0; const int c = n - h * DFF; return 256 * (c >> 7) + 128 * h + (c & 127); }
__device__ __forceinline__ int map_proj(int n) { const bool roped = (n >= 1024 && n < 1664) || (n >= 1792 && n < 1920) || (n >= 2048 && n < 2176); return roped ? ((n & ~63) + rope_d(n & 63)) : n; }

template <int MAP, bool KPERM>
__device__ __forceinline__ void tr_item(const float* W, int K, int N, bf16_t* WT, LAS float* scr, int item, int lane) {
    const int nblk = (N + 31) / 32, kb = item / nblk, nb = item % nblk, k0 = 64 * kb, n0 = 32 * nb;
    const int n4 = (lane & 7) * 4; const bool ok = (n0 + n4) < N;
    f32x4 ld[8];
#pragma unroll
    for (int i = 0; i < 8; ++i) { const int kk = 8 * i + (lane >> 3); ld[i] = ok ? *(const f32x4*)(W + (size_t)(k0 + kk) * N + n0 + n4) : (f32x4){0.f, 0.f, 0.f, 0.f}; }
#pragma unroll
    for (int i = 0; i < 8; ++i) { const int kk = 8 * i + (lane >> 3); LAS float* d = scr + kk * 33 + n4; d[0] = ld[i][0]; d[1] = ld[i][1]; d[2] = ld[i][2]; d[3] = ld[i][3]; }
    LDS_WAIT(); asm volatile("" ::: "memory");
    const int c = lane & 7;
#pragma unroll
    for (int j = 0; j < 4; ++j) {
        const int n = (lane >> 3) + 8 * j;
        if (n0 + n < N) {
            const LAS float* s = scr + n;
            float e[8];
#pragma unroll
            for (int q = 0; q < 8; ++q) { const int kk = KPERM ? ((q & 1) * 32 + 4 * c + (q >> 1)) : (8 * c + q); e[q] = s[kk * 33]; }
            const int dn = MAP == 1 ? map_swiglu(n0 + n) : (MAP == 2 ? map_proj(n0 + n) : (n0 + n));
            u32x4 o; o.x = pk2(e[0], e[1]); o.y = pk2(e[2], e[3]); o.z = pk2(e[4], e[5]); o.w = pk2(e[6], e[7]);
            *(u32x4*)(WT + (size_t)dn * K + k0 + 8 * c) = o;
        }
    }
    LDS_WAIT(); asm volatile("" ::: "memory");
}

__device__ __forceinline__ void p_prologue(Frame& F) {
    LAS float* scr = (LAS float*)(F.lds + F.wave * 16384);
    const int gw = F.bid * NWAVES + F.wave, NGW = F.G * NWAVES;
    bf16_t* W1A = (bf16_t*)(F.ws + WS_W1A); bf16_t* W1B = (bf16_t*)(F.ws + WS_W1B); bf16_t* WMI = (bf16_t*)(F.ws + WS_WMI); bf16_t* WMO = (bf16_t*)(F.ws + WS_WMO);
    bf16_t* W2A = (bf16_t*)(F.ws + WS_W2A); bf16_t* W2B = (bf16_t*)(F.ws + WS_W2B); bf16_t* WC1 = (bf16_t*)(F.ws + WS_WC1);
    constexpr int I_A = (DM / 64) * (NFF2 / 32), I_B = (DFF / 64) * (DM / 32), I_MI = (DM / 64) * ((INCOLS + 31) / 32), I_MO = (DM / 64) * (DM / 32), I_C = (2048 / 64) * (256 / 32);
    constexpr int NITEMS = 2 * I_A + 2 * I_B + I_MI + I_MO + 2 * I_C;
    for (int it = gw; it < NITEMS; it += NGW) {
        int r = it;
        if (r < I_A) { tr_item<1, false>(INP(1), DM, NFF2, W1A, scr, r, F.lane); continue; } r -= I_A;
        if (r < I_A) { tr_item<1, false>(INP(24), DM, NFF2, W2A, scr, r, F.lane); continue; } r -= I_A;
        if (r < I_B) { tr_item<0, false>(INP(2), DFF, DM, W1B, scr, r, F.lane); continue; } r -= I_B;
        if (r < I_B) { tr_item<0, false>(INP(25), DFF, DM, W2B, scr, r, F.lane); continue; } r -= I_B;
        if (r < I_MI) { tr_item<2, false>(INP(5), DM, INCOLS, WMI, scr, r, F.lane); continue; } r -= I_MI;
        if (r < I_MO) { tr_item<0, false>(INP(21), DM, DM, WMO, scr, r, F.lane); continue; } r -= I_MO;
        if (r < I_C) { tr_item<0, true>(INP(14), 2048, 256, WC1, scr, r, F.lane); continue; } r -= I_C;
        tr_item<0, false>(INP(17), 2048, 256, WC1 + (size_t)256 * 2048, scr, r, F.lane);
    }
    const int gt = F.bid * NTHREADS + F.tid, NGT = F.G * NTHREADS;
    { u32x4* z = (u32x4*)(WMI + (size_t)INCOLS * DM); const int nz = (NPROJ - INCOLS) * DM / 8;
      for (int i = gt; i < nz; i += NGT) z[i] = (u32x4){0u, 0u, 0u, 0u}; }
    { float* R = (float*)(F.ws + WS_ROPE);
      for (int i = gt; i < 2048 * 32; i += NGT) {
          const int t = i >> 5, k = i & 31;
          const float inv = __builtin_amdgcn_exp2f(-(float)k * 0.41524101186092029f);
          const float ang = (float)t * inv;
          const float kk = rintf(ang * 0.15915494309189535f);
          float rr = fmaf(-kk, 6.28318548202514648f, ang); rr = fmaf(-kk, -1.74845553e-7f, rr);
          const float fr = rr * 0.15915494309189535f;
          R[2 * i] = __builtin_amdgcn_cosf(fr); R[2 * i + 1] = __builtin_amdgcn_sinf(fr);
      } }
    { const float* x = INP(0); bf16_t* XB = (bf16_t*)(F.ws + WS_AB);
      for (int m = 4 * gw; m < MTOK; m += 4 * NGW) {
          const f32x4* xr = (const f32x4*)(x + (size_t)m * DM) + F.lane; u32x2* o = (u32x2*)(XB + (size_t)m * DM) + F.lane;
          f32x4 v[16];
#pragma unroll
          for (int j = 0; j < 16; ++j) v[j] = __builtin_nontemporal_load(xr + 64 * j);
#pragma unroll
          for (int j = 0; j < 16; ++j) o[64 * j] = (u32x2){pk2(v[j][0], v[j][1]), pk2(v[j][2], v[j][3])};
      } }
    if (F.bid < 64) {
        __syncthreads();
        const int wsel = F.bid >> 5, nb0 = (F.bid & 31) * 8;
        const float* pe = INP(wsel == 0 ? 13 : 16); const float* w1 = INP(wsel == 0 ? 14 : 17);
        float acc8[8];
#pragma unroll
        for (int e = 0; e < 8; ++e) acc8[e] = 0.f;
#pragma unroll
        for (int r4 = 0; r4 < 4; ++r4) {
            const int kk = F.tid * 4 + r4; const float pv = pe[kk];
            const f32x4 a = *(const f32x4*)(w1 + (size_t)kk * 256 + nb0), b = *(const f32x4*)(w1 + (size_t)kk * 256 + nb0 + 4);
            acc8[0] += pv * a[0]; acc8[1] += pv * a[1]; acc8[2] += pv * a[2]; acc8[3] += pv * a[3]; acc8[4] += pv * b[0]; acc8[5] += pv * b[1]; acc8[6] += pv * b[2]; acc8[7] += pv * b[3];
        }
        LAS float* red = (LAS float*)F.lds;
#pragma unroll
        for (int e = 0; e < 8; ++e) { const float sv = wave_sum(acc8[e]); if (F.lane == 0) red[F.wave * 8 + e] = sv; }
        __syncthreads();
        if (F.tid < 8) { float t = 0.f;
#pragma unroll
            for (int wv = 0; wv < 8; ++wv) t += red[wv * 8 + F.tid];
            ((float*)(F.ws + WS_CBIAS))[wsel * 256 + nb0 + F.tid] = t; }
        __syncthreads();
    }
}

template <bool OUT_F32>
__device__ __forceinline__ void p_layernorm(Frame& F, const bf16_t* Z, const float* g, const float* bta, bf16_t* OB, float* OF) {
    const int gw = F.bid * NWAVES + F.wave, NGW = F.G * NWAVES;
    float gv[16], bv[16];
#pragma unroll
    for (int e = 0; e < 16; ++e) { gv[e] = g[16 * F.lane + e]; bv[e] = bta[16 * F.lane + e]; }
    for (int m = 4 * gw; m < MTOK; m += 4 * NGW) {
        u32x4 raw[4][2];
#pragma unroll
        for (int rr = 0; rr < 4; ++rr) { const u32x4* zr = (const u32x4*)(Z + (size_t)(m + rr) * DM + 16 * F.lane); raw[rr][0] = zr[0]; raw[rr][1] = zr[1]; }
#pragma unroll
        for (int rr = 0; rr < 4; ++rr) {
            float v[16];
            const u32x4 a = raw[rr][0], b = raw[rr][1];
            v[0] = bflo(a.x); v[1] = bfhi(a.x); v[2] = bflo(a.y); v[3] = bfhi(a.y); v[4] = bflo(a.z); v[5] = bfhi(a.z); v[6] = bflo(a.w); v[7] = bfhi(a.w);
            v[8] = bflo(b.x); v[9] = bfhi(b.x); v[10] = bflo(b.y); v[11] = bfhi(b.y); v[12] = bflo(b.z); v[13] = bfhi(b.z); v[14] = bflo(b.w); v[15] = bfhi(b.w);
            float s = 0.f;
#pragma unroll
            for (int e = 0; e < 16; ++e) s += v[e];
            const float mean = wave_sum(s) * (1.f / DM); float s2 = 0.f;
#pragma unroll
            for (int e = 0; e < 16; ++e) { v[e] -= mean; s2 += v[e] * v[e]; }
            const float rstd = 1.f / sqrtf(wave_sum(s2) * (1.f / DM) + LN_EPS);
#pragma unroll
            for (int e = 0; e < 16; ++e) v[e] = v[e] * rstd * gv[e] + bv[e];
            if (OUT_F32) {
                f32x4* o = (f32x4*)(OF + (size_t)(m + rr) * DM + 16 * F.lane);
                o[0] = (f32x4){v[0], v[1], v[2], v[3]}; o[1] = (f32x4){v[4], v[5], v[6], v[7]}; o[2] = (f32x4){v[8], v[9], v[10], v[11]}; o[3] = (f32x4){v[12], v[13], v[14], v[15]};
            } else {
                u32x4* o = (u32x4*)(OB + (size_t)(m + rr) * DM + 16 * F.lane);
                u32x4 oa, ob; oa.x = pk2(v[0], v[1]); oa.y = pk2(v[2], v[3]); oa.z = pk2(v[4], v[5]); oa.w = pk2(v[6], v[7]);
                ob.x = pk2(v[8], v[9]); ob.y = pk2(v[10], v[11]); ob.z = pk2(v[12], v[13]); ob.w = pk2(v[14], v[15]);
                o[0] = oa; o[1] = ob;
            }
        }
    }
}

__device__ __forceinline__ void p_rmsnorm(Frame& F, bf16_t* Y, const float* gl, const float* gn) {
    const int gw = F.bid * NWAVES + F.wave, NGW = F.G * NWAVES;
    const float* gp = (F.lane < 32) ? (gl + 16 * F.lane) : (gn + 16 * (F.lane - 32));
    float gvv[16];
#pragma unroll
    for (int e = 0; e < 16; ++e) gvv[e] = gp[e];
    for (int m = 4 * gw; m < MTOK; m += 4 * NGW) {
        u32x4 raw[4][2];
#pragma unroll
        for (int rr = 0; rr < 4; ++rr) { const u32x4* yr = (const u32x4*)(Y + (size_t)(m + rr) * DM + 16 * F.lane); raw[rr][0] = yr[0]; raw[rr][1] = yr[1]; }
#pragma unroll
        for (int rr = 0; rr < 4; ++rr) {
            u32x4* yr = (u32x4*)(Y + (size_t)(m + rr) * DM + 16 * F.lane);
            const u32x4 a = raw[rr][0], b = raw[rr][1];
            float v[16];
            v[0] = bflo(a.x); v[1] = bfhi(a.x); v[2] = bflo(a.y); v[3] = bfhi(a.y); v[4] = bflo(a.z); v[5] = bfhi(a.z); v[6] = bflo(a.w); v[7] = bfhi(a.w);
            v[8] = bflo(b.x); v[9] = bfhi(b.x); v[10] = bflo(b.y); v[11] = bfhi(b.y); v[12] = bflo(b.z); v[13] = bfhi(b.z); v[14] = bflo(b.w); v[15] = bfhi(b.w);
            float s = 0.f;
#pragma unroll
            for (int e = 0; e < 16; ++e) s += v[e] * v[e];
#pragma unroll
            for (int o = 1; o < 32; o <<= 1) s += __shfl_xor(s, o);
            const float r = 1.f / sqrtf(s * (1.f / 512.f) + RMS_EPS);
#pragma unroll
            for (int e = 0; e < 16; ++e) v[e] = v[e] * r * gvv[e];
            u32x4 oa, ob; oa.x = pk2(v[0], v[1]); oa.y = pk2(v[2], v[3]); oa.z = pk2(v[4], v[5]); oa.w = pk2(v[6], v[7]);
            ob.x = pk2(v[8], v[9]); ob.y = pk2(v[10], v[11]); ob.z = pk2(v[12], v[13]); ob.w = pk2(v[14], v[15]);
            yr[0] = oa; yr[1] = ob;
        }
    }
}

__device__ __forceinline__ void cmp_second(Frame& F, int which, int pm) {
    const int lane = F.lane, quad = lane >> 4, l16 = lane & 15;
    const float* w2 = INP(which == 0 ? 15 : 18);
    LAS bf16_t* WT = (LAS bf16_t*)F.lds;
    for (int idx = F.tid; idx < 256 * 64; idx += NTHREADS) { const int k = idx >> 6, d = idx & 63; WT[d * 264 + k] = (bf16_t)(pk2(w2[idx], 0.f) & 0xffffu); }
    __builtin_amdgcn_fence(__ATOMIC_RELEASE, "agent");
    __syncthreads();
    __builtin_amdgcn_fence(__ATOMIC_ACQUIRE, "agent");
    const bf16_t* HID = (const bf16_t*)(F.ws + WS_HID) + ((size_t)which * 4096 + 256 * pm) * 256;
    bf16_t* KC = (bf16_t*)(F.ws + WS_KC); bf16_t* VCT = (bf16_t*)(F.ws + WS_VCT);
#pragma unroll 1
    for (int mi = 0; mi < 2; ++mi) {
        const int r0 = (2 * F.wave + mi) * 16;
        bf16x8 af[8];
#pragma unroll
        for (int ks = 0; ks < 8; ++ks) af[ks] = *(const bf16x8*)(HID + (size_t)(r0 + l16) * 256 + ks * 32 + quad * 8);
#pragma unroll
        for (int nt = 0; nt < 4; ++nt) {
            f32x4 c = {0.f, 0.f, 0.f, 0.f};
#pragma unroll
            for (int ks = 0; ks < 8; ++ks) { const bf16x8 bfr = *(const LAS bf16x8*)(WT + (nt * 16 + l16) * 264 + ks * 32 + quad * 8); c = __builtin_amdgcn_mfma_f32_16x16x32_bf16(af[ks], bfr, c, 0, 0, 0); }
#pragma unroll
            for (int j = 0; j < 4; ++j) {
                const int row = 256 * pm + r0 + quad * 4 + j, d = nt * 16 + l16;
                const bf16_t hb = (bf16_t)(pk2(c[j], 0.f) & 0xffffu);
                if (which == 0) KC[(size_t)row * 64 + rope_d(d)] = hb;
                else VCT[((size_t)(row >> 7) * 64 + d) * 128 + (row & 127)] = hb;
            }
        }
    }
    __syncthreads();
}

constexpr int LR2_XC = 0, LR2_XCW = 9216, LR2_SUM = 8 * 9216;
__device__ __forceinline__ void lru_unit(Frame& F, int u) {
    const int b = u >> 4, h = (u >> 1) & 7, jh = u & 1;
    const int lane = F.lane, w = F.wave, quad = lane >> 4, l16 = lane & 15, ca0 = 8 * (lane & 7), tg = lane >> 3;
    const bf16_t* PROJ = (const bf16_t*)(F.ws + WS_ACT); bf16_t* Y = (bf16_t*)(F.ws + WS_Y);
    LAS unsigned char* xc = F.lds + LR2_XC + w * LR2_XCW;
    LAS float* SUM = (LAS float*)(F.lds + LR2_SUM);
    bf16x8 wf[2][2][2];
#pragma unroll
    for (int gsel = 0; gsel < 2; ++gsel)
#pragma unroll
        for (int nt = 0; nt < 2; ++nt)
#pragma unroll
            for (int sk = 0; sk < 2; ++sk) {
                const float* wsrc = INP(gsel == 0 ? 8 : 10) + ((size_t)(h * 64 + sk * 32 + quad * 8)) * 64 + 32 * jh + nt * 16 + l16;
                u32x4 pw; pw.x = pk2(wsrc[0], wsrc[64]); pw.y = pk2(wsrc[128], wsrc[192]); pw.z = pk2(wsrc[256], wsrc[320]); pw.w = pk2(wsrc[384], wsrc[448]);
                wf[gsel][nt][sk] = __builtin_bit_cast(bf16x8, pw);
            }
    float ba[2], bx[2], c8[2];
#pragma unroll
    for (int nt = 0; nt < 2; ++nt) { const int c = 64 * h + 32 * jh + nt * 16 + l16; ba[nt] = INP(9)[c]; bx[nt] = INP(11)[c]; c8[nt] = 8.0f * log1pf(expf(-INP(12)[c])); }
    float cw[4][8], cb[8];
#pragma unroll
    for (int e = 0; e < 8; ++e) { cb[e] = INP(7)[64 * h + ca0 + e];
#pragma unroll
        for (int jt = 0; jt < 4; ++jt) cw[jt][e] = INP(6)[jt * 512 + 64 * h + ca0 + e]; }
    float hin[2] = {0.f, 0.f};
#pragma unroll 1
    for (int pass = 0; pass < 2; ++pass) {
        float hc[2] = {hin[0], hin[1]}, pc[2] = {1.f, 1.f};
#pragma unroll 1
        for (int sub = 0; sub < 4; ++sub) {
            const int t0 = 256 * w + 64 * sub;
            {
                u32x4 raw[11];
#pragma unroll
                for (int k = 0; k < 11; ++k) { const int ts = t0 + 8 * tg - 3 + k; raw[k] = (ts >= 0) ? *(const u32x4*)(PROJ + ((size_t)(b * 2048 + ts)) * NPROJ + 64 * h + ca0) : (u32x4){0u, 0u, 0u, 0u}; }
#pragma unroll
                for (int i = 0; i < 8; ++i) {
                    float a[8];
#pragma unroll
                    for (int e = 0; e < 8; ++e) a[e] = cb[e];
#pragma unroll
                    for (int jt = 0; jt < 4; ++jt) { const u32x4 rw = raw[i + jt];
                        a[0] += cw[jt][0] * bflo(rw.x); a[1] += cw[jt][1] * bfhi(rw.x); a[2] += cw[jt][2] * bflo(rw.y); a[3] += cw[jt][3] * bfhi(rw.y);
                        a[4] += cw[jt][4] * bflo(rw.z); a[5] += cw[jt][5] * bfhi(rw.z); a[6] += cw[jt][6] * bflo(rw.w); a[7] += cw[jt][7] * bfhi(rw.w); }
                    u32x4 pw; pw.x = pk2(a[0], a[1]); pw.y = pk2(a[2], a[3]); pw.z = pk2(a[4], a[5]); pw.w = pk2(a[6], a[7]);
                    *(LAS u32x4*)(xc + (8 * tg + i) * 144 + ca0 * 2) = pw;
                }
            }
#pragma unroll 1
            for (int mt = 0; mt < 4; ++mt) {
                const bf16x8 af0 = *(const LAS bf16x8*)(xc + (16 * mt + l16) * 144 + (quad * 8) * 2), af1 = *(const LAS bf16x8*)(xc + (16 * mt + l16) * 144 + (32 + quad * 8) * 2);
                const int trow = t0 + 16 * mt + quad * 4;
                float gt[2][4];
                if (pass == 1) {
#pragma unroll
                    for (int nt = 0; nt < 2; ++nt)
#pragma unroll
                        for (int j = 0; j < 4; ++j) gt[nt][j] = bf2f(PROJ[((size_t)(b * 2048 + trow + j)) * NPROJ + 512 + 64 * h + 32 * jh + nt * 16 + l16]);
                }
                f32x4 acc[2][2];
#pragma unroll
                for (int gsel = 0; gsel < 2; ++gsel)
#pragma unroll
                    for (int nt = 0; nt < 2; ++nt) { f32x4 c = {0.f, 0.f, 0.f, 0.f}; c = __builtin_amdgcn_mfma_f32_16x16x32_bf16(af0, wf[gsel][nt][0], c, 0, 0, 0); c = __builtin_amdgcn_mfma_f32_16x16x32_bf16(af1, wf[gsel][nt][1], c, 0, 0, 0); acc[gsel][nt] = c; }
#pragma unroll
                for (int nt = 0; nt < 2; ++nt) {
                    float av[4], uv[4];
#pragma unroll
                    for (int j = 0; j < 4; ++j) {
                        const float xcv = bf2f(*(const LAS bf16_t*)(xc + (16 * mt + quad * 4 + j) * 144 + (32 * jh + nt * 16 + l16) * 2));
                        const float r = fsigmoid(acc[0][nt][j] + ba[nt]), ig = fsigmoid(acc[1][nt][j] + bx[nt]);
                        const float la = -c8[nt] * r, x2 = 2.0f * la;
                        av[j] = __builtin_amdgcn_exp2f(la * L2E);
                        const float em = (x2 > -0.3f) ? x2 * (1.0f + x2 * (0.5f + x2 * (0.16666667f + x2 * (0.041666668f + x2 * (0.0083333338f + x2 * 0.0013888889f)))))
                                                      : (__builtin_amdgcn_exp2f(x2 * L2E) - 1.0f);
                        const float mult = (trow + j == 0) ? 1.0f : __builtin_amdgcn_sqrtf(-em);
                        uv[j] = mult * ig * xcv;
                    }
                    float P = av[0], H = uv[0];
#pragma unroll
                    for (int j = 1; j < 4; ++j) { H = av[j] * H + uv[j]; P *= av[j]; }
                    float Pp = __shfl_up(P, 16), Hp = __shfl_up(H, 16);
                    if (quad >= 1) { H = P * Hp + H; P = Pp * P; }
                    Pp = __shfl_up(P, 32); Hp = __shfl_up(H, 32);
                    if (quad >= 2) { H = P * Hp + H; P = Pp * P; }
                    const float Pt = __shfl(P, 48 + l16), Ht = __shfl(H, 48 + l16);
                    if (pass == 1) {
                        float Pe = __shfl_up(P, 16), He = __shfl_up(H, 16);
                        if (quad == 0) { Pe = 1.0f; He = 0.0f; }
                        float hq = Pe * hc[nt] + He;
#pragma unroll
                        for (int j = 0; j < 4; ++j) {
                            hq = av[j] * hq + uv[j];
                            const float x = gt[nt][j], z = 0.7978845608028654f * (x + 0.044715f * x * x * x);
                            const float th = 1.0f - 2.0f * __builtin_amdgcn_rcpf(1.0f + __builtin_amdgcn_exp2f(2.0f * z * L2E));
                            const float yv = hq * (0.5f * x * (1.0f + th));
                            Y[((size_t)(b * 2048 + trow + j)) * DM + 64 * h + 32 * jh + nt * 16 + l16] = (bf16_t)(pk2(yv, 0.f) & 0xffffu);
                        }
                    }
                    hc[nt] = Pt * hc[nt] + Ht; pc[nt] *= Pt;
                }
            }
        }
        if (pass == 0) {
            if (quad == 0) {
#pragma unroll
                for (int nt = 0; nt < 2; ++nt) { SUM[(w * 32 + nt * 16 + l16) * 2] = pc[nt]; SUM[(w * 32 + nt * 16 + l16) * 2 + 1] = hc[nt]; }
            }
            __syncthreads();
            for (int w2 = 0; w2 < w; ++w2) {
#pragma unroll
                for (int nt = 0; nt < 2; ++nt) hin[nt] = SUM[(w2 * 32 + nt * 16 + l16) * 2] * hin[nt] + SUM[(w2 * 32 + nt * 16 + l16) * 2 + 1];
            }
        }
    }
    __syncthreads();
}

constexpr int AT_KC = 0, AT_VC = 18432, AT_K = 35328, AT_V = 44544, AT_IMPP = 53248, AT_IMP = 87040, AT_SEL = 95488;
__device__ __forceinline__ int crow(int r, int hi) { return (r & 3) + 8 * (r >> 2) + 4 * hi; }
#define MFMA32(a, b, c) __builtin_amdgcn_mfma_f32_32x32x16_bf16((a), (b), (c), 0, 0, 0)
__device__ __forceinline__ f32x16 qk_tile(const LAS unsigned char* Kl, int krow0, const bf16x8 (&qf)[4], int i, int hi) {
    f32x16 p;
#pragma unroll
    for (int r = 0; r < 16; ++r) p[r] = 0.f;
    const LAS unsigned char* kp = Kl + (krow0 + i) * 144 + hi * 16;
#pragma unroll
    for (int d0 = 0; d0 < 4; ++d0) { const bf16x8 a = *(const LAS bf16x8*)(kp + d0 * 32); p = MFMA32(a, qf[d0], p); }
    return p;
}
__device__ __forceinline__ bf16x8 pack8(const f32x16& p, int s) {
    u32x4 w; w.x = pk2(p[8 * s], p[8 * s + 1]); w.y = pk2(p[8 * s + 2], p[8 * s + 3]); w.z = pk2(p[8 * s + 4], p[8 * s + 5]); w.w = pk2(p[8 * s + 6], p[8 * s + 7]);
    return __builtin_bit_cast(bf16x8, w);
}
__device__ __forceinline__ void pv_step(f32x16 (&o)[2], const LAS unsigned char* Vl, int VS, int kbase, bf16x8 pb, int i, int hi) {
#pragma unroll
    for (int d0t = 0; d0t < 2; ++d0t) {
        const LAS unsigned char* vp = Vl + (32 * d0t + i) * VS + (kbase + 4 * hi) * 2;
        const s16x4 lo = *(const LAS s16x4*)vp, hi4 = *(const LAS s16x4*)(vp + 16);
        const bf16x8 a = __builtin_shufflevector(lo, hi4, 0, 1, 2, 3, 4, 5, 6, 7);
        o[d0t] = MFMA32(a, pb, o[d0t]);
    }
}
template <int MODE>
__device__ __forceinline__ void attn_branch(const bf16_t* Kg, const bf16_t* VTg, int kt_lo, int kt_hi, unsigned selw, unsigned unionmask, int tq,
                                            const bf16x8 (&qf)[4], LAS unsigned char* lds, int tid, int i, int hi, float gate, f32x16 (&tot)[2]) {
    f32x16 o[2];
#pragma unroll
    for (int r = 0; r < 16; ++r) { o[0][r] = 0.f; o[1][r] = 0.f; }
    float m = -INFINITY, l = 0.f;
    const int ldrow = tid >> 3, ldch = tid & 7;
    const bf16_t* kgp = Kg + (size_t)ldrow * NPROJ + ldch * 8;
    const bf16_t* vgp = VTg + (size_t)ldrow * 2048 + ldch * 8;
    unsigned todo = (MODE == 1) ? (unionmask & (kt_hi >= 31 ? 0xffffffffu : ((2u << kt_hi) - 1u))) : (((kt_hi >= 31) ? 0xffffffffu : ((2u << kt_hi) - 1u)) & ~((1u << kt_lo) - 1u));
    u32x4 kv = {0u, 0u, 0u, 0u}, vv = {0u, 0u, 0u, 0u};
    if (todo) { const int k0 = __builtin_ctz(todo); kv = *(const u32x4*)(kgp + (size_t)k0 * 64 * NPROJ); vv = *(const u32x4*)(vgp + k0 * 64); }
    while (todo) {
        const int kt = __builtin_ctz(todo); todo &= todo - 1u;
        {
            *(LAS u32x4*)(lds + AT_K + ldrow * 144 + ldch * 16) = kv;
            LAS u32x2* vd = (LAS u32x2*)(lds + AT_V + ldrow * 136 + ldch * 16); vd[0] = (u32x2){vv.x, vv.y}; vd[1] = (u32x2){vv.z, vv.w};
        }
        __syncthreads();
        if (todo) { const int kn = __builtin_ctz(todo); kv = *(const u32x4*)(kgp + (size_t)kn * 64 * NPROJ); vv = *(const u32x4*)(vgp + kn * 64); }
        f32x16 p0 = qk_tile(lds + AT_K, 0, qf, i, hi), p1 = qk_tile(lds + AT_K, 32, qf, i, hi);
        const bool selbit = (MODE == 1) ? (((selw >> kt) & 1u) != 0u) : true;
        const bool edge = (MODE == 1) ? (kt == kt_hi) : (kt == kt_hi || kt + 8 == kt_hi);
        if (edge) {
            const int rel = tq - kt * 64 - 4 * hi;
#pragma unroll
            for (int r = 0; r < 16; ++r) {
                const int cr0 = (r & 3) + 8 * (r >> 2), cr1 = cr0 + 32;
                const bool v0 = cr0 <= rel && (MODE == 1 || cr0 >= rel - 511);
                const bool v1 = cr1 <= rel && (MODE == 1 || cr1 >= rel - 511);
                p0[r] = v0 ? p0[r] : -INFINITY; p1[r] = v1 ? p1[r] : -INFINITY;
            }
        }
        float mx = -INFINITY;
#pragma unroll
        for (int r = 0; r < 16; ++r) mx = fmaxf(mx, fmaxf(p0[r], p1[r]));
        if (MODE == 1 && !selbit) mx = -INFINITY;
        mx = fmaxf(mx, __shfl_xor(mx, 32));
        if (__any(mx > m + 8.0f)) {
            const float mnew = (mx > m + 8.0f) ? mx : m;
            const float alpha = (mnew == m) ? 1.0f : __builtin_amdgcn_exp2f(m - mnew);
#pragma unroll
            for (int r = 0; r < 16; ++r) { o[0][r] *= alpha; o[1][r] *= alpha; }
            l *= alpha; m = mnew;
        }
        const float moff = (MODE == 1 && !selbit) ? INFINITY : ((m == -INFINITY) ? 0.f : m);
        float ls = 0.f;
#pragma unroll
        for (int r = 0; r < 16; ++r) { p0[r] = __builtin_amdgcn_exp2f(p0[r] - moff); p1[r] = __builtin_amdgcn_exp2f(p1[r] - moff); ls += p0[r] + p1[r]; }
        l += ls;
        pv_step(o, lds + AT_V, 136, 0, pack8(p0, 0), i, hi);
        pv_step(o, lds + AT_V, 136, 16, pack8(p0, 1), i, hi);
        pv_step(o, lds + AT_V, 136, 32, pack8(p1, 0), i, hi);
        pv_step(o, lds + AT_V, 136, 48, pack8(p1, 1), i, hi);
        __syncthreads();
    }
    l += __shfl_xor(l, 32);
    const float sc = gate / l;
#pragma unroll
    for (int r = 0; r < 16; ++r) { tot[0][r] += o[0][r] * sc; tot[1][r] += o[1][r] * sc; }
}

__device__ __forceinline__ void attn_unit(Frame& F, int b, int g, int qt) {
    const int tid = F.tid, lane = F.lane, w = F.wave, i = lane & 31, hi = lane >> 5, r = w >> 1;
    const int bg = b * 2 + g, t0 = qt * 64, tl = 32 * (w & 1) + i, tq = t0 + tl;
    const size_t row = (size_t)b * 2048 + tq;
    LAS unsigned char* lds = F.lds;
    const bf16_t* PROJ = (const bf16_t*)(F.ws + WS_ACT); bf16_t* Y = (bf16_t*)(F.ws + WS_Y);
    const bf16_t* KC = (const bf16_t*)(F.ws + WS_KC); const bf16_t* VCT = (const bf16_t*)(F.ws + WS_VCT); const bf16_t* VT = (const bf16_t*)(F.ws + WS_VT);
    bf16x8 qf[4];
    { const bf16_t* qp = PROJ + row * NPROJ + 1024 + 64 * (4 * g + r) + 8 * hi;
#pragma unroll
      for (int d0 = 0; d0 < 4; ++d0) qf[d0] = *(const bf16x8*)(qp + 16 * d0); }
    float g0, g1, g2;
    { const bf16_t* gp = PROJ + row * NPROJ + 2304 + (4 * g + r) * 3; g0 = fsigmoid(bf2f(gp[0])); g1 = fsigmoid(bf2f(gp[1])); g2 = fsigmoid(bf2f(gp[2])); }
#pragma unroll
    for (int c2 = 0; c2 < 2; ++c2) {
        const int idx = tid + NTHREADS * c2;
        { const int rk = idx >> 3, ch = idx & 7; const u32x4 v = *(const u32x4*)(KC + ((size_t)bg * 128 + rk) * 64 + ch * 8); *(LAS u32x4*)(lds + AT_KC + rk * 144 + ch * 16) = v; }
        { const int rd = idx >> 4, ch = idx & 15; const u32x4 v = *(const u32x4*)(VCT + ((size_t)bg * 64 + rd) * 128 + ch * 8);
          LAS u32x2* vd = (LAS u32x2*)(lds + AT_VC + rd * 264 + ch * 16); vd[0] = (u32x2){v.x, v.y}; vd[1] = (u32x2){v.z, v.w}; }
    }
    __syncthreads();
    f32x16 tot[2];
    {
        f32x16 p[4];
#pragma unroll
        for (int kt = 0; kt < 4; ++kt) p[kt] = qk_tile(lds + AT_KC, 32 * kt, qf, i, hi);
        const int nv = tq >= 31 ? (((tq - 31) >> 4) + 1) : 0;
        const int nvl = nv - 4 * hi;
        float mx = -INFINITY;
#pragma unroll
        for (int kt = 0; kt < 4; ++kt)
#pragma unroll
            for (int rr = 0; rr < 16; ++rr) { const int nc = 32 * kt + (rr & 3) + 8 * (rr >> 2); p[kt][rr] = (nc < nvl) ? p[kt][rr] : -INFINITY; mx = fmaxf(mx, p[kt][rr]); }
        mx = fmaxf(mx, __shfl_xor(mx, 32));
        const float msafe = (mx == -INFINITY) ? 0.f : mx;
        float ls = 0.f;
#pragma unroll
        for (int kt = 0; kt < 4; ++kt)
#pragma unroll
            for (int rr = 0; rr < 16; ++rr) { p[kt][rr] = __builtin_amdgcn_exp2f(p[kt][rr] - msafe); ls += p[kt][rr]; }
        ls += __shfl_xor(ls, 32);
        const float inv = ls > 0.f ? 1.0f / ls : 0.f;
#pragma unroll
        for (int kt = 0; kt < 4; ++kt)
#pragma unroll
            for (int rr = 0; rr < 16; ++rr) p[kt][rr] *= inv;
        float Qs[16], rl[16];
#pragma unroll
        for (int q4 = 0; q4 < 16; ++q4) {
            const int kt = q4 >> 2, g4 = q4 & 3;
            Qs[q4] = (p[kt][4 * g4] + p[kt][4 * g4 + 1]) + (p[kt][4 * g4 + 2] + p[kt][4 * g4 + 3]);
            rl[q4] = __shfl_xor(p[kt][4 * g4 + 3], 32);
        }
        LAS float* impp = (LAS float*)(lds + AT_IMPP) + (r * 64 + tl) * 33;
#pragma unroll
        for (int q4 = 0; q4 < 16; ++q4) {
            const float ex = hi ? rl[q4] : (q4 > 0 ? rl[q4 > 0 ? q4 - 1 : 0] : 0.f);
            impp[8 * (q4 >> 2) + 2 * (q4 & 3) + hi] = Qs[q4] + ex;
        }
        f32x16 o[2];
#pragma unroll
        for (int rr = 0; rr < 16; ++rr) { o[0][rr] = 0.f; o[1][rr] = 0.f; }
#pragma unroll
        for (int kt = 0; kt < 4; ++kt)
#pragma unroll
            for (int s = 0; s < 2; ++s) pv_step(o, lds + AT_VC, 264, 32 * kt + 16 * s, pack8(p[kt], s), i, hi);
#pragma unroll
        for (int rr = 0; rr < 16; ++rr) { tot[0][rr] = o[0][rr] * g0; tot[1][rr] = o[1][rr] * g0; }
    }
    __syncthreads();
    {
        LAS float* IMPP = (LAS float*)(lds + AT_IMPP); LAS float* IMP = (LAS float*)(lds + AT_IMP); LAS unsigned* SEL = (LAS unsigned*)(lds + AT_SEL);
#pragma unroll
        for (int it = 0; it < 4; ++it) {
            const int idx = tid + NTHREADS * it, tt = idx >> 5, j = idx & 31;
            IMP[tt * 33 + j] = ((IMPP[(0 * 64 + tt) * 33 + j] + IMPP[(1 * 64 + tt) * 33 + j]) + IMPP[(2 * 64 + tt) * 33 + j]) + IMPP[(3 * 64 + tt) * 33 + j];
        }
        __syncthreads();
#pragma unroll 1
        for (int it = 0; it < 4; ++it) {
            const int idx = tid + NTHREADS * it, tt = idx >> 5, j = idx & 31;
            const float v = IMP[tt * 33 + j];
            int cnt = 0;
#pragma unroll 2
            for (int j2 = 1; j2 <= qt - 2; ++j2) { const float v2 = IMP[tt * 33 + j2]; cnt += ((v2 > v) || (v2 == v && j2 < j)) ? 1 : 0; }
            const bool forced = (j == 0) || (j == qt) || (j == qt - 1);
            const bool sel = (j <= qt) && (forced || (j >= 1 && j <= qt - 2 && cnt < 13));
            const unsigned long long bal = __ballot(sel);
            if ((lane & 31) == 0) SEL[tt] = (lane < 32) ? (unsigned)bal : (unsigned)(bal >> 32);
        }
        __syncthreads();
    }
    unsigned selw, unionmask;
    { LAS unsigned* SEL = (LAS unsigned*)(lds + AT_SEL); selw = SEL[tl]; unsigned uu = SEL[lane];
#pragma unroll
      for (int o = 1; o < 64; o <<= 1) uu |= __shfl_xor(uu, o);
      unionmask = uu; }
    unionmask = __builtin_amdgcn_readfirstlane(unionmask);
    attn_branch<0>(PROJ + (size_t)b * 2048 * NPROJ + 2048 + 64 * g, VT + ((size_t)(32 + bg) * 64) * 2048, qt - 8 > 0 ? qt - 8 : 0, qt, 0u, 0u, tq, qf, lds, tid, i, hi, g2, tot);
    attn_branch<1>(PROJ + (size_t)b * 2048 * NPROJ + 1792 + 64 * g, VT + ((size_t)bg * 64) * 2048, 0, qt, selw, unionmask, tq, qf, lds, tid, i, hi, g1, tot);
    bf16_t* yp = Y + row * DM + 512 + 64 * (4 * g + r);
#pragma unroll
    for (int d0t = 0; d0t < 2; ++d0t)
#pragma unroll
        for (int g4 = 0; g4 < 4; ++g4) {
            const int d = 32 * d0t + 8 * g4 + 4 * hi;
            *(u32x2*)(yp + d) = (u32x2){pk2(tot[d0t][4 * g4], tot[d0t][4 * g4 + 1]), pk2(tot[d0t][4 * g4 + 2], tot[d0t][4 * g4 + 3])};
        }
}


#define XB_TMO      128
#define XB_XCNT(j)  (256  + 64 * (j))
#define XB_XSUB(j)  (1280 + 64 * (j))
#define XB_XGEN(j)  (2304 + 64 * (j))
#define XB_TOP      3328
#define XB_TOPGEN   3392
#define XCD_BAR_WORDS 3456
#define XB_SPIN_CAP (1u << 20)
__device__ __forceinline__ unsigned xb_ld(unsigned* p)              { return __hip_atomic_load(p, __ATOMIC_RELAXED, __HIP_MEMORY_SCOPE_AGENT); }
__device__ __forceinline__ unsigned xb_add(unsigned* p, unsigned v) { return __hip_atomic_fetch_add(p, v, __ATOMIC_RELAXED, __HIP_MEMORY_SCOPE_AGENT); }
__device__ __forceinline__ unsigned xb_xcc_id() { return (unsigned)__builtin_amdgcn_s_getreg((3 << 11) | 20) & 0xFu; }
#define XB_SPIN(cond, bar) do { unsigned _sp = 0; while (cond) { __builtin_amdgcn_s_sleep(1); \
    if ((++_sp & 255u) == 0u) { if (xb_ld(&(bar)[XB_TMO])) break; if (_sp > XB_SPIN_CAP) { atomicAdd(&(bar)[XB_TMO], 1u); break; } } } } while (0)
struct XcdBarrier { unsigned* bar; unsigned x; volatile LAS unsigned* st; };
__device__ __forceinline__ XcdBarrier xcd_barrier_post(unsigned* bar, volatile LAS unsigned* st) {
    XcdBarrier b; b.bar = bar; b.x = xb_xcc_id(); b.st = st;
    if (threadIdx.x == 0) (void)xb_add(&bar[XB_XCNT(b.x)], 1u);
    return b;
}
__device__ __forceinline__ void xcd_barrier_complete(unsigned* bar, unsigned x, unsigned& nloc, unsigned& nx) {
    const unsigned G = gridDim.x * gridDim.y * gridDim.z;
    unsigned sum, cnt, mine, sp = 0u;
    for (;;) {
        sum = 0u; cnt = 0u; mine = 0u;
#pragma unroll
        for (unsigned j = 0; j < 16; ++j) { const unsigned c = xb_ld(&bar[XB_XCNT(j)]); sum += c; cnt += (c > 0u) ? 1u : 0u; mine = (j == x) ? c : mine; }
        if (sum == G) break;
        __builtin_amdgcn_s_sleep(1);
        if ((++sp & 255u) == 0u) { if (xb_ld(&bar[XB_TMO])) break; if (sp > XB_SPIN_CAP) { atomicAdd(&bar[XB_TMO], 1u); break; } }
    }
    nloc = mine > 0u ? mine : 1u; nx = cnt > 0u ? cnt : 1u;
}
__device__ __forceinline__ void xcd_barrier(const XcdBarrier& b) {
    asm volatile("s_waitcnt vmcnt(0)" ::: "memory");
    __syncthreads();
    if (threadIdx.x == 0) {
        unsigned* bar = b.bar;
        __builtin_amdgcn_s_waitcnt(0);
        unsigned nloc = b.st[0], nx = b.st[1];
        if (nloc == 0u) { xcd_barrier_complete(bar, b.x, nloc, nx); b.st[0] = nloc; b.st[1] = nx; }
        const unsigned old = xb_add(&bar[XB_XSUB(b.x)], 1u);
        const unsigned gen = old / nloc;
        if (old + 1u == (gen + 1u) * nloc) {
            __builtin_amdgcn_fence(__ATOMIC_RELEASE, "agent");
            asm volatile("s_waitcnt vmcnt(0)" ::: "memory");
            const unsigned og = xb_add(&bar[XB_TOP], 1u);
            const unsigned tg = og / nx;
            if (og + 1u == (tg + 1u) * nx) xb_add(&bar[XB_TOPGEN], 1u);
            else XB_SPIN(xb_ld(&bar[XB_TOPGEN]) == tg, bar);
            __builtin_amdgcn_fence(__ATOMIC_ACQUIRE, "agent");
            xb_add(&bar[XB_XGEN(b.x)], 1u);
            asm volatile("s_waitcnt vmcnt(0)" ::: "memory");
        } else {
            XB_SPIN(xb_ld(&bar[XB_XGEN(b.x)]) == gen, bar);
            __builtin_amdgcn_fence(__ATOMIC_ACQUIRE, "agent");
            asm volatile("s_waitcnt vmcnt(0)" ::: "memory");
        }
    }
    __syncthreads();
}

__global__ void __launch_bounds__(NTHREADS, 2) hymba_fwd(Args args) {
    extern __shared__ __attribute__((aligned(16))) unsigned char lds_raw[];
    cg::grid_group grid = cg::this_grid();
    Frame F;
    F.lds = (LAS unsigned char*)lds_raw;
    F.G = gridDim.x;
    if (threadIdx.x < 64) ((LAS unsigned*)(F.lds + 131072))[threadIdx.x] = 0u;
    __syncthreads();
    const XcdBarrier xbar = xcd_barrier_post((unsigned*)(args.ws + WS_CTL), (volatile LAS unsigned*)(F.lds + 131072));
    if (args.ph_hi > 1000) grid.sync();

    const int lo = args.ph_lo, hi = args.ph_hi;
#define RELAUNDER() do { int tv = threadIdx.x; asm volatile("" : "+v"(tv)); F.tid = tv; F.lane = tv & 63; F.wave = __builtin_amdgcn_readfirstlane(tv >> 6); \
        int bv = blockIdx.x; asm volatile("" : "+s"(bv)); F.bid = bv; \
        const __attribute__((address_space(4))) unsigned long long* kv = (const __attribute__((address_space(4))) unsigned long long*)__builtin_amdgcn_kernarg_segment_ptr(); asm volatile("" : "+s"(kv)); F.kp = kv; \
        F.ws = (unsigned char*)kv[29]; F.out = (float*)kv[28]; } while (0)
#ifndef REPMASK
#define REPMASK 0
#endif
#define PH(k) if (lo <= (k) && (k) < hi) for (int rep_ = 0; rep_ < 1 + ((REPMASK >> (k)) & 1); ++rep_)
#define SEAM(k) do { if ((k) + 1 < hi || rep_ < ((REPMASK >> (k)) & 1)) xcd_barrier(xbar); } while (0)
#define WSB(off) ((bf16_t*)(F.ws + (off)))

    PH(0) { RELAUNDER();
#ifndef NO_P0
        p_prologue(F);
#endif
        SEAM(0); }
    PH(1) { RELAUNDER();
        pg8::Gemm g{WSB(WS_AB), WSB(WS_W1A), MTOK, NFF2, DM, DM}; pg8::StaticOrder S; S.init(MTOK, NFF2, F.G, F.bid); pg8::EpiSwiGLU E{WSB(WS_ACT)};
#ifndef NO_P1
        pg8::gemm_phase<pg8::EpiSwiGLU, DM, DM>(F.lds, g, S, E, F.tid);
#endif
        SEAM(1); }
    PH(2) { RELAUNDER();
        pg8::Gemm g{WSB(WS_ACT), WSB(WS_W1B), MTOK, DM, DFF, DFF}; pg8::StaticOrder S; S.init(MTOK, DM, F.G, F.bid); pg8::EpiResid E{WSB(WS_AB), WSB(WS_Y), ALPHA, 0.5f};
#ifndef NO_P2
        pg8::gemm_phase<pg8::EpiResid, DFF, DFF>(F.lds, g, S, E, F.tid);
#endif
        SEAM(2); }
    PH(3) { RELAUNDER(); p_layernorm<false>(F, WSB(WS_Y), INP(3), INP(4), WSB(WS_AB), nullptr); SEAM(3); }
    PH(4) { RELAUNDER();
        pg8::Gemm g{WSB(WS_AB), WSB(WS_WMI), MTOK, NPROJ, DM, DM}; pg8::StaticOrder S; S.init(MTOK, NPROJ, F.G, F.bid);
        pg8::EpiProj E{WSB(WS_ACT), WSB(WS_KCV), WSB(WS_VT), (const float*)(F.ws + WS_ROPE)};
#ifndef NO_P4
        pg8::gemm_phase<pg8::EpiProj, DM, DM>(F.lds, g, S, E, F.tid);
#endif
        SEAM(4); }
    PH(5) { RELAUNDER();
        const int ncmp = (F.G > 64) ? 32 : 0;
        if (F.bid < 32) {
            const int which = F.bid >> 4;
            pg8::Gemm g{WSB(WS_KCV) + (size_t)which * 32 * 2048 * 64, WSB(WS_WC1) + (size_t)which * 256 * 2048, 4096, 256, 2048, 1024};
            pg8::StaticOrder S; S.init(4096, 256, F.G > 16 ? F.G : 16, F.bid & 15);
            pg8::EpiCmp E{WSB(WS_HID) + (size_t)which * 4096 * 256, (const float*)(F.ws + WS_CBIAS) + which * 256};
#ifndef NO_P5A
            pg8::gemm_phase<pg8::EpiCmp, 2048, 1024>(F.lds, g, S, E, F.tid);
#endif
            pg8::Unit cu; if (S.next(0, cu)) cmp_second(F, which, cu.pm);
        }
        if (F.bid >= ncmp) for (int u = F.bid - ncmp; u < 256; u += F.G - ncmp) {
#ifndef NO_P5B
            lru_unit(F, u);
#endif
        }
        SEAM(6); }
    PH(7) { RELAUNDER();
        for (int L = F.bid; L < 1024; L += F.G) {
            const int rd = L >> 8, c = L & 255, bg = c & 31, a = c >> 5;
            const int qt = rd == 0 ? 31 - a : (rd == 1 ? 16 + a : (rd == 2 ? 15 - a : a));
            { int tv = threadIdx.x; asm volatile("" : "+v"(tv)); F.tid = tv; F.lane = tv & 63; F.wave = __builtin_amdgcn_readfirstlane(tv >> 6); }
#ifndef NO_P7
            attn_unit(F, bg >> 1, bg & 1, qt);
#endif
        }
        SEAM(7); }
    PH(8) { RELAUNDER(); p_rmsnorm(F, WSB(WS_Y), INP(19), INP(20)); SEAM(8); }
    PH(9) { RELAUNDER();
        pg8::Gemm g{WSB(WS_Y), WSB(WS_WMO), MTOK, DM, DM, DM}; pg8::StaticOrder S; S.init(MTOK, DM, F.G, F.bid); pg8::EpiResid E{WSB(WS_AB), WSB(WS_ACT), ALPHA, 1.0f};
#ifndef NO_P9
        pg8::gemm_phase<pg8::EpiResid, DM, DM>(F.lds, g, S, E, F.tid);
#endif
        SEAM(9); }
    PH(10) { RELAUNDER(); p_layernorm<false>(F, WSB(WS_ACT), INP(22), INP(23), WSB(WS_AB), nullptr); SEAM(10); }
    PH(11) { RELAUNDER();
        pg8::Gemm g{WSB(WS_AB), WSB(WS_W2A), MTOK, NFF2, DM, DM}; pg8::StaticOrder S; S.init(MTOK, NFF2, F.G, F.bid); pg8::EpiSwiGLU E{WSB(WS_ACT)};
#ifndef NO_P1
        pg8::gemm_phase<pg8::EpiSwiGLU, DM, DM>(F.lds, g, S, E, F.tid);
#endif
        SEAM(11); }
    PH(12) { RELAUNDER();
        pg8::Gemm g{WSB(WS_ACT), WSB(WS_W2B), MTOK, DM, DFF, DFF}; pg8::StaticOrder S; S.init(MTOK, DM, F.G, F.bid); pg8::EpiResid E{WSB(WS_AB), WSB(WS_Y), ALPHA, 0.5f};
#ifndef NO_P2
        pg8::gemm_phase<pg8::EpiResid, DFF, DFF>(F.lds, g, S, E, F.tid);
#endif
        SEAM(12); }
    PH(13) { RELAUNDER(); p_layernorm<true>(F, WSB(WS_Y), INP(26), INP(27), nullptr, F.out); }
}

extern "C" void kernel_launch(void* const* d_in, const int* in_sizes, int n_in, void* d_out, int out_size, void* d_ws, size_t ws_size, hipStream_t stream) {
    static int grid = 0;
    if (grid == 0) {
        if (n_in != 28 || out_size != MTOK * DM || ws_size < WS_END) { fprintf(stderr, "kernel_launch: unexpected shapes (n_in %d out %d ws %zu)\n", n_in, out_size, ws_size); grid = -1; return; }
        int dev = 0, cus = 0, per_cu = 0;
        (void)hipGetDevice(&dev); (void)hipDeviceGetAttribute(&cus, hipDeviceAttributeMultiprocessorCount, dev);
        if (hipFuncSetAttribute((const void*)hymba_fwd, hipFuncAttributeMaxDynamicSharedMemorySize, LDS_BYTES) != hipSuccess) { fprintf(stderr, "kernel_launch: hipFuncSetAttribute failed\n"); grid = -1; return; }
        if (hipOccupancyMaxActiveBlocksPerMultiprocessor(&per_cu, (const void*)hymba_fwd, NTHREADS, LDS_BYTES) != hipSuccess || per_cu < 1) { fprintf(stderr, "kernel_launch: occupancy query failed (%d)\n", per_cu); (void)hipGetLastError(); per_cu = 1; }
        if (per_cu > 1) per_cu = 1;
        grid = cus * per_cu;
        if (grid <= 0) { grid = -1; return; }
    }
    if (grid < 0) return;
    if (hipMemsetAsync((char*)d_ws + WS_CTL, 0, CTL_BYTES, stream) != hipSuccess) { fprintf(stderr, "kernel_launch: memset failed\n"); return; }
    Args a{};
    for (int i = 0; i < 28; ++i) a.in[i] = (const float*)d_in[i];
    a.out = (float*)d_out; a.ws = (unsigned char*)d_ws; a.ph_lo = 0; a.ph_hi = NPHASE;
    void* kargs[] = {&a};
    hipError_t e = hipLaunchCooperativeKernel((const void*)hymba_fwd, dim3(grid), dim3(NTHREADS), kargs, LDS_BYTES, stream);
    if (e != hipSuccess) fprintf(stderr, "kernel_launch: cooperative launch failed: %s (grid %d)\n", hipGetErrorString(e), grid);
}
```
